# Optimizing an MI355X kernel written in HIP

```python
import math
import jax, jax.numpy as jnp
from jax import lax
import numpy as np

D_MODEL = 1024
BATCH = 16
SEQ = 2048
DEPTH = 1
DEC_BATCH = 32
DEC_SEQ = 16
PAST_LEN = 2048

CHUNK = 64
Q_BLOCK = 128
BRANCH_WIDTH = D_MODEL // 2
DA_HEAD_DIM = 64
DA_HEADS = BRANCH_WIDTH // (2 * DA_HEAD_DIM)
DA_V = 2 * DA_HEAD_DIM
SB_HEAD_DIM = 64
SB_HEADS = BRANCH_WIDTH // SB_HEAD_DIM
D_FF = 2816
CONV_WIDTH = 3
ROPE_THETA = 10000.0
NORM_EPS = 1e-6
N_IN = 6 * BRANCH_WIDTH + 2 * D_MODEL
NEG_INF = -1e30

kernel_name = "gated_diffattn_stickbreak_convffn_stream_step"


def rms_norm(x, g):
    xf = x.astype(jnp.float32)
    y = xf * lax.rsqrt(jnp.mean(xf * xf, axis=-1, keepdims=True) + NORM_EPS)
    return (y * g.astype(jnp.float32)).astype(x.dtype)


def rope(x, pos):
    dh = x.shape[-1]
    half = dh // 2
    inv = ROPE_THETA ** (-jnp.arange(half, dtype=jnp.float32) * 2.0 / dh)
    ang = pos.astype(jnp.float32)[:, None] * inv[None, :]
    cos = jnp.cos(ang)[:, None, None, :]
    sin = jnp.sin(ang)[:, None, None, :]
    xf = x.astype(jnp.float32)
    x1, x2 = xf[..., :half], xf[..., half:]
    out = jnp.concatenate([x1 * cos - x2 * sin, x2 * cos + x1 * sin], axis=-1)
    return out.astype(x.dtype)


def split_projection(z, pos):
    lead = z.shape[:2]
    W = BRANCH_WIDTH
    qa = rope(z[..., 0:W].reshape(lead + (DA_HEADS, 2, DA_HEAD_DIM)), pos)
    ka = rope(z[..., W:2 * W].reshape(lead + (DA_HEADS, 2, DA_HEAD_DIM)), pos)
    va = z[..., 2 * W:3 * W].reshape(lead + (DA_HEADS, DA_V))
    qb = z[..., 3 * W:4 * W].reshape(lead + (SB_HEADS, SB_HEAD_DIM))
    kb = z[..., 4 * W:5 * W].reshape(lead + (SB_HEADS, SB_HEAD_DIM))
    vb = z[..., 5 * W:6 * W].reshape(lead + (SB_HEADS, SB_HEAD_DIM))
    gate_a = jax.nn.sigmoid(z[..., 6 * W:6 * W + D_MODEL])
    gate_b = jax.nn.sigmoid(z[..., 6 * W + D_MODEL:])
    return qa, ka, va, qb, kb, vb, gate_a, gate_b


def diff_attention(q, k, v, q_pos, k_pos, lam):
    s = jnp.einsum('bqhcd,bkhcd->bhcqk', q, k).astype(jnp.float32) * (DA_HEAD_DIM ** -0.5)
    mask = (k_pos[None, :] // CHUNK) <= (q_pos[:, None] // CHUNK)
    p = jax.nn.softmax(jnp.where(mask, s, NEG_INF), axis=-1)
    w = p[:, :, 0] - lam * p[:, :, 1]
    return jnp.einsum('bhqk,bkhe->bqhe', w.astype(v.dtype), v)


def stick_breaking(q, k, v, q_pos, k_pos):
    z = jnp.einsum('bqhd,bkhd->bhqk', q, k).astype(jnp.float32) * (SB_HEAD_DIM ** -0.5)
    mask = k_pos[None, :] < q_pos[:, None]
    log_keep = jnp.where(mask, -jax.nn.softplus(z), 0.0)
    later = lax.cumsum(log_keep, axis=3, reverse=True) - log_keep
    a = jnp.where(mask, jnp.exp(jax.nn.log_sigmoid(z) + later), 0.0)
    return jnp.einsum('bhqk,bkhd->bqhd', a.astype(v.dtype), v)


def merge_branches(oa, ob, gate_a, gate_b, subln_g, lam_init, w_br_a, w_br_b, w_out):
    lead = oa.shape[:2]
    oa = rms_norm(oa, subln_g) * (1.0 - lam_init)
    br_a = oa.reshape(lead + (BRANCH_WIDTH,)) @ w_br_a
    br_b = ob.reshape(lead + (BRANCH_WIDTH,)) @ w_br_b
    return (gate_a * br_a + gate_b * br_b) @ w_out


def conv_ffn(x, prev, g, w_up, conv_w, conv_b, w_down):
    T = x.shape[1]
    u = rms_norm(x, g) @ w_up
    full = jnp.concatenate([prev.astype(u.dtype), u], axis=1)
    c = conv_b
    for j in range(CONV_WIDTH):
        c = c + conv_w[j] * full[:, j:j + T]
    gate, val = c[..., :D_FF], c[..., D_FF:]
    y = (jax.nn.silu(gate) * val) @ w_down
    return x + y, full[:, -(CONV_WIDTH - 1):]


def setup_inputs(seed: int = 0) -> dict:
    key = jax.random.key(seed)
    ks = jax.random.split(key, 32)
    f32 = jnp.float32
    nrm = lambda k, s, scale: jax.random.normal(k, s, f32) * scale
    return {
        "x_prompt": nrm(ks[0], (BATCH, SEQ, D_MODEL), 1.0),
        "x_sample": nrm(ks[1], (DEC_BATCH, DEC_SEQ, D_MODEL), 1.0),
        "cache_diff_k": nrm(ks[2], (DEPTH, DEC_BATCH, PAST_LEN, DA_HEADS, 2, DA_HEAD_DIM), 1.0),
        "cache_diff_v": nrm(ks[3], (DEPTH, DEC_BATCH, PAST_LEN, DA_HEADS, DA_V), 1.0),
        "cache_sb_k": nrm(ks[4], (DEPTH, DEC_BATCH, PAST_LEN, SB_HEADS, SB_HEAD_DIM), 1.0),
        "cache_sb_v": nrm(ks[5], (DEPTH, DEC_BATCH, PAST_LEN, SB_HEADS, SB_HEAD_DIM), 1.0),
        "state_conv": nrm(ks[6], (DEPTH, DEC_BATCH, CONV_WIDTH - 1, 2 * D_FF), 1.0),
        "attn_norm_g": 1.0 + nrm(ks[7], (DEPTH, D_MODEL), 0.02),
        "w_in": nrm(ks[8], (DEPTH, D_MODEL, N_IN), D_MODEL ** -0.5),
        "lambda_q1": nrm(ks[9], (DEPTH, DA_HEAD_DIM), 0.1),
        "lambda_k1": nrm(ks[10], (DEPTH, DA_HEAD_DIM), 0.1),
        "lambda_q2": nrm(ks[11], (DEPTH, DA_HEAD_DIM), 0.1),
        "lambda_k2": nrm(ks[12], (DEPTH, DA_HEAD_DIM), 0.1),
        "subln_g": 1.0 + nrm(ks[13], (DEPTH, DA_V), 0.02),
        "w_branch_a": nrm(ks[14], (DEPTH, BRANCH_WIDTH, D_MODEL), BRANCH_WIDTH ** -0.5),
        "w_branch_b": nrm(ks[15], (DEPTH, BRANCH_WIDTH, D_MODEL), BRANCH_WIDTH ** -0.5),
        "w_out": nrm(ks[16], (DEPTH, D_MODEL, D_MODEL), D_MODEL ** -0.5),
        "ffn_norm_g": 1.0 + nrm(ks[17], (DEPTH, D_MODEL), 0.02),
        "w_up": nrm(ks[18], (DEPTH, D_MODEL, 2 * D_FF), D_MODEL ** -0.5),
        "conv_w": nrm(ks[19], (DEPTH, CONV_WIDTH, 2 * D_FF), CONV_WIDTH ** -0.5),
        "conv_b": nrm(ks[20], (DEPTH, 2 * D_FF), 0.01),
        "w_down": nrm(ks[21], (DEPTH, D_FF, D_MODEL), D_FF ** -0.5),
        "final_norm_g": 1.0 + nrm(ks[22], (D_MODEL,), 0.02),
    }


def reference(x_prompt, x_sample, cache_diff_k, cache_diff_v, cache_sb_k, cache_sb_v,
              state_conv, attn_norm_g, w_in, lambda_q1, lambda_k1, lambda_q2, lambda_k2,
              subln_g, w_branch_a, w_branch_b, w_out, ffn_norm_g, w_up, conv_w, conv_b,
              w_down, final_norm_g):
    seq = x_prompt.shape[1]
    t_new = x_sample.shape[1]
    past = cache_diff_k.shape[2]
    pos_p = jnp.arange(seq)
    pos_s = past + jnp.arange(t_new)
    k_pos_s = jnp.arange(past + t_new)

    xp, xs = x_prompt, x_sample
    p_dk, p_dv, p_sk, p_sv, p_cv = [], [], [], [], []
    s_dk, s_dv, s_sk, s_sv, s_cv = [], [], [], [], []
    for l in range(DEPTH):
        lam_init = 0.8 - 0.6 * math.exp(-0.3 * l)
        lam = (jnp.exp(jnp.sum(lambda_q1[l].astype(jnp.float32) * lambda_k1[l].astype(jnp.float32)))
               - jnp.exp(jnp.sum(lambda_q2[l].astype(jnp.float32) * lambda_k2[l].astype(jnp.float32)))
               + lam_init)

        zp = rms_norm(xp, attn_norm_g[l]) @ w_in[l]
        qa, ka, va, qb, kb, vb, ga, gb = split_projection(zp, pos_p)
        oa_blocks, ob_blocks = [], []
        for i in range(seq // Q_BLOCK):
            s0, e0 = i * Q_BLOCK, (i + 1) * Q_BLOCK
            qpos = jnp.arange(s0, e0)
            kpos = jnp.arange(e0)
            oa_blocks.append(diff_attention(qa[:, s0:e0], ka[:, :e0], va[:, :e0], qpos, kpos, lam))
            ob_blocks.append(stick_breaking(qb[:, s0:e0], kb[:, :e0], vb[:, :e0], qpos, kpos))
        oa = jnp.concatenate(oa_blocks, axis=1)
        ob = jnp.concatenate(ob_blocks, axis=1)
        xp = xp + merge_branches(oa, ob, ga, gb, subln_g[l], lam_init,
                                 w_branch_a[l], w_branch_b[l], w_out[l])
        zeros_prev = jnp.zeros((xp.shape[0], CONV_WIDTH - 1, 2 * D_FF), xp.dtype)
        xp, conv_p = conv_ffn(xp, zeros_prev, ffn_norm_g[l], w_up[l], conv_w[l], conv_b[l], w_down[l])
        p_dk.append(ka); p_dv.append(va); p_sk.append(kb); p_sv.append(vb); p_cv.append(conv_p)

        zs = rms_norm(xs, attn_norm_g[l]) @ w_in[l]
        qa2, ka2, va2, qb2, kb2, vb2, ga2, gb2 = split_projection(zs, pos_s)
        ka_all = jnp.concatenate([cache_diff_k[l].astype(ka2.dtype), ka2], axis=1)
        va_all = jnp.concatenate([cache_diff_v[l].astype(va2.dtype), va2], axis=1)
        kb_all = jnp.concatenate([cache_sb_k[l].astype(kb2.dtype), kb2], axis=1)
        vb_all = jnp.concatenate([cache_sb_v[l].astype(vb2.dtype), vb2], axis=1)
        oa2 = diff_attention(qa2, ka_all, va_all, pos_s, k_pos_s, lam)
        ob2 = stick_breaking(qb2, kb_all, vb_all, pos_s, k_pos_s)
        xs = xs + merge_branches(oa2, ob2, ga2, gb2, subln_g[l], lam_init,
                                 w_branch_a[l], w_branch_b[l], w_out[l])
        xs, conv_s = conv_ffn(xs, state_conv[l], ffn_norm_g[l], w_up[l], conv_w[l], conv_b[l], w_down[l])
        s_dk.append(ka2); s_dv.append(va2); s_sk.append(kb2); s_sv.append(vb2); s_cv.append(conv_s)

    y_prompt = rms_norm(xp, final_norm_g)
    y_sample = rms_norm(xs, final_norm_g)
    return (y_prompt, y_sample,
            jnp.stack(p_dk), jnp.stack(p_dv), jnp.stack(p_sk), jnp.stack(p_sv), jnp.stack(p_cv),
            jnp.stack(s_dk), jnp.stack(s_dv), jnp.stack(s_sk), jnp.stack(s_sv), jnp.stack(s_cv))
```

```cpp
#include <hip/hip_runtime.h>
#include <hip/hip_cooperative_groups.h>
#include <cstdio>
#include <cstdint>
namespace cg = cooperative_groups;
namespace pg8 {
#define PG8_LAS __attribute__((address_space(3)))
typedef unsigned short bf16_t;
typedef short bf16x8 __attribute__((ext_vector_type(8)));
typedef float f32x4 __attribute__((ext_vector_type(4)));
typedef unsigned u32x4 __attribute__((ext_vector_type(4)));
constexpr int BM = 256, BK = 64, HALF = 128, HTB = HALF * BK * 2  , STAGE_BYTES = 8 * HTB, NXCD = 8, WGM = 8;

__host__ __device__ __forceinline__ int lds_byte(int r, int c) { const int st = (r >> 4) * 2 + (c >> 5), rr = r & 15, cc = c & 31, ob = rr * 64 + cc * 2; return st * 1024 + (ob ^ (((ob >> 9) & 1) << 5)); }
__host__ __device__ __forceinline__ void stage_rc(int b, int& R, int& C) { const int st = b / 1024, sb = b % 1024, swz = sb ^ (((sb >> 9) & 1) << 5); R = (st >> 1) * 16 + swz / 64; C = (st & 1) * 32 + (swz % 64) / 2; }
__host__ __device__ __forceinline__ int perm32(int rho) { const int n = rho >> 4, i = rho & 15; return 8 * (i >> 2) + 4 * n + (i & 3); }

struct Unit { int pm, pn; };
struct Gemm { const bf16_t* A; const bf16_t* Bt; int M, N, K; };

struct StaticOrder {
    int nM, nN, nwg, G, c;
    __host__ __device__ void init(int M, int N, int G_, int c_) { nM = M / BM; nN = N / BM; nwg = nM * nN; G = G_; c = c_; }
    __host__ __device__ bool next(int i, Unit& u) const {
        const long L = (long)i * G + c; if (L >= nwg) return false;
        int wgid = (int)L; { const int q = nwg / NXCD, r = nwg % NXCD, xcd = wgid % NXCD, off = wgid / NXCD; wgid = (xcd < r ? xcd * (q + 1) : r * (q + 1) + (xcd - r) * q) + off; }
        const int nig = WGM * nN, gid = wgid / nig, fm = gid * WGM, gsz = (nM - fm) < WGM ? (nM - fm) : WGM;
        u.pm = fm + ((wgid % nig) % gsz); u.pn = (wgid % nig) / gsz; return true;
    }
    __device__ __forceinline__ void a_ready(const Unit&) const {}
    __device__ __forceinline__ void done(const Unit&) const {}
};

__device__ __forceinline__ unsigned cvt_pk_bf16(float lo, float hi) { unsigned r; asm volatile("v_cvt_pk_bf16_f32 %0, %1, %2" : "=v"(r) : "v"(lo), "v"(hi)); return r; }
typedef float f32x2 __attribute__((ext_vector_type(2)));
template <class Epi, class Sched, bool ALIGN_EPI = false, bool SP2 = false>
__device__ __forceinline__ void gemm_phase(PG8_LAS unsigned char* lds, const Gemm g, const Sched& S, const Epi& E) {
    const int tid = threadIdx.x, wid = __builtin_amdgcn_readfirstlane(tid >> 6), lane = tid & 63, wr = wid >> 2, wc = wid & 3, fr = lane & 15, fq = lane >> 4;
    const int K = g.K, nt = K / BK;
    unsigned voffA[2], voffB[2];
#pragma unroll
    for (int i = 0; i < 2; ++i) { int R, C; stage_rc(tid * 16 + i * 8192, R, C); const int Rb = Epi::PERM ? ((R & ~31) + perm32(R & 31)) : R;
        voffA[i] = (unsigned)(R * K + C) * 2u; voffB[i] = (unsigned)(Rb * K + C) * 2u; }
    const size_t kstep = (size_t)(BK * 2);
    const size_t hstep = (size_t)HALF * K * 2;
    const size_t tstep = 2 * hstep;
    const unsigned ldsw = (unsigned)wid * 1024u;
    const int aoff = lds_byte(wr * 64 + fr, fq * 8), boff = lds_byte(wc * 32 + fr, fq * 8);
#define PG8_SA(b, h) (((b) * 2 + (h)) * HTB)
#define PG8_SB(b, h) ((4 + (b) * 2 + (h)) * HTB)
#define PG8_STAGE(bufoff, gbase, voff) do { _Pragma("unroll") for (int _i = 0; _i < 2; ++_i) \
        __builtin_amdgcn_global_load_lds((const unsigned*)((const char*)(gbase) + (voff)[_i]), (PG8_LAS unsigned*)(lds + (bufoff) + ldsw + _i * 8192), 16, 0, 0); } while (0)
#define PG8_LDA(dst, b, h) do { _Pragma("unroll") for (int m = 0; m < 4; ++m) _Pragma("unroll") for (int k = 0; k < 2; ++k) dst[m][k] = *(const PG8_LAS bf16x8*)(lds + PG8_SA(b, h) + aoff + m * 2048 + k * 1024); } while (0)
#define PG8_LDB(dst, b, h) do { _Pragma("unroll") for (int n = 0; n < 2; ++n) _Pragma("unroll") for (int k = 0; k < 2; ++k) dst[n][k] = *(const PG8_LAS bf16x8*)(lds + PG8_SB(b, h) + boff + n * 2048 + k * 1024); } while (0)
#define PG8_MMA(ai, bj, At, Bt) do { __builtin_amdgcn_s_setprio(1); _Pragma("unroll") for (int m = 0; m < 4; ++m) _Pragma("unroll") for (int n = 0; n < 2; ++n) _Pragma("unroll") for (int k = 0; k < 2; ++k) \
        acc[ai][bj][m][n] = __builtin_amdgcn_mfma_f32_16x16x32_bf16(Bt[n][k], At[m][k], acc[ai][bj][m][n], 0, 0, 0); __builtin_amdgcn_s_setprio(0); } while (0)
#define PG8_WAIT_V(n) asm volatile("s_waitcnt vmcnt(" #n ")" ::: "memory")
#define PG8_WAIT_L(n) asm volatile("s_waitcnt lgkmcnt(" #n ")" ::: "memory")
#define PG8_BAR __builtin_amdgcn_s_barrier()
#define PG8_SCHED __builtin_amdgcn_sched_barrier(0)
    Unit cur, nxt; int ui = 0;
    if (!S.next(0, cur)) return;
    f32x4 acc[2][2][4][2];
#pragma unroll
    for (int a = 0; a < 2; ++a)
#pragma unroll
        for (int b = 0; b < 2; ++b)
#pragma unroll
            for (int m = 0; m < 4; ++m)
#pragma unroll
                for (int n = 0; n < 2; ++n) acc[a][b][m][n] = (f32x4){0.f, 0.f, 0.f, 0.f};
    bf16x8 At[4][2], B0[2][2], B1[2][2];
    const char* cA = (const char*)g.A + (size_t)cur.pm * tstep; const char* cB = (const char*)g.Bt + (size_t)cur.pn * tstep;
    S.a_ready(cur);
    if constexpr (SP2) {
        PG8_STAGE(PG8_SB(0, 0), cB, voffB); PG8_STAGE(PG8_SB(0, 1), cB + hstep, voffB); PG8_STAGE(PG8_SA(0, 0), cA, voffA); PG8_STAGE(PG8_SA(0, 1), cA + hstep, voffA);
        if (wr == 1) PG8_BAR;
        PG8_WAIT_V(2); PG8_BAR;
        PG8_STAGE(PG8_SB(1, 0), cB + kstep, voffB); PG8_STAGE(PG8_SA(1, 0), cA + kstep, voffA); PG8_STAGE(PG8_SB(1, 1), cB + hstep + kstep, voffB);
        PG8_WAIT_V(6); PG8_BAR;
    } else {
        PG8_STAGE(PG8_SB(0, 0), cB, voffB); PG8_STAGE(PG8_SA(0, 0), cA, voffA); PG8_STAGE(PG8_SB(0, 1), cB + hstep, voffB); PG8_STAGE(PG8_SA(0, 1), cA + hstep, voffA);
        if (wr == 1) PG8_BAR;
        PG8_WAIT_V(4); PG8_BAR;
        PG8_STAGE(PG8_SB(1, 0), cB + kstep, voffB); PG8_STAGE(PG8_SA(1, 0), cA + kstep, voffA); PG8_STAGE(PG8_SB(1, 1), cB + hstep + kstep, voffB);
        PG8_WAIT_V(6); PG8_BAR;
    }
    for (;;) {
        const bool has_next = S.next(ui + 1, nxt);
        const char* nA = has_next ? (const char*)g.A + (size_t)nxt.pm * tstep : cA; const char* nB = has_next ? (const char*)g.Bt + (size_t)nxt.pn * tstep : cB;
        for (int t = 0; t < nt; t += 2) {
            const bool last = (t == nt - 2);
            const char* a1 = cA + (size_t)(t + 1) * kstep;
            const char* a2 = last ? nA : cA + (size_t)(t + 2) * kstep; const char* b2 = last ? nB : cB + (size_t)(t + 2) * kstep;
            const char* a3 = a2 + kstep; const char* b3 = b2 + kstep;
            if (last && has_next) S.a_ready(nxt);
            if constexpr (SP2) {
            PG8_LDB(B0, 0, 0); PG8_LDB(B1, 0, 1); PG8_SCHED; PG8_LDA(At, 0, 0); PG8_STAGE(PG8_SA(1, 1), a1 + hstep, voffA);
            PG8_WAIT_V(8); PG8_WAIT_L(0); PG8_BAR; PG8_MMA(0, 0, At, B0); PG8_MMA(0, 1, At, B1); PG8_BAR; PG8_SCHED;
            PG8_LDA(At, 0, 1); PG8_STAGE(PG8_SB(0, 0), b2, voffB); PG8_STAGE(PG8_SB(0, 1), b2 + hstep, voffB); PG8_STAGE(PG8_SA(0, 0), a2, voffA);
            PG8_WAIT_V(8); PG8_WAIT_L(0); PG8_BAR; PG8_MMA(1, 0, At, B0); PG8_MMA(1, 1, At, B1); PG8_BAR; PG8_SCHED;
            PG8_LDB(B0, 1, 0); PG8_LDB(B1, 1, 1); PG8_SCHED; PG8_LDA(At, 1, 0); PG8_STAGE(PG8_SA(0, 1), a2 + hstep, voffA);
            PG8_WAIT_V(8); PG8_WAIT_L(0); PG8_BAR; PG8_MMA(0, 0, At, B0); PG8_MMA(0, 1, At, B1); PG8_BAR; PG8_SCHED;
            PG8_LDA(At, 1, 1); PG8_STAGE(PG8_SB(1, 0), b3, voffB); PG8_STAGE(PG8_SB(1, 1), b3 + hstep, voffB); PG8_STAGE(PG8_SA(1, 0), a3, voffA);
            PG8_WAIT_V(8); PG8_WAIT_L(0); PG8_BAR; PG8_MMA(1, 0, At, B0); PG8_MMA(1, 1, At, B1); PG8_BAR; PG8_SCHED;
            } else {
            PG8_LDB(B0, 0, 0); PG8_SCHED; PG8_LDA(At, 0, 0); PG8_STAGE(PG8_SA(1, 1), a1 + hstep, voffA);
            PG8_WAIT_L(8); PG8_BAR; PG8_WAIT_L(0); PG8_MMA(0, 0, At, B0); PG8_BAR; PG8_SCHED;
            PG8_LDB(B1, 0, 1); PG8_STAGE(PG8_SB(0, 0), b2, voffB);
            PG8_BAR; PG8_WAIT_L(0); PG8_MMA(0, 1, At, B1); PG8_BAR;
            PG8_LDA(At, 0, 1); PG8_STAGE(PG8_SA(0, 0), a2, voffA);
            PG8_BAR; PG8_WAIT_L(0); PG8_MMA(1, 0, At, B0); PG8_BAR; PG8_SCHED;
            PG8_STAGE(PG8_SB(0, 1), b2 + hstep, voffB);
            PG8_WAIT_V(6); PG8_BAR; PG8_MMA(1, 1, At, B1); PG8_BAR;
            PG8_LDB(B0, 1, 0); PG8_SCHED; PG8_LDA(At, 1, 0); PG8_STAGE(PG8_SA(0, 1), a2 + hstep, voffA);
            PG8_WAIT_L(8); PG8_BAR; PG8_WAIT_L(0); PG8_MMA(0, 0, At, B0); PG8_BAR; PG8_SCHED;
            PG8_LDB(B1, 1, 1); PG8_STAGE(PG8_SB(1, 0), b3, voffB);
            PG8_BAR; PG8_WAIT_L(0); PG8_MMA(0, 1, At, B1); PG8_BAR;
            PG8_LDA(At, 1, 1); PG8_STAGE(PG8_SA(1, 0), a3, voffA);
            PG8_BAR; PG8_WAIT_L(0); PG8_MMA(1, 0, At, B0); PG8_BAR; PG8_SCHED;
            PG8_STAGE(PG8_SB(1, 1), b3 + hstep, voffB);
            PG8_WAIT_V(6); PG8_BAR; PG8_MMA(1, 1, At, B1); PG8_BAR;
            }
        }
        if constexpr (ALIGN_EPI) { if (wr == 0) PG8_BAR; }
        if constexpr (!Epi::AFTER_DRAIN) { E(acc, cur, wr, wc, fr, fq); S.done(cur); }
        if (!has_next) break;
#pragma unroll
        for (int a = 0; a < 2; ++a)
#pragma unroll
            for (int b = 0; b < 2; ++b)
#pragma unroll
                for (int m = 0; m < 4; ++m)
#pragma unroll
                    for (int n = 0; n < 2; ++n) acc[a][b][m][n] = (f32x4){0.f, 0.f, 0.f, 0.f};
        cur = nxt; cA = nA; cB = nB; ++ui;
        if constexpr (ALIGN_EPI) { if (wr == 1) PG8_BAR; }
    }
    PG8_WAIT_V(0);
    if constexpr (!ALIGN_EPI) { if (wr == 0) PG8_BAR; }
    PG8_BAR;
    if constexpr (Epi::AFTER_DRAIN) { E.fused(acc, cur, wr, wc, fr, fq, lds, wid, lane); S.done(cur); }
#undef PG8_SA
#undef PG8_SB
#undef PG8_STAGE
#undef PG8_LDA
#undef PG8_LDB
#undef PG8_MMA
#undef PG8_WAIT_V
#undef PG8_WAIT_L
#undef PG8_BAR
#undef PG8_SCHED
}
}

#define LAS __attribute__((address_space(3)))
typedef LAS unsigned char* lptr;
typedef unsigned short bf16_t;
typedef float f32x4 __attribute__((ext_vector_type(4)));
typedef float f32x2 __attribute__((ext_vector_type(2)));
typedef float f32x16 __attribute__((ext_vector_type(16)));
typedef unsigned u32x4 __attribute__((ext_vector_type(4)));
typedef unsigned u32x2 __attribute__((ext_vector_type(2)));
typedef short bf16x8 __attribute__((ext_vector_type(8)));
typedef short s16x4 __attribute__((ext_vector_type(4)));
typedef short v4i16_t __attribute__((ext_vector_type(4)));

constexpr int M_TOK = 33280, M_P = 32768, DM = 1024, NIN = 5120, DFF = 2816, NUP = 5632;
constexpr float L2E = 1.4426950408889634f, LN2 = 0.6931471805599453f, NEPS = 1e-6f;
constexpr size_t O_Y = 0, O_PDK = 34078720, O_PDV = O_PDK + 16777216, O_PSK = O_PDV + 16777216, O_PSV = O_PSK + 16777216,
                 O_PCONV = O_PSV + 16777216, O_SDK = O_PCONV + 180224, O_SDV = O_SDK + 262144, O_SSK = O_SDV + 262144, O_SSV = O_SSK + 262144,
                 O_SCONV = O_SSV + 262144, O_END = O_SCONV + 360448;
constexpr size_t WS_CTL = 0, WS_RSTD = 4096, WS_SSQ1 = WS_RSTD + 133120, WS_SSQ2 = WS_SSQ1 + 2129920, WS_WIN = WS_SSQ2 + 2129920,
                 WS_WA = WS_WIN + 10485760, WS_WB = WS_WA + 1048576, WS_WOUT = WS_WB + 1048576, WS_WUP = WS_WOUT + 2097152,
                 WS_WDN = WS_WUP + 11534336, WS_A = WS_WDN + 5767168, WS_B = WS_A + 408944640, WS_X1B = WS_B + 187432960, WS_END = WS_X1B + 68157440;
constexpr size_t ZSEC = (size_t)M_TOK * 512;

struct Params {
    const float* x_prompt; const float* x_sample; const float* cdk; const float* cdv; const float* csk; const float* csv; const float* state_conv;
    const float* attn_g; const float* w_in; const float* lq1; const float* lk1; const float* lq2; const float* lk2; const float* subln_g;
    const float* w_a; const float* w_b; const float* w_out; const float* ffn_g; const float* w_up; const float* conv_w; const float* conv_b;
    const float* w_down; const float* final_g; float* out; unsigned char* ws;
};

__device__ __forceinline__ float bflo(unsigned w) { return __uint_as_float(w << 16); }
__device__ __forceinline__ float bfhi(unsigned w) { return __uint_as_float(w & 0xffff0000u); }
__device__ __forceinline__ unsigned cvtpk(float lo, float hi) { unsigned r; asm volatile("v_cvt_pk_bf16_f32 %0, %1, %2" : "=v"(r) : "v"(lo), "v"(hi)); return r; }
__device__ __forceinline__ u32x4 pack8(f32x4 a, f32x4 b) { u32x4 w; w.x = cvtpk(a[0], a[1]); w.y = cvtpk(a[2], a[3]); w.z = cvtpk(b[0], b[1]); w.w = cvtpk(b[2], b[3]); return w; }
__device__ __forceinline__ float wave_sum(float v) {
#pragma unroll
    for (int o = 1; o < 64; o <<= 1) v += __shfl_xor(v, o);
    return v;
}
__device__ __forceinline__ float fexp2(float x) { return __builtin_amdgcn_exp2f(x); }
__device__ __forceinline__ float flog2(float x) { return __builtin_amdgcn_logf(x); }
__device__ __forceinline__ float frcp(float x) { return __builtin_amdgcn_rcpf(x); }
__device__ __forceinline__ float sigmoidf_(float x) { return frcp(1.f + fexp2(-x * L2E)); }

struct EpiIn {
    static constexpr bool PERM = true, AFTER_DRAIN = false;
    const float* rstd; bf16_t* z; float* out;
    __device__ __forceinline__ void operator()(const pg8::f32x4 (&acc)[2][2][4][2], const pg8::Unit& u, int wr, int wc, int fr, int fq) const {
        const int pn = u.pn; const bool samp = u.pm >= 128;
        bf16_t* zb; int ld, tcol; float* fo = nullptr; float sc = 1.f; int mode = 0;
        if (pn < 12) {
            const int sec = pn >> 1; zb = z + (size_t)sec * ZSEC; ld = 512; tcol = (pn & 1) * 256;
            if (sec < 2) mode = 1;
            if (sec == 0) sc = 0.125f * L2E; else if (sec == 3) sc = 0.125f;
            if (sec == 1) fo = out + (samp ? O_SDK : O_PDK); else if (sec == 2) fo = out + (samp ? O_SDV : O_PDV);
            else if (sec == 4) fo = out + (samp ? O_SSK : O_PSK); else if (sec == 5) fo = out + (samp ? O_SSV : O_PSV);
        } else { const int gs = (pn - 12) >> 2; zb = z + (size_t)(6 + 2 * gs) * ZSEC; ld = 1024; tcol = ((pn - 12) & 3) * 256; mode = 2; }
        const int cb = tcol + wc * 64 + fq * 8;
        float ir[2][4];
#pragma unroll
        for (int n = 0; n < 2; ++n)
#pragma unroll
            for (int e = 0; e < 4; ++e) ir[n][e] = exp2f(-(float)(8 * fq + 4 * n + e) * (13.287712379549449f / 32.f)) * 0.15915494309189535f;
#pragma unroll
        for (int ai = 0; ai < 2; ++ai)
#pragma unroll
            for (int m = 0; m < 4; ++m) {
                const int row = u.pm * 256 + ai * 128 + wr * 64 + m * 16 + fr;
                const float rs = rstd[row] * sc;
                f32x4 v[2][2];
#pragma unroll
                for (int bj = 0; bj < 2; ++bj)
#pragma unroll
                    for (int n = 0; n < 2; ++n) v[bj][n] = acc[ai][bj][m][n] * rs;
                if (mode == 1) {
                    const float pos = samp ? (float)(2048 + (row & 15)) : (float)(row & 2047);
#pragma unroll
                    for (int n = 0; n < 2; ++n)
#pragma unroll
                        for (int e = 0; e < 4; ++e) {
                            float rev = pos * ir[n][e]; rev -= rintf(rev);
                            const float sn = __builtin_amdgcn_sinf(rev), cs = __builtin_amdgcn_cosf(rev);
                            const float x1 = v[0][n][e], x2 = v[1][n][e];
                            v[0][n][e] = x1 * cs - x2 * sn; v[1][n][e] = x2 * cs + x1 * sn;
                        }
                } else if (mode == 2) {
#pragma unroll
                    for (int bj = 0; bj < 2; ++bj)
#pragma unroll
                        for (int n = 0; n < 2; ++n)
#pragma unroll
                            for (int e = 0; e < 4; ++e) v[bj][n][e] = sigmoidf_(v[bj][n][e]);
                }
                const size_t rl = samp ? (size_t)(row - M_P) : (size_t)row;
#pragma unroll
                for (int bj = 0; bj < 2; ++bj) {
                    *(u32x4*)(zb + (size_t)row * ld + cb + 32 * bj) = pack8(v[bj][0], v[bj][1]);
                    if (fo) { float* d = fo + rl * 512 + cb + 32 * bj; *(f32x4*)d = v[bj][0]; *(f32x4*)(d + 4) = v[bj][1]; }
                }
            }
    }
};
template <bool FIRST> struct EpiMerge {
    static constexpr bool PERM = true, AFTER_DRAIN = false;
    const bf16_t* gate; bf16_t* mg;
    __device__ __forceinline__ void operator()(const pg8::f32x4 (&acc)[2][2][4][2], const pg8::Unit& u, int wr, int wc, int fr, int fq) const {
#pragma unroll
        for (int ai = 0; ai < 2; ++ai)
#pragma unroll
            for (int m = 0; m < 4; ++m) {
                const int row = u.pm * 256 + ai * 128 + wr * 64 + m * 16 + fr;
#pragma unroll
                for (int bj = 0; bj < 2; ++bj) {
                    const size_t off = (size_t)row * 1024 + u.pn * 256 + bj * 128 + wc * 32 + fq * 8;
                    const u32x4 g = *(const u32x4*)(gate + off);
                    f32x4 a = acc[ai][bj][m][0], b = acc[ai][bj][m][1];
                    a[0] *= bflo(g.x); a[1] *= bfhi(g.x); a[2] *= bflo(g.y); a[3] *= bfhi(g.y);
                    b[0] *= bflo(g.z); b[1] *= bfhi(g.z); b[2] *= bflo(g.w); b[3] *= bfhi(g.w);
                    if (!FIRST) { const u32x4 o = *(const u32x4*)(mg + off);
                        a[0] += bflo(o.x); a[1] += bfhi(o.x); a[2] += bflo(o.y); a[3] += bfhi(o.y);
                        b[0] += bflo(o.z); b[1] += bfhi(o.z); b[2] += bflo(o.w); b[3] += bfhi(o.w); }
                    *(u32x4*)(mg + off) = pack8(a, b);
                }
            }
    }
};
template <bool WRITE_BF> struct EpiRes {
    static constexpr bool PERM = true, AFTER_DRAIN = false;
    const float* base_p; const float* base_s; float* y; bf16_t* yb; float* ssq;
    __device__ __forceinline__ void operator()(const pg8::f32x4 (&acc)[2][2][4][2], const pg8::Unit& u, int wr, int wc, int fr, int fq) const {
        const bool samp = u.pm >= 128;
#pragma unroll
        for (int ai = 0; ai < 2; ++ai)
#pragma unroll
            for (int m = 0; m < 4; ++m) {
                const int row = u.pm * 256 + ai * 128 + wr * 64 + m * 16 + fr;
                const float* brow = samp ? base_s + (size_t)(row - M_P) * 1024 : base_p + (size_t)row * 1024;
                float s = 0.f;
#pragma unroll
                for (int bj = 0; bj < 2; ++bj) {
                    const int col = u.pn * 256 + bj * 128 + wc * 32 + fq * 8;
                    f32x4 a = acc[ai][bj][m][0] + *(const f32x4*)(brow + col), b = acc[ai][bj][m][1] + *(const f32x4*)(brow + col + 4);
                    s += (a[0] * a[0] + a[1] * a[1]) + (a[2] * a[2] + a[3] * a[3]) + (b[0] * b[0] + b[1] * b[1]) + (b[2] * b[2] + b[3] * b[3]);
                    float* d = y + (size_t)row * 1024 + col; *(f32x4*)d = a; *(f32x4*)(d + 4) = b;
                    if (WRITE_BF) *(u32x4*)(yb + (size_t)row * 1024 + col) = pack8(a, b);
                }
                s += __shfl_xor(s, 16); s += __shfl_xor(s, 32);
                if (fq == 0) ssq[(size_t)row * 16 + u.pn * 4 + wc] = s;
            }
    }
};
struct EpiUp {
    static constexpr bool PERM = true, AFTER_DRAIN = false;
    const float* ssq; bf16_t* U; float* out;
    __device__ __forceinline__ void operator()(const pg8::f32x4 (&acc)[2][2][4][2], const pg8::Unit& u, int wr, int wc, int fr, int fq) const {
        const bool samp = u.pm >= 128;
#pragma unroll
        for (int ai = 0; ai < 2; ++ai)
#pragma unroll
            for (int m = 0; m < 4; ++m) {
                const int row = u.pm * 256 + ai * 128 + wr * 64 + m * 16 + fr;
                const f32x4* sp = (const f32x4*)(ssq + (size_t)row * 16);
                const f32x4 s0 = sp[0], s1 = sp[1], s2 = sp[2], s3 = sp[3];
                const float tot = ((s0[0] + s0[1]) + (s0[2] + s0[3])) + ((s1[0] + s1[1]) + (s1[2] + s1[3])) + ((s2[0] + s2[1]) + (s2[2] + s2[3])) + ((s3[0] + s3[1]) + (s3[2] + s3[3]));
                const float rs = rsqrtf(tot * (1.f / 1024.f) + NEPS);
                float* cs = nullptr;
                if (!samp) { const int t = row & 2047; if (t >= 2046) cs = out + O_PCONV + (size_t)((row >> 11) * 2 + (t - 2046)) * NUP; }
                else { const int t = row & 15; if (t >= 14) cs = out + O_SCONV + (size_t)(((row - M_P) >> 4) * 2 + (t - 14)) * NUP; }
#pragma unroll
                for (int bj = 0; bj < 2; ++bj) {
                    const int col = u.pn * 256 + bj * 128 + wc * 32 + fq * 8;
                    const f32x4 a = acc[ai][bj][m][0] * rs, b = acc[ai][bj][m][1] * rs;
                    *(u32x4*)(U + (size_t)row * NUP + col) = pack8(a, b);
                    if (cs) { *(f32x4*)(cs + col) = a; *(f32x4*)(cs + col + 4) = b; }
                }
            }
    }
};

template <bool PERMROWS>
__device__ __forceinline__ void transpose_item(const float* W, int K, int N, bf16_t* WT, const float* g, LAS float* scr, int item, int lane) {
    const int nblk = N / 32, kb = item / nblk, nb = item % nblk, k0 = 64 * kb, n0 = 32 * nb;
#pragma unroll 8
    for (int i = 0; i < 32; ++i) { const int kk = 2 * i + (lane >> 5); float v = W[(size_t)(k0 + kk) * N + n0 + (lane & 31)]; if (g) v *= g[k0 + kk]; scr[kk * 33 + (lane & 31)] = v; }
    asm volatile("s_waitcnt lgkmcnt(0)" ::: "memory");
    const int c = lane & 7;
#pragma unroll
    for (int j = 0; j < 4; ++j) {
        const int n = (lane >> 3) + 8 * j; const LAS float* s = scr + (8 * c) * 33 + n;
        u32x4 o; o.x = cvtpk(s[0 * 33], s[1 * 33]); o.y = cvtpk(s[2 * 33], s[3 * 33]); o.z = cvtpk(s[4 * 33], s[5 * 33]); o.w = cvtpk(s[6 * 33], s[7 * 33]);
        int nn = n0 + n;
        if (PERMROWS) { const int p = nn & 255; nn = (nn & ~255) + ((p >> 5) & 1) * 128 + (p >> 6) * 32 + (p & 31); }
        *(u32x4*)(WT + (size_t)nn * K + k0 + 8 * c) = o;
    }
    asm volatile("s_waitcnt lgkmcnt(0)" ::: "memory");
}

namespace att {
constexpr int KCH = 1040, KMAP = 8 * KCH;
constexpr int DA_K = 0, DA_V = 2 * KMAP, DA_VS = 320;
constexpr int SB_K = 0, SB_V = KMAP, SB_VS = 192;
constexpr int WSF = 37376, CTL = 39424, EXCH = 40960, EXS = 132;
constexpr int NU_DAS = 128, NU_SBS = 256, NU_DAP = 1024, NU_SBP = 1024, NUNITS = NU_DAS + NU_SBS + NU_DAP + NU_SBP;
constexpr float SB_THR = -88.0f;

__device__ __forceinline__ s16x4 vtr(lptr p) { return __builtin_bit_cast(s16x4, __builtin_amdgcn_ds_read_tr16_b64_v4i16((LAS v4i16_t*)p)); }
__device__ __forceinline__ int crow(int r, int hi) { return (r & 3) + 8 * (r >> 2) + 4 * hi; }
__device__ __forceinline__ void expand8(u32x4 w, f32x4& a, f32x4& b) { a[0] = bflo(w.x); a[1] = bfhi(w.x); a[2] = bflo(w.y); a[3] = bfhi(w.y); b[0] = bflo(w.z); b[1] = bfhi(w.z); b[2] = bflo(w.w); b[3] = bfhi(w.w); }

template <bool SAMPLE> struct DAStage;
template <> struct DAStage<false> {
    u32x4 k[2], v[2];
    __device__ __forceinline__ void load(const Params& p, const bf16_t* KA, const bf16_t* VA, int b, int h, int t, int tid) {
#pragma unroll
        for (int i = 0; i < 2; ++i) { const int id = tid + 512 * i, row = id >> 4, ch = id & 15; const size_t off = (size_t)(b * 2048 + 64 * t + row) * 512 + h * 128 + ch * 8;
            k[i] = *(const u32x4*)(KA + off); v[i] = *(const u32x4*)(VA + off); }
    }
    __device__ __forceinline__ void store(lptr lds, int tid) {
#pragma unroll
        for (int i = 0; i < 2; ++i) { const int id = tid + 512 * i, row = id >> 4, ch = id & 15;
            *(LAS u32x4*)(lds + DA_K + (ch >> 3) * KMAP + (ch & 7) * KCH + row * 16) = k[i]; *(LAS u32x4*)(lds + DA_V + row * DA_VS + ch * 16) = v[i]; }
    }
};
template <> struct DAStage<true> {
    f32x4 k[2][2], v[2][2];
    __device__ __forceinline__ void load(const Params& p, const bf16_t* KA, const bf16_t* VA, int b, int h, int t, int tid) {
#pragma unroll
        for (int i = 0; i < 2; ++i) { const int id = tid + 512 * i, row = id >> 4, ch = id & 15;
            if (t < 32) { const size_t off = ((size_t)(b * 2048 + 64 * t + row) * 4 + h) * 128 + ch * 8;
                k[i][0] = *(const f32x4*)(p.cdk + off); k[i][1] = *(const f32x4*)(p.cdk + off + 4); v[i][0] = *(const f32x4*)(p.cdv + off); v[i][1] = *(const f32x4*)(p.cdv + off + 4); }
            else if (row < 16) { const size_t off = (size_t)(M_P + b * 16 + row) * 512 + h * 128 + ch * 8; expand8(*(const u32x4*)(KA + off), k[i][0], k[i][1]); expand8(*(const u32x4*)(VA + off), v[i][0], v[i][1]); }
            else { k[i][0] = k[i][1] = v[i][0] = v[i][1] = (f32x4){0.f, 0.f, 0.f, 0.f}; } }
    }
    __device__ __forceinline__ void store(lptr lds, int tid) {
#pragma unroll
        for (int i = 0; i < 2; ++i) { const int id = tid + 512 * i, row = id >> 4, ch = id & 15;
            *(LAS u32x4*)(lds + DA_K + (ch >> 3) * KMAP + (ch & 7) * KCH + row * 16) = pack8(k[i][0], k[i][1]); *(LAS u32x4*)(lds + DA_V + row * DA_VS + ch * 16) = pack8(v[i][0], v[i][1]); }
    }
};
template <bool SAMPLE> struct SBStage;
template <> struct SBStage<false> {
    u32x4 k, v;
    __device__ __forceinline__ void load(const Params& p, const bf16_t* KB, const bf16_t* VB, int b, int h, int t, int tid) {
        const int row = tid >> 3, ch = tid & 7; const size_t off = (size_t)(b * 2048 + 64 * t + row) * 512 + h * 64 + ch * 8;
        k = *(const u32x4*)(KB + off); v = *(const u32x4*)(VB + off);
    }
    __device__ __forceinline__ void store(lptr lds, int tid) {
        const int row = tid >> 3, ch = tid & 7;
        *(LAS u32x4*)(lds + SB_K + ch * KCH + row * 16) = k; *(LAS u32x4*)(lds + SB_V + row * SB_VS + ch * 16) = v;
    }
};
template <> struct SBStage<true> {
    f32x4 k[2], v[2];
    __device__ __forceinline__ void load(const Params& p, const bf16_t* KB, const bf16_t* VB, int b, int h, int t, int tid) {
        const int row = tid >> 3, ch = tid & 7;
        if (t < 32) { const size_t off = ((size_t)(b * 2048 + 64 * t + row) * 8 + h) * 64 + ch * 8;
            k[0] = *(const f32x4*)(p.csk + off); k[1] = *(const f32x4*)(p.csk + off + 4); v[0] = *(const f32x4*)(p.csv + off); v[1] = *(const f32x4*)(p.csv + off + 4); }
        else if (row < 16) { const size_t off = (size_t)(M_P + b * 16 + row) * 512 + h * 64 + ch * 8; expand8(*(const u32x4*)(KB + off), k[0], k[1]); expand8(*(const u32x4*)(VB + off), v[0], v[1]); }
        else { k[0] = k[1] = v[0] = v[1] = (f32x4){0.f, 0.f, 0.f, 0.f}; }
    }
    __device__ __forceinline__ void store(lptr lds, int tid) {
        const int row = tid >> 3, ch = tid & 7;
        *(LAS u32x4*)(lds + SB_K + ch * KCH + row * 16) = pack8(k[0], k[1]); *(LAS u32x4*)(lds + SB_V + row * SB_VS + ch * 16) = pack8(v[0], v[1]);
    }
};

#define MFMA32(a, b, c) __builtin_amdgcn_mfma_f32_32x32x16_bf16((a), (b), (c), 0, 0, 0)

template <bool SAMPLE>
__device__ __forceinline__ void da_unit(lptr lds, const Params& p, const bf16_t* zA, bf16_t* OA, int b, int h, int qblk, float lam) {
    const int tid = threadIdx.x, lane = tid & 63, r32 = lane & 31, hi = lane >> 5, wid = __builtin_amdgcn_readfirstlane(tid >> 6), c = wid & 1, sub = wid >> 1;
    const bf16_t* QA = zA; const bf16_t* KA = zA + ZSEC; const bf16_t* VA = zA + 2 * ZSEC;
    const size_t qrow = SAMPLE ? (size_t)(M_P + b * 16 + (r32 & 15)) : (size_t)(b * 2048 + qblk * 128 + sub * 32 + r32);
    bf16x8 qr[4];
#pragma unroll
    for (int d0 = 0; d0 < 4; ++d0) qr[d0] = *(const bf16x8*)(QA + qrow * 512 + h * 128 + c * 64 + d0 * 16 + hi * 8);
    const int nt = SAMPLE ? 33 : 2 * qblk + 2;
    const int ntw = SAMPLE ? (sub == 0 ? 33 : 0) : 2 * qblk + 1 + (sub >> 1);
    f32x16 o[4];
#pragma unroll
    for (int i = 0; i < 4; ++i) o[i] = f32x16{};
    float m = -1e30f, l = 0.f;
    LAS float* wsf = (LAS float*)(lds + WSF) + wid * 64;
    const int vlane = ((lane >> 4) & 1) * 32 + (lane & 3) * 8 + (4 * hi + ((lane & 15) >> 2)) * DA_VS;
    DAStage<SAMPLE> st;
    st.load(p, KA, VA, b, h, 0, tid);
    for (int t = 0; t < nt; ++t) {
        __syncthreads();
        st.store(lds, tid);
        __syncthreads();
        if (t + 1 < nt) st.load(p, KA, VA, b, h, t + 1, tid);
        if (t < ntw) {
            f32x16 p0 = f32x16{}, p1 = f32x16{};
#pragma unroll
            for (int d0 = 0; d0 < 4; ++d0) {
                lptr ka = lds + DA_K + c * KMAP + (2 * d0 + hi) * KCH + r32 * 16;
                const bf16x8 b0 = *(const LAS bf16x8*)ka, b1 = *(const LAS bf16x8*)(ka + 512);
                p0 = MFMA32(b0, qr[d0], p0); p1 = MFMA32(b1, qr[d0], p1);
            }
            if (SAMPLE && t == 32) {
#pragma unroll
                for (int r = 8; r < 16; ++r) p0[r] = -1e30f;
#pragma unroll
                for (int r = 0; r < 16; ++r) p1[r] = -1e30f;
            }
            float rm = fmaxf(p0[0], p1[0]);
#pragma unroll
            for (int r = 1; r < 16; ++r) rm = fmaxf(rm, fmaxf(p0[r], p1[r]));
            rm = fmaxf(rm, __shfl_xor(rm, 32));
            const float mn = fmaxf(m, rm);
            if (__any(mn > m)) {
                const float alpha = fexp2(m - mn); l *= alpha;
                if (hi == 0) wsf[r32] = alpha;
                asm volatile("s_waitcnt lgkmcnt(0)" ::: "memory");
                float f[16];
#pragma unroll
                for (int r = 0; r < 16; ++r) f[r] = wsf[crow(r, hi)];
#pragma unroll
                for (int d0 = 0; d0 < 4; ++d0)
#pragma unroll
                    for (int r = 0; r < 16; ++r) o[d0][r] *= f[r];
                asm volatile("s_waitcnt lgkmcnt(0)" ::: "memory");
            }
            m = mn;
            float ls = 0.f;
#pragma unroll
            for (int r = 0; r < 16; ++r) { p0[r] = fexp2(p0[r] - m); p1[r] = fexp2(p1[r] - m); ls += p0[r] + p1[r]; }
            l += ls;
            bf16x8 pw[4];
            { u32x4 w;
              w.x = cvtpk(p0[0], p0[1]); w.y = cvtpk(p0[2], p0[3]); w.z = cvtpk(p0[4], p0[5]); w.w = cvtpk(p0[6], p0[7]); pw[0] = __builtin_bit_cast(bf16x8, w);
              w.x = cvtpk(p0[8], p0[9]); w.y = cvtpk(p0[10], p0[11]); w.z = cvtpk(p0[12], p0[13]); w.w = cvtpk(p0[14], p0[15]); pw[1] = __builtin_bit_cast(bf16x8, w);
              w.x = cvtpk(p1[0], p1[1]); w.y = cvtpk(p1[2], p1[3]); w.z = cvtpk(p1[4], p1[5]); w.w = cvtpk(p1[6], p1[7]); pw[2] = __builtin_bit_cast(bf16x8, w);
              w.x = cvtpk(p1[8], p1[9]); w.y = cvtpk(p1[10], p1[11]); w.z = cvtpk(p1[12], p1[13]); w.w = cvtpk(p1[14], p1[15]); pw[3] = __builtin_bit_cast(bf16x8, w); }
#pragma unroll
            for (int d0 = 0; d0 < 4; ++d0)
#pragma unroll
                for (int ks = 0; ks < 4; ++ks) {
                    lptr va = lds + DA_V + vlane + ks * 16 * DA_VS + d0 * 64;
                    const s16x4 lo = vtr(va), hh = vtr(va + 8 * DA_VS);
                    const bf16x8 vf = (bf16x8){lo[0], lo[1], lo[2], lo[3], hh[0], hh[1], hh[2], hh[3]};
                    o[d0] = MFMA32(pw[ks], vf, o[d0]);
                }
        }
    }
    l += __shfl_xor(l, 32);
    const bool live = !SAMPLE || sub == 0;
    if (live) {
        const float fac = (c == 0) ? frcp(l) : lam * frcp(l);
        if (hi == 0) wsf[r32] = fac;
        asm volatile("s_waitcnt lgkmcnt(0)" ::: "memory");
        float f[16];
#pragma unroll
        for (int r = 0; r < 16; ++r) f[r] = wsf[crow(r, hi)];
#pragma unroll
        for (int d0 = 0; d0 < 4; ++d0)
#pragma unroll
            for (int r = 0; r < 16; ++r) o[d0][r] *= f[r];
    }
    LAS float* ex = (LAS float*)(lds + EXCH) + sub * 32 * EXS;
    if (live && c == 1) {
#pragma unroll
        for (int d0 = 0; d0 < 4; ++d0)
#pragma unroll
            for (int r = 0; r < 16; ++r) ex[crow(r, hi) * EXS + d0 * 32 + r32] = o[d0][r];
    }
    __syncthreads();
    if (live && c == 0) {
#pragma unroll
        for (int d0 = 0; d0 < 4; ++d0)
#pragma unroll
            for (int r = 0; r < 16; ++r) { LAS float* e = ex + crow(r, hi) * EXS + d0 * 32 + r32; *e = o[d0][r] - *e; }
    }
    __syncthreads();
    if (live) {
        const f32x2 g = *(const f32x2*)(p.subln_g + 2 * lane);
#pragma unroll 4
        for (int rr = 0; rr < 16; ++rr) {
            const int row = c * 16 + rr;
            const f32x2 v = *(const LAS f32x2*)(ex + row * EXS + 2 * lane);
            const float ss = wave_sum(v.x * v.x + v.y * v.y);
            const float rs = rsqrtf(ss * (1.f / 128.f) + NEPS) * 0.8f;
            const bool ok = !SAMPLE || row < 16;
            const size_t grow = SAMPLE ? (size_t)(M_P + b * 16 + row) : (size_t)(b * 2048 + qblk * 128 + sub * 32 + row);
            if (ok) *(unsigned*)(OA + grow * 512 + h * 128 + 2 * lane) = cvtpk(v.x * rs * g.x, v.y * rs * g.y);
        }
    }
}

template <bool SAMPLE>
__device__ __forceinline__ void sb_unit(lptr lds, const Params& p, const bf16_t* zA, bf16_t* OB, int b, int h, int qblk) {
    const int tid = threadIdx.x, lane = tid & 63, r32 = lane & 31, hi = lane >> 5, wid = __builtin_amdgcn_readfirstlane(tid >> 6);
    const bf16_t* QB = zA + 3 * ZSEC; const bf16_t* KB = zA + 4 * ZSEC; const bf16_t* VB = zA + 5 * ZSEC;
    const int qw = SAMPLE ? 2048 : qblk * 256 + wid * 32;
    const int qpos = SAMPLE ? 2048 + (r32 & 15) : qw + r32;
    const size_t qrow = SAMPLE ? (size_t)(M_P + b * 16 + (r32 & 15)) : (size_t)(b * 2048 + qpos);
    bf16x8 qr[4];
#pragma unroll
    for (int d0 = 0; d0 < 4; ++d0) qr[d0] = *(const bf16x8*)(QB + qrow * 512 + h * 64 + d0 * 16 + hi * 8);
    const int t_hi = SAMPLE ? 32 : 4 * qblk + 3;
    const int tw = qw >> 6;
    const bool active = !SAMPLE || wid == 0;
    f32x16 o[2]; o[0] = f32x16{}; o[1] = f32x16{};
    float R = 0.f;
    bool mydone = !active;
    LAS int* flags = (LAS int*)(lds + CTL);
    if (lane == 0) flags[wid] = mydone ? 1 : 0;
    const int vlane = ((lane >> 4) & 1) * 32 + (lane & 3) * 8 + (4 * hi + ((lane & 15) >> 2)) * SB_VS;
    SBStage<SAMPLE> st;
    st.load(p, KB, VB, b, h, t_hi, tid);
    for (int t = t_hi; t >= 0; --t) {
        __syncthreads();
        { int nd = 0;
#pragma unroll
          for (int w = 0; w < 8; ++w) nd += flags[w];
          if (nd == 8) break; }
        st.store(lds, tid);
        __syncthreads();
        if (t > 0) st.load(p, KB, VB, b, h, t - 1, tid);
        if (!mydone && t <= tw) {
            f32x16 p0 = f32x16{}, p1 = f32x16{};
#pragma unroll
            for (int d0 = 0; d0 < 4; ++d0) {
                lptr ka = lds + SB_K + (2 * d0 + hi) * KCH + r32 * 16;
                const bf16x8 b0 = *(const LAS bf16x8*)ka, b1 = *(const LAS bf16x8*)(ka + 512);
                p0 = MFMA32(b0, qr[d0], p0); p1 = MFMA32(b1, qr[d0], p1);
            }
            float x[32], lk[32];
#pragma unroll
            for (int r = 0; r < 16; ++r) { x[r] = p0[r]; x[16 + r] = p1[r]; }
            const int kb = 64 * t + 4 * hi;
#pragma unroll
            for (int i = 0; i < 32; ++i) {
                const float z = x[i];
                const float e = fexp2(-fabsf(z) * L2E);
                const float sp = fmaxf(z, 0.f) + LN2 * flog2(1.f + e);
                const bool msk = (kb + 8 * (i >> 2) + (i & 3)) < qpos;
                lk[i] = msk ? -sp : 0.f;
                x[i] = msk ? (z - sp) : -1e30f;
            }
            float gs[8], gp[8];
#pragma unroll
            for (int k = 0; k < 8; ++k) { gs[k] = (lk[4 * k] + lk[4 * k + 1]) + (lk[4 * k + 2] + lk[4 * k + 3]); gp[k] = __shfl_xor(gs[k], 32); }
            float run = R;
#pragma unroll
            for (int k = 7; k >= 0; --k) {
                const float c3 = run + (hi == 0 ? gp[k] : 0.f), c2 = c3 + lk[4 * k + 3], c1 = c2 + lk[4 * k + 2], c0 = c1 + lk[4 * k + 1];
                x[4 * k + 3] += c3; x[4 * k + 2] += c2; x[4 * k + 1] += c1; x[4 * k] += c0;
                run += gs[k] + gp[k];
            }
            R = run;
#pragma unroll
            for (int i = 0; i < 32; ++i) x[i] = fexp2(x[i] * L2E);
            bf16x8 pw[4];
#pragma unroll
            for (int ks = 0; ks < 4; ++ks) { u32x4 w; w.x = cvtpk(x[8 * ks], x[8 * ks + 1]); w.y = cvtpk(x[8 * ks + 2], x[8 * ks + 3]); w.z = cvtpk(x[8 * ks + 4], x[8 * ks + 5]); w.w = cvtpk(x[8 * ks + 6], x[8 * ks + 7]); pw[ks] = __builtin_bit_cast(bf16x8, w); }
#pragma unroll
            for (int d0 = 0; d0 < 2; ++d0)
#pragma unroll
                for (int ks = 0; ks < 4; ++ks) {
                    lptr va = lds + SB_V + vlane + ks * 16 * SB_VS + d0 * 64;
                    const s16x4 lo = vtr(va), hh = vtr(va + 8 * SB_VS);
                    const bf16x8 vf = (bf16x8){lo[0], lo[1], lo[2], lo[3], hh[0], hh[1], hh[2], hh[3]};
                    o[d0] = MFMA32(pw[ks], vf, o[d0]);
                }
            if (__all(R < SB_THR)) { mydone = true; if (lane == 0) flags[wid] = 1; }
        }
    }
    __syncthreads();
    if (active) {
#pragma unroll
        for (int d0 = 0; d0 < 2; ++d0)
#pragma unroll
            for (int r = 0; r < 16; ++r) {
                const int q = crow(r, hi);
                const bool ok = !SAMPLE || q < 16;
                const size_t grow = SAMPLE ? (size_t)(M_P + b * 16 + q) : (size_t)(b * 2048 + qw + q);
                if (ok) OB[grow * 512 + h * 64 + d0 * 32 + r32] = (bf16_t)(cvtpk(o[d0][r], 0.f) & 0xffffu);
            }
    }
}

__device__ __forceinline__ void attention_phase(lptr lds, const Params& p, unsigned* counter) {
    const int tid = threadIdx.x, lane = tid & 63;
    bf16_t* zA = (bf16_t*)(p.ws + WS_A);
    bf16_t* OA = zA + 10 * ZSEC; bf16_t* OB = zA + 11 * ZSEC;
    const float d1 = wave_sum(p.lq1[lane] * p.lk1[lane]), d2 = wave_sum(p.lq2[lane] * p.lk2[lane]);
    const float lam = expf(d1) - expf(d2) + 0.2f;
    LAS int* ctl = (LAS int*)(lds + CTL);
    for (;;) {
        __syncthreads();
        if (tid == 0) ctl[8] = (int)atomicAdd(counter, 1u);
        __syncthreads();
        int u = __builtin_amdgcn_readfirstlane(ctl[8]);
        if (u >= NUNITS) break;
        if (u < NU_DAS) { da_unit<true>(lds, p, zA, OA, u >> 2, u & 3, 0, lam); continue; }
        u -= NU_DAS;
        if (u < NU_SBS) { sb_unit<true>(lds, p, zA, OB, u >> 3, u & 7, 0); continue; }
        u -= NU_SBS;
        if (u < NU_DAP) { const int bh = u & 63; da_unit<false>(lds, p, zA, OA, bh >> 2, bh & 3, 15 - (u >> 6), lam); continue; }
        u -= NU_DAP;
        { const int bh = u & 127; sb_unit<false>(lds, p, zA, OB, bh >> 3, bh & 7, 7 - (u >> 7)); }
    }
}
#undef MFMA32
}

constexpr int LDS_BYTES = 147456;
__global__ void __launch_bounds__(512, 2) fwd_megakernel(Params p) {
    extern __shared__ __attribute__((aligned(16))) unsigned char lds_raw[];
    lptr lds = (lptr)lds_raw;
    cg::grid_group grid = cg::this_grid();
    const int tid = threadIdx.x, lane = tid & 63, wave = __builtin_amdgcn_readfirstlane(tid >> 6);
    const int G = gridDim.x, gw = blockIdx.x * 8 + wave, NGW = G * 8;
    unsigned char* ws = p.ws;
    float* rstd1 = (float*)(ws + WS_RSTD); float* ssq1 = (float*)(ws + WS_SSQ1); float* ssq2 = (float*)(ws + WS_SSQ2);
    bf16_t* WinT = (bf16_t*)(ws + WS_WIN); bf16_t* WaT = (bf16_t*)(ws + WS_WA); bf16_t* WbT = (bf16_t*)(ws + WS_WB); bf16_t* WoutT = (bf16_t*)(ws + WS_WOUT);
    bf16_t* WupT = (bf16_t*)(ws + WS_WUP); bf16_t* WdnT = (bf16_t*)(ws + WS_WDN);
    bf16_t* zA = (bf16_t*)(ws + WS_A); bf16_t* U = zA;
    bf16_t* XB = (bf16_t*)(ws + WS_B); bf16_t* MG = XB + (size_t)M_TOK * 1024; bf16_t* H = XB;
    bf16_t* X1B = (bf16_t*)(ws + WS_X1B);
    unsigned* counter = (unsigned*)(ws + WS_CTL);

    {
        if (blockIdx.x == 0 && tid == 0) *counter = 0u;
        LAS float* scr = (LAS float*)(lds + wave * 16384);
        constexpr int I_IN = 16 * 160, I_A = 8 * 32, I_O = 16 * 32, I_UP = 16 * 176, I_DN = 44 * 32, NITEMS = I_IN + 2 * I_A + I_O + I_UP + I_DN;
        for (int it = gw; it < NITEMS; it += NGW) {
            int r = it;
            if (r < I_IN) { transpose_item<true>(p.w_in, 1024, NIN, WinT, p.attn_g, scr, r, lane); continue; } r -= I_IN;
            if (r < I_A) { transpose_item<false>(p.w_a, 512, 1024, WaT, nullptr, scr, r, lane); continue; } r -= I_A;
            if (r < I_A) { transpose_item<false>(p.w_b, 512, 1024, WbT, nullptr, scr, r, lane); continue; } r -= I_A;
            if (r < I_O) { transpose_item<false>(p.w_out, 1024, 1024, WoutT, nullptr, scr, r, lane); continue; } r -= I_O;
            if (r < I_UP) { transpose_item<false>(p.w_up, 1024, NUP, WupT, p.ffn_g, scr, r, lane); continue; } r -= I_UP;
            transpose_item<false>(p.w_down, DFF, 1024, WdnT, nullptr, scr, r, lane);
        }
        for (int row = gw; row < M_TOK; row += NGW) {
            const float* xr = row < M_P ? p.x_prompt + (size_t)row * 1024 : p.x_sample + (size_t)(row - M_P) * 1024;
            f32x4 v[4]; float s = 0.f;
#pragma unroll
            for (int j = 0; j < 4; ++j) { v[j] = *(const f32x4*)(xr + 4 * lane + 256 * j); s += (v[j][0] * v[j][0] + v[j][1] * v[j][1]) + (v[j][2] * v[j][2] + v[j][3] * v[j][3]); }
            s = wave_sum(s);
            if (lane == 0) rstd1[row] = rsqrtf(s * (1.f / 1024.f) + NEPS);
#pragma unroll
            for (int j = 0; j < 4; ++j) { u32x2 w; w.x = cvtpk(v[j][0], v[j][1]); w.y = cvtpk(v[j][2], v[j][3]); *(u32x2*)(XB + (size_t)row * 1024 + 4 * lane + 256 * j) = w; }
        }
    }
    grid.sync();
    {
        pg8::Gemm g{XB, WinT, M_TOK, NIN, 1024}; pg8::StaticOrder S; S.init(M_TOK, NIN, G, (int)blockIdx.x);
        EpiIn E{rstd1, zA, p.out};
        pg8::gemm_phase<EpiIn, pg8::StaticOrder, true, true>(lds, g, S, E);
    }
    grid.sync();
    att::attention_phase(lds, p, counter);
    grid.sync();
    {
        pg8::Gemm g{zA + 10 * ZSEC, WaT, M_TOK, 1024, 512}; pg8::StaticOrder S; S.init(M_TOK, 1024, G, (int)blockIdx.x);
        EpiMerge<true> E{zA + 6 * ZSEC, MG};
        pg8::gemm_phase<EpiMerge<true>, pg8::StaticOrder, true, true>(lds, g, S, E);
    }
    {
        pg8::Gemm g{zA + 11 * ZSEC, WbT, M_TOK, 1024, 512}; pg8::StaticOrder S; S.init(M_TOK, 1024, G, (int)blockIdx.x);
        EpiMerge<false> E{zA + 8 * ZSEC, MG};
        pg8::gemm_phase<EpiMerge<false>, pg8::StaticOrder, true, true>(lds, g, S, E);
    }
    grid.sync();
    {
        pg8::Gemm g{MG, WoutT, M_TOK, 1024, 1024}; pg8::StaticOrder S; S.init(M_TOK, 1024, G, (int)blockIdx.x);
        EpiRes<true> E{p.x_prompt, p.x_sample, p.out + O_Y, X1B, ssq1};
        pg8::gemm_phase<EpiRes<true>, pg8::StaticOrder, true, true>(lds, g, S, E);
    }
    grid.sync();
    {
        pg8::Gemm g{X1B, WupT, M_TOK, NUP, 1024}; pg8::StaticOrder S; S.init(M_TOK, NUP, G, (int)blockIdx.x);
        EpiUp E{ssq1, U, p.out};
        pg8::gemm_phase<EpiUp, pg8::StaticOrder, true, true>(lds, g, S, E);
    }
    grid.sync();
    {
        constexpr int NCH = DFF / 8, TOTAL = (M_TOK / 16) * NCH;
        for (int it = blockIdx.x * 512 + tid; it < TOTAL; it += G * 512) {
            const int run = it / NCH, ch = it - run * NCH, row0 = run * 16, j0 = ch * 8;
            const bool samp = row0 >= M_P; const int t0 = samp ? 0 : (row0 & 2047);
            float wg[3][8], wv[3][8], bg[8], bv[8];
#pragma unroll
            for (int j = 0; j < 3; ++j)
#pragma unroll
                for (int e = 0; e < 8; ++e) { wg[j][e] = p.conv_w[j * NUP + j0 + e]; wv[j][e] = p.conv_w[j * NUP + DFF + j0 + e]; }
#pragma unroll
            for (int e = 0; e < 8; ++e) { bg[e] = p.conv_b[j0 + e]; bv[e] = p.conv_b[DFF + j0 + e]; }
            f32x4 g2[2], g1[2], v2[2], v1[2];
            if (t0 == 0) {
                if (samp) { const float* sc = p.state_conv + (size_t)((row0 - M_P) >> 4) * 2 * NUP;
                    g2[0] = *(const f32x4*)(sc + j0); g2[1] = *(const f32x4*)(sc + j0 + 4); v2[0] = *(const f32x4*)(sc + DFF + j0); v2[1] = *(const f32x4*)(sc + DFF + j0 + 4);
                    g1[0] = *(const f32x4*)(sc + NUP + j0); g1[1] = *(const f32x4*)(sc + NUP + j0 + 4); v1[0] = *(const f32x4*)(sc + NUP + DFF + j0); v1[1] = *(const f32x4*)(sc + NUP + DFF + j0 + 4);
                } else { g2[0] = g2[1] = g1[0] = g1[1] = v2[0] = v2[1] = v1[0] = v1[1] = (f32x4){0.f, 0.f, 0.f, 0.f}; }
            } else {
                att::expand8(*(const u32x4*)(U + (size_t)(row0 - 2) * NUP + j0), g2[0], g2[1]); att::expand8(*(const u32x4*)(U + (size_t)(row0 - 2) * NUP + DFF + j0), v2[0], v2[1]);
                att::expand8(*(const u32x4*)(U + (size_t)(row0 - 1) * NUP + j0), g1[0], g1[1]); att::expand8(*(const u32x4*)(U + (size_t)(row0 - 1) * NUP + DFF + j0), v1[0], v1[1]);
            }
#pragma unroll 4
            for (int r = 0; r < 16; ++r) {
                f32x4 g0[2], v0[2];
                att::expand8(*(const u32x4*)(U + (size_t)(row0 + r) * NUP + j0), g0[0], g0[1]); att::expand8(*(const u32x4*)(U + (size_t)(row0 + r) * NUP + DFF + j0), v0[0], v0[1]);
                f32x4 hh[2];
#pragma unroll
                for (int q = 0; q < 2; ++q)
#pragma unroll
                    for (int e = 0; e < 4; ++e) {
                        const int i = 4 * q + e;
                        const float cgt = bg[i] + wg[0][i] * g2[q][e] + wg[1][i] * g1[q][e] + wg[2][i] * g0[q][e];
                        const float cvl = bv[i] + wv[0][i] * v2[q][e] + wv[1][i] * v1[q][e] + wv[2][i] * v0[q][e];
                        hh[q][e] = cgt * sigmoidf_(cgt) * cvl;
                    }
                *(u32x4*)(H + (size_t)(row0 + r) * DFF + j0) = pack8(hh[0], hh[1]);
                g2[0] = g1[0]; g2[1] = g1[1]; v2[0] = v1[0]; v2[1] = v1[1]; g1[0] = g0[0]; g1[1] = g0[1]; v1[0] = v0[0]; v1[1] = v0[1];
            }
        }
    }
    grid.sync();
    {
        pg8::Gemm g{H, WdnT, M_TOK, 1024, DFF}; pg8::StaticOrder S; S.init(M_TOK, 1024, G, (int)blockIdx.x);
        EpiRes<false> E{p.out + O_Y, p.out + O_Y + (size_t)M_P * 1024, p.out + O_Y, nullptr, ssq2};
        pg8::gemm_phase<EpiRes<false>, pg8::StaticOrder, true, true>(lds, g, S, E);
    }
    grid.sync();
    for (int row = gw; row < M_TOK; row += NGW) {
        const f32x4* sp = (const f32x4*)(ssq2 + (size_t)row * 16);
        const f32x4 s0 = sp[0], s1 = sp[1], s2 = sp[2], s3 = sp[3];
        const float tot = ((s0[0] + s0[1]) + (s0[2] + s0[3])) + ((s1[0] + s1[1]) + (s1[2] + s1[3])) + ((s2[0] + s2[1]) + (s2[2] + s2[3])) + ((s3[0] + s3[1]) + (s3[2] + s3[3]));
        const float rs = rsqrtf(tot * (1.f / 1024.f) + NEPS);
        float* yr = p.out + O_Y + (size_t)row * 1024;
#pragma unroll
        for (int j = 0; j < 4; ++j) { const int c = 4 * lane + 256 * j; const f32x4 g = *(const f32x4*)(p.final_g + c); f32x4 v = *(const f32x4*)(yr + c); v = v * rs * g; *(f32x4*)(yr + c) = v; }
    }
}

extern "C" void kernel_launch(void* const* d_in, const int* in_sizes, int n_in, void* d_out, int out_size, void* d_ws, size_t ws_size, hipStream_t stream) {
    static int grid = 0;
    if (grid == 0) {
        if (n_in != 23 || (size_t)out_size != O_END || ws_size < WS_END) { fprintf(stderr, "kernel_launch: unexpected sizes n_in %d out %d ws %zu (need %zu)\n", n_in, out_size, ws_size, (size_t)WS_END); grid = -1; return; }
        int dev = 0, cus = 0, per_cu = 0;
        hipGetDevice(&dev); hipDeviceGetAttribute(&cus, hipDeviceAttributeMultiprocessorCount, dev);
        if (hipFuncSetAttribute((const void*)fwd_megakernel, hipFuncAttributeMaxDynamicSharedMemorySize, LDS_BYTES) != hipSuccess) { fprintf(stderr, "kernel_launch: hipFuncSetAttribute failed\n"); grid = -1; return; }
        if (hipOccupancyMaxActiveBlocksPerMultiprocessor(&per_cu, (const void*)fwd_megakernel, 512, LDS_BYTES) != hipSuccess || per_cu < 1) { fprintf(stderr, "kernel_launch: occupancy query says %d\n", per_cu); per_cu = 1; }
        (void)hipGetLastError();
        grid = cus * 1;
    }
    if (grid < 0) return;
    Params p{};
    p.x_prompt = (const float*)d_in[0]; p.x_sample = (const float*)d_in[1]; p.cdk = (const float*)d_in[2]; p.cdv = (const float*)d_in[3]; p.csk = (const float*)d_in[4]; p.csv = (const float*)d_in[5];
    p.state_conv = (const float*)d_in[6]; p.attn_g = (const float*)d_in[7]; p.w_in = (const float*)d_in[8]; p.lq1 = (const float*)d_in[9]; p.lk1 = (const float*)d_in[10]; p.lq2 = (const float*)d_in[11];
    p.lk2 = (const float*)d_in[12]; p.subln_g = (const float*)d_in[13]; p.w_a = (const float*)d_in[14]; p.w_b = (const float*)d_in[15]; p.w_out = (const float*)d_in[16]; p.ffn_g = (const float*)d_in[17];
    p.w_up = (const float*)d_in[18]; p.conv_w = (const float*)d_in[19]; p.conv_b = (const float*)d_in[20]; p.w_down = (const float*)d_in[21]; p.final_g = (const float*)d_in[22];
    p.out = (float*)d_out; p.ws = (unsigned char*)d_ws;
    void* args[] = {&p};
    hipError_t e = hipLaunchCooperativeKernel((const void*)fwd_megakernel, dim3(grid), dim3(512), args, LDS_BYTES, stream);
    if (e != hipSuccess) fprintf(stderr, "cooperative launch failed: %s (grid %d)\n", hipGetErrorString(e), grid);
}
```

```cpp
#include <hip/hip_runtime.h>
#include <hip/hip_cooperative_groups.h>
#include <cstdio>
#include <cstdint>
namespace cg = cooperative_groups;
namespace pg8 {
#define PG8_LAS __attribute__((address_space(3)))
typedef unsigned short bf16_t;
typedef short bf16x8 __attribute__((ext_vector_type(8)));
typedef float f32x4 __attribute__((ext_vector_type(4)));
typedef unsigned u32x4 __attribute__((ext_vector_type(4)));
constexpr int BM = 256, BK = 64, HALF = 128, HTB = HALF * BK * 2  , STAGE_BYTES = 8 * HTB, NXCD = 8, WGM = 8;

__host__ __device__ __forceinline__ int lds_byte(int r, int c) { const int st = (r >> 4) * 2 + (c >> 5), rr = r & 15, cc = c & 31, ob = rr * 64 + cc * 2; return st * 1024 + (ob ^ (((ob >> 9) & 1) << 5)); }
__host__ __device__ __forceinline__ void stage_rc(int b, int& R, int& C) { const int st = b / 1024, sb = b % 1024, swz = sb ^ (((sb >> 9) & 1) << 5); R = (st >> 1) * 16 + swz / 64; C = (st & 1) * 32 + (swz % 64) / 2; }
__host__ __device__ __forceinline__ int perm32(int rho) { const int n = rho >> 4, i = rho & 15; return 8 * (i >> 2) + 4 * n + (i & 3); }

struct Unit { int pm, pn; };
struct Gemm { const bf16_t* A; const bf16_t* Bt; int M, N, K; };

struct StaticOrder {
    int nM, nN, nwg, G, c;
    __host__ __device__ void init(int M, int N, int G_, int c_) { nM = M / BM; nN = N / BM; nwg = nM * nN; G = G_; c = c_; }
    __host__ __device__ bool next(int i, Unit& u) const {
        const long L = (long)i * G + c; if (L >= nwg) return false;
        int wgid = (int)L; { const int q = nwg / NXCD, r = nwg % NXCD, xcd = wgid % NXCD, off = wgid / NXCD; wgid = (xcd < r ? xcd * (q + 1) : r * (q + 1) + (xcd - r) * q) + off; }
        const int nig = WGM * nN, gid = wgid / nig, fm = gid * WGM, gsz = (nM - fm) < WGM ? (nM - fm) : WGM;
        u.pm = fm + ((wgid % nig) % gsz); u.pn = (wgid % nig) / gsz; return true;
    }
    __device__ __forceinline__ void a_ready(const Unit&) const {}
    __device__ __forceinline__ void done(const Unit&) const {}
};

__device__ __forceinline__ unsigned cvt_pk_bf16(float lo, float hi) { unsigned r; asm volatile("v_cvt_pk_bf16_f32 %0, %1, %2" : "=v"(r) : "v"(lo), "v"(hi)); return r; }
typedef float f32x2 __attribute__((ext_vector_type(2)));
template <class Epi, class Sched, bool ALIGN_EPI = false, bool SP2 = false>
__device__ __forceinline__ void gemm_phase(PG8_LAS unsigned char* lds, const Gemm g, const Sched& S, const Epi& E) {
    const int tid = threadIdx.x, wid = __builtin_amdgcn_readfirstlane(tid >> 6), lane = tid & 63, wr = wid >> 2, wc = wid & 3, fr = lane & 15, fq = lane >> 4;
    const int K = g.K, nt = K / BK;
    unsigned voffA[2], voffB[2];
#pragma unroll
    for (int i = 0; i < 2; ++i) { int R, C; stage_rc(tid * 16 + i * 8192, R, C); const int Rb = Epi::PERM ? ((R & ~31) + perm32(R & 31)) : R;
        voffA[i] = (unsigned)(R * K + C) * 2u; voffB[i] = (unsigned)(Rb * K + C) * 2u; }
    const size_t kstep = (size_t)(BK * 2);
    const size_t hstep = (size_t)HALF * K * 2;
    const size_t tstep = 2 * hstep;
    const unsigned ldsw = (unsigned)wid * 1024u;
    const int aoff = lds_byte(wr * 64 + fr, fq * 8), boff = lds_byte(wc * 32 + fr, fq * 8);
#define PG8_SA(b, h) (((b) * 2 + (h)) * HTB)
#define PG8_SB(b, h) ((4 + (b) * 2 + (h)) * HTB)
#define PG8_STAGE(bufoff, gbase, voff) do { _Pragma("unroll") for (int _i = 0; _i < 2; ++_i) \
        __builtin_amdgcn_global_load_lds((const unsigned*)((const char*)(gbase) + (voff)[_i]), (PG8_LAS unsigned*)(lds + (bufoff) + ldsw + _i * 8192), 16, 0, 0); } while (0)
#define PG8_LDA(dst, b, h) do { _Pragma("unroll") for (int m = 0; m < 4; ++m) _Pragma("unroll") for (int k = 0; k < 2; ++k) dst[m][k] = *(const PG8_LAS bf16x8*)(lds + PG8_SA(b, h) + aoff + m * 2048 + k * 1024); } while (0)
#define PG8_LDB(dst, b, h) do { _Pragma("unroll") for (int n = 0; n < 2; ++n) _Pragma("unroll") for (int k = 0; k < 2; ++k) dst[n][k] = *(const PG8_LAS bf16x8*)(lds + PG8_SB(b, h) + boff + n * 2048 + k * 1024); } while (0)
#define PG8_MMA(ai, bj, At, Bt) do { __builtin_amdgcn_s_setprio(1); _Pragma("unroll") for (int m = 0; m < 4; ++m) _Pragma("unroll") for (int n = 0; n < 2; ++n) _Pragma("unroll") for (int k = 0; k < 2; ++k) \
        acc[ai][bj][m][n] = __builtin_amdgcn_mfma_f32_16x16x32_bf16(Bt[n][k], At[m][k], acc[ai][bj][m][n], 0, 0, 0); __builtin_amdgcn_s_setprio(0); } while (0)
#define PG8_WAIT_V(n) asm volatile("s_waitcnt vmcnt(" #n ")" ::: "memory")
#define PG8_WAIT_L(n) asm volatile("s_waitcnt lgkmcnt(" #n ")" ::: "memory")
#define PG8_BAR __builtin_amdgcn_s_barrier()
#define PG8_SCHED __builtin_amdgcn_sched_barrier(0)
    Unit cur, nxt; int ui = 0;
    if (!S.next(0, cur)) return;
    f32x4 acc[2][2][4][2];
#pragma unroll
    for (int a = 0; a < 2; ++a)
#pragma unroll
        for (int b = 0; b < 2; ++b)
#pragma unroll
            for (int m = 0; m < 4; ++m)
#pragma unroll
                for (int n = 0; n < 2; ++n) acc[a][b][m][n] = (f32x4){0.f, 0.f, 0.f, 0.f};
    bf16x8 At[4][2], B0[2][2], B1[2][2];
    const char* cA = (const char*)g.A + (size_t)cur.pm * tstep; const char* cB = (const char*)g.Bt + (size_t)cur.pn * tstep;
    S.a_ready(cur);
    if constexpr (SP2) {
        PG8_STAGE(PG8_SB(0, 0), cB, voffB); PG8_STAGE(PG8_SB(0, 1), cB + hstep, voffB); PG8_STAGE(PG8_SA(0, 0), cA, voffA); PG8_STAGE(PG8_SA(0, 1), cA + hstep, voffA);
        if (wr == 1) PG8_BAR;
        PG8_WAIT_V(2); PG8_BAR;
        PG8_STAGE(PG8_SB(1, 0), cB + kstep, voffB); PG8_STAGE(PG8_SA(1, 0), cA + kstep, voffA); PG8_STAGE(PG8_SB(1, 1), cB + hstep + kstep, voffB);
        PG8_WAIT_V(6); PG8_BAR;
    } else {
        PG8_STAGE(PG8_SB(0, 0), cB, voffB); PG8_STAGE(PG8_SA(0, 0), cA, voffA); PG8_STAGE(PG8_SB(0, 1), cB + hstep, voffB); PG8_STAGE(PG8_SA(0, 1), cA + hstep, voffA);
        if (wr == 1) PG8_BAR;
        PG8_WAIT_V(4); PG8_BAR;
        PG8_STAGE(PG8_SB(1, 0), cB + kstep, voffB); PG8_STAGE(PG8_SA(1, 0), cA + kstep, voffA); PG8_STAGE(PG8_SB(1, 1), cB + hstep + kstep, voffB);
        PG8_WAIT_V(6); PG8_BAR;
    }
    for (;;) {
        const bool has_next = S.next(ui + 1, nxt);
        const char* nA = has_next ? (const char*)g.A + (size_t)nxt.pm * tstep : cA; const char* nB = has_next ? (const char*)g.Bt + (size_t)nxt.pn * tstep : cB;
        for (int t = 0; t < nt; t += 2) {
            const bool last = (t == nt - 2);
            const char* a1 = cA + (size_t)(t + 1) * kstep;
            const char* a2 = last ? nA : cA + (size_t)(t + 2) * kstep; const char* b2 = last ? nB : cB + (size_t)(t + 2) * kstep;
            const char* a3 = a2 + kstep; const char* b3 = b2 + kstep;
            if (last && has_next) S.a_ready(nxt);
            if constexpr (SP2) {
            PG8_LDB(B0, 0, 0); PG8_LDB(B1, 0, 1); PG8_SCHED; PG8_LDA(At, 0, 0); PG8_STAGE(PG8_SA(1, 1), a1 + hstep, voffA);
            PG8_WAIT_V(8); PG8_WAIT_L(0); PG8_BAR; PG8_MMA(0, 0, At, B0); PG8_MMA(0, 1, At, B1); PG8_BAR; PG8_SCHED;
            PG8_LDA(At, 0, 1); PG8_STAGE(PG8_SB(0, 0), b2, voffB); PG8_STAGE(PG8_SB(0, 1), b2 + hstep, voffB); PG8_STAGE(PG8_SA(0, 0), a2, voffA);
            PG8_WAIT_V(8); PG8_WAIT_L(0); PG8_BAR; PG8_MMA(1, 0, At, B0); PG8_MMA(1, 1, At, B1); PG8_BAR; PG8_SCHED;
            PG8_LDB(B0, 1, 0); PG8_LDB(B1, 1, 1); PG8_SCHED; PG8_LDA(At, 1, 0); PG8_STAGE(PG8_SA(0, 1), a2 + hstep, voffA);
            PG8_WAIT_V(8); PG8_WAIT_L(0); PG8_BAR; PG8_MMA(0, 0, At, B0); PG8_MMA(0, 1, At, B1); PG8_BAR; PG8_SCHED;
            PG8_LDA(At, 1, 1); PG8_STAGE(PG8_SB(1, 0), b3, voffB); PG8_STAGE(PG8_SB(1, 1), b3 + hstep, voffB); PG8_STAGE(PG8_SA(1, 0), a3, voffA);
            PG8_WAIT_V(8); PG8_WAIT_L(0); PG8_BAR; PG8_MMA(1, 0, At, B0); PG8_MMA(1, 1, At, B1); PG8_BAR; PG8_SCHED;
            } else {
            PG8_LDB(B0, 0, 0); PG8_SCHED; PG8_LDA(At, 0, 0); PG8_STAGE(PG8_SA(1, 1), a1 + hstep, voffA);
            PG8_WAIT_L(8); PG8_BAR; PG8_WAIT_L(0); PG8_MMA(0, 0, At, B0); PG8_BAR; PG8_SCHED;
            PG8_LDB(B1, 0, 1); PG8_STAGE(PG8_SB(0, 0), b2, voffB);
            PG8_BAR; PG8_WAIT_L(0); PG8_MMA(0, 1, At, B1); PG8_BAR;
            PG8_LDA(At, 0, 1); PG8_STAGE(PG8_SA(0, 0), a2, voffA);
            PG8_BAR; PG8_WAIT_L(0); PG8_MMA(1, 0, At, B0); PG8_BAR; PG8_SCHED;
            PG8_STAGE(PG8_SB(0, 1), b2 + hstep, voffB);
            PG8_WAIT_V(6); PG8_BAR; PG8_MMA(1, 1, At, B1); PG8_BAR;
            PG8_LDB(B0, 1, 0); PG8_SCHED; PG8_LDA(At, 1, 0); PG8_STAGE(PG8_SA(0, 1), a2 + hstep, voffA);
            PG8_WAIT_L(8); PG8_BAR; PG8_WAIT_L(0); PG8_MMA(0, 0, At, B0); PG8_BAR; PG8_SCHED;
            PG8_LDB(B1, 1, 1); PG8_STAGE(PG8_SB(1, 0), b3, voffB);
            PG8_BAR; PG8_WAIT_L(0); PG8_MMA(0, 1, At, B1); PG8_BAR;
            PG8_LDA(At, 1, 1); PG8_STAGE(PG8_SA(1, 0), a3, voffA);
            PG8_BAR; PG8_WAIT_L(0); PG8_MMA(1, 0, At, B0); PG8_BAR; PG8_SCHED;
            PG8_STAGE(PG8_SB(1, 1), b3 + hstep, voffB);
            PG8_WAIT_V(6); PG8_BAR; PG8_MMA(1, 1, At, B1); PG8_BAR;
            }
        }
        if constexpr (ALIGN_EPI) { if (wr == 0) PG8_BAR; }
        if constexpr (!Epi::AFTER_DRAIN) { E(acc, cur, wr, wc, fr, fq); S.done(cur); }
        if (!has_next) break;
#pragma unroll
        for (int a = 0; a < 2; ++a)
#pragma unroll
            for (int b = 0; b < 2; ++b)
#pragma unroll
                for (int m = 0; m < 4; ++m)
#pragma unroll
                    for (int n = 0; n < 2; ++n) acc[a][b][m][n] = (f32x4){0.f, 0.f, 0.f, 0.f};
        cur = nxt; cA = nA; cB = nB; ++ui;
        if constexpr (ALIGN_EPI) { if (wr == 1) PG8_BAR; }
    }
    PG8_WAIT_V(0);
    if constexpr (!ALIGN_EPI) { if (wr == 0) PG8_BAR; }
    PG8_BAR;
    if constexpr (Epi::AFTER_DRAIN) { E.fused(acc, cur, wr, wc, fr, fq, lds, wid, lane); S.done(cur); }
#undef PG8_SA
#undef PG8_SB
#undef PG8_STAGE
#undef PG8_LDA
#undef PG8_LDB
#undef PG8_MMA
#undef PG8_WAIT_V
#undef PG8_WAIT_L
#undef PG8_BAR
#undef PG8_SCHED
}
}

#define LAS __attribute__((address_space(3)))
typedef LAS unsigned char* lptr;
typedef unsigned short bf16_t;
typedef float f32x4 __attribute__((ext_vector_type(4)));
typedef float f32x2 __attribute__((ext_vector_type(2)));
typedef float f32x16 __attribute__((ext_vector_type(16)));
typedef unsigned u32x4 __attribute__((ext_vector_type(4)));
typedef unsigned u32x2 __attribute__((ext_vector_type(2)));
typedef short bf16x8 __attribute__((ext_vector_type(8)));
typedef short s16x4 __attribute__((ext_vector_type(4)));
typedef short v4i16_t __attribute__((ext_vector_type(4)));

constexpr int M_TOK = 33280, M_P = 32768, DM = 1024, NIN = 5120, DFF = 2816, NUP = 5632;
constexpr float L2E = 1.4426950408889634f, LN2 = 0.6931471805599453f, NEPS = 1e-6f;
constexpr size_t O_Y = 0, O_PDK = 34078720, O_PDV = O_PDK + 16777216, O_PSK = O_PDV + 16777216, O_PSV = O_PSK + 16777216,
                 O_PCONV = O_PSV + 16777216, O_SDK = O_PCONV + 180224, O_SDV = O_SDK + 262144, O_SSK = O_SDV + 262144, O_SSV = O_SSK + 262144,
                 O_SCONV = O_SSV + 262144, O_END = O_SCONV + 360448;
constexpr size_t WS_CTL = 0, WS_RSTD = 16384, WS_SSQ1 = WS_RSTD + 133120, WS_SSQ2 = WS_SSQ1 + 2129920, WS_WIN = WS_SSQ2 + 2129920,
                 WS_WA = WS_WIN + 10485760, WS_WB = WS_WA + 1048576, WS_WOUT = WS_WB + 1048576, WS_WUP = WS_WOUT + 2097152,
                 WS_WDN = WS_WUP + 11534336, WS_A = WS_WDN + 5767168, WS_B = WS_A + 408944640, WS_X1B = WS_B + 187432960, WS_END = WS_X1B + 68157440;
constexpr size_t ZSEC = (size_t)M_TOK * 512;

struct Params {
    const float* x_prompt; const float* x_sample; const float* cdk; const float* cdv; const float* csk; const float* csv; const float* state_conv;
    const float* attn_g; const float* w_in; const float* lq1; const float* lk1; const float* lq2; const float* lk2; const float* subln_g;
    const float* w_a; const float* w_b; const float* w_out; const float* ffn_g; const float* w_up; const float* conv_w; const float* conv_b;
    const float* w_down; const float* final_g; float* out; unsigned char* ws;
};

__device__ __forceinline__ float bflo(unsigned w) { return __uint_as_float(w << 16); }
__device__ __forceinline__ float bfhi(unsigned w) { return __uint_as_float(w & 0xffff0000u); }
__device__ __forceinline__ unsigned cvtpk(float lo, float hi) { unsigned r; asm volatile("v_cvt_pk_bf16_f32 %0, %1, %2" : "=v"(r) : "v"(lo), "v"(hi)); return r; }
__device__ __forceinline__ u32x4 pack8(f32x4 a, f32x4 b) { u32x4 w; w.x = cvtpk(a[0], a[1]); w.y = cvtpk(a[2], a[3]); w.z = cvtpk(b[0], b[1]); w.w = cvtpk(b[2], b[3]); return w; }
__device__ __forceinline__ float wave_sum(float v) {
#pragma unroll
    for (int o = 1; o < 64; o <<= 1) v += __shfl_xor(v, o);
    return v;
}
__device__ __forceinline__ float fexp2(float x) { return __builtin_amdgcn_exp2f(x); }
__device__ __forceinline__ float flog2(float x) { return __builtin_amdgcn_logf(x); }
__device__ __forceinline__ float frcp(float x) { return __builtin_amdgcn_rcpf(x); }
__device__ __forceinline__ float sigmoidf_(float x) { return frcp(1.f + fexp2(-x * L2E)); }

struct EpiIn {
    static constexpr bool PERM = true, AFTER_DRAIN = false;
    const float* rstd; bf16_t* z; float* out;
    __device__ __forceinline__ void operator()(const pg8::f32x4 (&acc)[2][2][4][2], const pg8::Unit& u, int wr, int wc, int fr, int fq) const {
        const int pn = u.pn; const bool samp = u.pm >= 128;
        bf16_t* zb; int ld, tcol; float* fo = nullptr; float sc = 1.f; int mode = 0;
        if (pn < 12) {
            const int sec = pn >> 1; zb = z + (size_t)sec * ZSEC; ld = 512; tcol = (pn & 1) * 256;
            if (sec < 2) mode = 1;
            if (sec == 0) sc = 0.125f * L2E; else if (sec == 3) sc = 0.125f;
            if (sec == 1) fo = out + (samp ? O_SDK : O_PDK); else if (sec == 2) fo = out + (samp ? O_SDV : O_PDV);
            else if (sec == 4) fo = out + (samp ? O_SSK : O_PSK); else if (sec == 5) fo = out + (samp ? O_SSV : O_PSV);
        } else { const int gs = (pn - 12) >> 2; zb = z + (size_t)(6 + 2 * gs) * ZSEC; ld = 1024; tcol = ((pn - 12) & 3) * 256; mode = 2; }
        const int cb = tcol + wc * 64 + fq * 8;
        float ir[2][4];
#pragma unroll
        for (int n = 0; n < 2; ++n)
#pragma unroll
            for (int e = 0; e < 4; ++e) ir[n][e] = exp2f(-(float)(8 * fq + 4 * n + e) * (13.287712379549449f / 32.f)) * 0.15915494309189535f;
#pragma unroll
        for (int ai = 0; ai < 2; ++ai)
#pragma unroll
            for (int m = 0; m < 4; ++m) {
                const int row = u.pm * 256 + ai * 128 + wr * 64 + m * 16 + fr;
                const float rs = rstd[row] * sc;
                f32x4 v[2][2];
#pragma unroll
                for (int bj = 0; bj < 2; ++bj)
#pragma unroll
                    for (int n = 0; n < 2; ++n) v[bj][n] = acc[ai][bj][m][n] * rs;
                if (mode == 1) {
                    const float pos = samp ? (float)(2048 + (row & 15)) : (float)(row & 2047);
#pragma unroll
                    for (int n = 0; n < 2; ++n)
#pragma unroll
                        for (int e = 0; e < 4; ++e) {
                            float rev = pos * ir[n][e]; rev -= rintf(rev);
                            const float sn = __builtin_amdgcn_sinf(rev), cs = __builtin_amdgcn_cosf(rev);
                            const float x1 = v[0][n][e], x2 = v[1][n][e];
                            v[0][n][e] = x1 * cs - x2 * sn; v[1][n][e] = x2 * cs + x1 * sn;
                        }
                } else if (mode == 2) {
#pragma unroll
                    for (int bj = 0; bj < 2; ++bj)
#pragma unroll
                        for (int n = 0; n < 2; ++n)
#pragma unroll
                            for (int e = 0; e < 4; ++e) v[bj][n][e] = sigmoidf_(v[bj][n][e]);
                }
                const size_t rl = samp ? (size_t)(row - M_P) : (size_t)row;
#pragma unroll
                for (int bj = 0; bj < 2; ++bj) {
                    *(u32x4*)(zb + (size_t)row * ld + cb + 32 * bj) = pack8(v[bj][0], v[bj][1]);
                    if (fo) { float* d = fo + rl * 512 + cb + 32 * bj; *(f32x4*)d = v[bj][0]; *(f32x4*)(d + 4) = v[bj][1]; }
                }
            }
    }
};
template <bool FIRST> struct EpiMerge {
    static constexpr bool PERM = true, AFTER_DRAIN = false;
    const bf16_t* gate; bf16_t* mg;
    __device__ __forceinline__ void operator()(const pg8::f32x4 (&acc)[2][2][4][2], const pg8::Unit& u, int wr, int wc, int fr, int fq) const {
#pragma unroll
        for (int ai = 0; ai < 2; ++ai)
#pragma unroll
            for (int m = 0; m < 4; ++m) {
                const int row = u.pm * 256 + ai * 128 + wr * 64 + m * 16 + fr;
#pragma unroll
                for (int bj = 0; bj < 2; ++bj) {
                    const size_t off = (size_t)row * 1024 + u.pn * 256 + bj * 128 + wc * 32 + fq * 8;
                    const u32x4 g = *(const u32x4*)(gate + off);
                    f32x4 a = acc[ai][bj][m][0], b = acc[ai][bj][m][1];
                    a[0] *= bflo(g.x); a[1] *= bfhi(g.x); a[2] *= bflo(g.y); a[3] *= bfhi(g.y);
                    b[0] *= bflo(g.z); b[1] *= bfhi(g.z); b[2] *= bflo(g.w); b[3] *= bfhi(g.w);
                    if (!FIRST) { const u32x4 o = *(const u32x4*)(mg + off);
                        a[0] += bflo(o.x); a[1] += bfhi(o.x); a[2] += bflo(o.y); a[3] += bfhi(o.y);
                        b[0] += bflo(o.z); b[1] += bfhi(o.z); b[2] += bflo(o.w); b[3] += bfhi(o.w); }
                    *(u32x4*)(mg + off) = pack8(a, b);
                }
            }
    }
};
template <bool WRITE_BF> struct EpiRes {
    static constexpr bool PERM = true, AFTER_DRAIN = false;
    const float* base_p; const float* base_s; float* y; bf16_t* yb; float* ssq;
    __device__ __forceinline__ void operator()(const pg8::f32x4 (&acc)[2][2][4][2], const pg8::Unit& u, int wr, int wc, int fr, int fq) const {
        const bool samp = u.pm >= 128;
#pragma unroll
        for (int ai = 0; ai < 2; ++ai)
#pragma unroll
            for (int m = 0; m < 4; ++m) {
                const int row = u.pm * 256 + ai * 128 + wr * 64 + m * 16 + fr;
                const float* brow = samp ? base_s + (size_t)(row - M_P) * 1024 : base_p + (size_t)row * 1024;
                float s = 0.f;
#pragma unroll
                for (int bj = 0; bj < 2; ++bj) {
                    const int col = u.pn * 256 + bj * 128 + wc * 32 + fq * 8;
                    f32x4 a = acc[ai][bj][m][0] + *(const f32x4*)(brow + col), b = acc[ai][bj][m][1] + *(const f32x4*)(brow + col + 4);
                    s += (a[0] * a[0] + a[1] * a[1]) + (a[2] * a[2] + a[3] * a[3]) + (b[0] * b[0] + b[1] * b[1]) + (b[2] * b[2] + b[3] * b[3]);
                    float* d = y + (size_t)row * 1024 + col; *(f32x4*)d = a; *(f32x4*)(d + 4) = b;
                    if (WRITE_BF) *(u32x4*)(yb + (size_t)row * 1024 + col) = pack8(a, b);
                }
                s += __shfl_xor(s, 16); s += __shfl_xor(s, 32);
                if (fq == 0) ssq[(size_t)row * 16 + u.pn * 4 + wc] = s;
            }
    }
};
struct EpiUp {
    static constexpr bool PERM = true, AFTER_DRAIN = false;
    const float* ssq; bf16_t* U; float* out;
    __device__ __forceinline__ void operator()(const pg8::f32x4 (&acc)[2][2][4][2], const pg8::Unit& u, int wr, int wc, int fr, int fq) const {
        const bool samp = u.pm >= 128;
#pragma unroll
        for (int ai = 0; ai < 2; ++ai)
#pragma unroll
            for (int m = 0; m < 4; ++m) {
                const int row = u.pm * 256 + ai * 128 + wr * 64 + m * 16 + fr;
                const f32x4* sp = (const f32x4*)(ssq + (size_t)row * 16);
                const f32x4 s0 = sp[0], s1 = sp[1], s2 = sp[2], s3 = sp[3];
                const float tot = ((s0[0] + s0[1]) + (s0[2] + s0[3])) + ((s1[0] + s1[1]) + (s1[2] + s1[3])) + ((s2[0] + s2[1]) + (s2[2] + s2[3])) + ((s3[0] + s3[1]) + (s3[2] + s3[3]));
                const float rs = rsqrtf(tot * (1.f / 1024.f) + NEPS);
                float* cs = nullptr;
                if (!samp) { const int t = row & 2047; if (t >= 2046) cs = out + O_PCONV + (size_t)((row >> 11) * 2 + (t - 2046)) * NUP; }
                else { const int t = row & 15; if (t >= 14) cs = out + O_SCONV + (size_t)(((row - M_P) >> 4) * 2 + (t - 14)) * NUP; }
#pragma unroll
                for (int bj = 0; bj < 2; ++bj) {
                    const int col = u.pn * 256 + bj * 128 + wc * 32 + fq * 8;
                    const f32x4 a = acc[ai][bj][m][0] * rs, b = acc[ai][bj][m][1] * rs;
                    *(u32x4*)(U + (size_t)row * NUP + col) = pack8(a, b);
                    if (cs) { *(f32x4*)(cs + col) = a; *(f32x4*)(cs + col + 4) = b; }
                }
            }
    }
};

template <bool PERMROWS>
__device__ __forceinline__ void transpose_item(const float* W, int K, int N, bf16_t* WT, const float* g, LAS float* scr, int item, int lane) {
    const int nblk = N / 32, kb = item / nblk, nb = item % nblk, k0 = 64 * kb, n0 = 32 * nb;
#pragma unroll 8
    for (int i = 0; i < 32; ++i) { const int kk = 2 * i + (lane >> 5); float v = W[(size_t)(k0 + kk) * N + n0 + (lane & 31)]; if (g) v *= g[k0 + kk]; scr[kk * 33 + (lane & 31)] = v; }
    asm volatile("s_waitcnt lgkmcnt(0)" ::: "memory");
    const int c = lane & 7;
#pragma unroll
    for (int j = 0; j < 4; ++j) {
        const int n = (lane >> 3) + 8 * j; const LAS float* s = scr + (8 * c) * 33 + n;
        u32x4 o; o.x = cvtpk(s[0 * 33], s[1 * 33]); o.y = cvtpk(s[2 * 33], s[3 * 33]); o.z = cvtpk(s[4 * 33], s[5 * 33]); o.w = cvtpk(s[6 * 33], s[7 * 33]);
        int nn = n0 + n;
        if (PERMROWS) { const int p = nn & 255; nn = (nn & ~255) + ((p >> 5) & 1) * 128 + (p >> 6) * 32 + (p & 31); }
        *(u32x4*)(WT + (size_t)nn * K + k0 + 8 * c) = o;
    }
    asm volatile("s_waitcnt lgkmcnt(0)" ::: "memory");
}

namespace att {
constexpr int KCH = 1040, KMAP = 8 * KCH;
constexpr int DA_K = 0, DA_V = 2 * KMAP, DA_VS = 320;
constexpr int SB_K = 0, SB_V = KMAP, SB_VS = 192;
constexpr int WSF = 37376, CTL = 39424, EXCH = 40960, EXS = 132;
constexpr int NU_DAS = 128, NU_SBS = 256, NU_DAP = 1024, NU_SBP = 1024, NUNITS = NU_DAS + NU_SBS + NU_DAP + NU_SBP;
constexpr float SB_THR = -88.0f;

__device__ __forceinline__ s16x4 vtr(lptr p) { return __builtin_bit_cast(s16x4, __builtin_amdgcn_ds_read_tr16_b64_v4i16((LAS v4i16_t*)p)); }
__device__ __forceinline__ int crow(int r, int hi) { return (r & 3) + 8 * (r >> 2) + 4 * hi; }
__device__ __forceinline__ void expand8(u32x4 w, f32x4& a, f32x4& b) { a[0] = bflo(w.x); a[1] = bfhi(w.x); a[2] = bflo(w.y); a[3] = bfhi(w.y); b[0] = bflo(w.z); b[1] = bfhi(w.z); b[2] = bflo(w.w); b[3] = bfhi(w.w); }

template <bool SAMPLE> struct DAStage;
template <> struct DAStage<false> {
    u32x4 k[2], v[2];
    __device__ __forceinline__ void load(const Params& p, const bf16_t* KA, const bf16_t* VA, int b, int h, int t, int tid) {
#pragma unroll
        for (int i = 0; i < 2; ++i) { const int id = tid + 512 * i, row = id >> 4, ch = id & 15; const size_t off = (size_t)(b * 2048 + 64 * t + row) * 512 + h * 128 + ch * 8;
            k[i] = *(const u32x4*)(KA + off); v[i] = *(const u32x4*)(VA + off); }
    }
    __device__ __forceinline__ void store(lptr lds, int tid) {
#pragma unroll
        for (int i = 0; i < 2; ++i) { const int id = tid + 512 * i, row = id >> 4, ch = id & 15;
            *(LAS u32x4*)(lds + DA_K + (ch >> 3) * KMAP + (ch & 7) * KCH + row * 16) = k[i]; *(LAS u32x4*)(lds + DA_V + row * DA_VS + ch * 16) = v[i]; }
    }
};
template <> struct DAStage<true> {
    f32x4 k[2][2], v[2][2];
    __device__ __forceinline__ void load(const Params& p, const bf16_t* KA, const bf16_t* VA, int b, int h, int t, int tid) {
#pragma unroll
        for (int i = 0; i < 2; ++i) { const int id = tid + 512 * i, row = id >> 4, ch = id & 15;
            if (t < 32) { const size_t off = ((size_t)(b * 2048 + 64 * t + row) * 4 + h) * 128 + ch * 8;
                k[i][0] = *(const f32x4*)(p.cdk + off); k[i][1] = *(const f32x4*)(p.cdk + off + 4); v[i][0] = *(const f32x4*)(p.cdv + off); v[i][1] = *(const f32x4*)(p.cdv + off + 4); }
            else if (row < 16) { const size_t off = (size_t)(M_P + b * 16 + row) * 512 + h * 128 + ch * 8; expand8(*(const u32x4*)(KA + off), k[i][0], k[i][1]); expand8(*(const u32x4*)(VA + off), v[i][0], v[i][1]); }
            else { k[i][0] = k[i][1] = v[i][0] = v[i][1] = (f32x4){0.f, 0.f, 0.f, 0.f}; } }
    }
    __device__ __forceinline__ void store(lptr lds, int tid) {
#pragma unroll
        for (int i = 0; i < 2; ++i) { const int id = tid + 512 * i, row = id >> 4, ch = id & 15;
            *(LAS u32x4*)(lds + DA_K + (ch >> 3) * KMAP + (ch & 7) * KCH + row * 16) = pack8(k[i][0], k[i][1]); *(LAS u32x4*)(lds + DA_V + row * DA_VS + ch * 16) = pack8(v[i][0], v[i][1]); }
    }
};
template <bool SAMPLE> struct SBStage;
template <> struct SBStage<false> {
    u32x4 k, v;
    __device__ __forceinline__ void load(const Params& p, const bf16_t* KB, const bf16_t* VB, int b, int h, int t, int tid) {
        const int row = tid >> 3, ch = tid & 7; const size_t off = (size_t)(b * 2048 + 64 * t + row) * 512 + h * 64 + ch * 8;
        k = *(const u32x4*)(KB + off); v = *(const u32x4*)(VB + off);
    }
    __device__ __forceinline__ void store(lptr lds, int tid) {
        const int row = tid >> 3, ch = tid & 7;
        *(LAS u32x4*)(lds + SB_K + ch * KCH + row * 16) = k; *(LAS u32x4*)(lds + SB_V + row * SB_VS + ch * 16) = v;
    }
};
template <> struct SBStage<true> {
    f32x4 k[2], v[2];
    __device__ __forceinline__ void load(const Params& p, const bf16_t* KB, const bf16_t* VB, int b, int h, int t, int tid) {
        const int row = tid >> 3, ch = tid & 7;
        if (t < 32) { const size_t off = ((size_t)(b * 2048 + 64 * t + row) * 8 + h) * 64 + ch * 8;
            k[0] = *(const f32x4*)(p.csk + off); k[1] = *(const f32x4*)(p.csk + off + 4); v[0] = *(const f32x4*)(p.csv + off); v[1] = *(const f32x4*)(p.csv + off + 4); }
        else if (row < 16) { const size_t off = (size_t)(M_P + b * 16 + row) * 512 + h * 64 + ch * 8; expand8(*(const u32x4*)(KB + off), k[0], k[1]); expand8(*(const u32x4*)(VB + off), v[0], v[1]); }
        else { k[0] = k[1] = v[0] = v[1] = (f32x4){0.f, 0.f, 0.f, 0.f}; }
    }
    __device__ __forceinline__ void store(lptr lds, int tid) {
        const int row = tid >> 3, ch = tid & 7;
        *(LAS u32x4*)(lds + SB_K + ch * KCH + row * 16) = pack8(k[0], k[1]); *(LAS u32x4*)(lds + SB_V + row * SB_VS + ch * 16) = pack8(v[0], v[1]);
    }
};

#define MFMA32(a, b, c) __builtin_amdgcn_mfma_f32_32x32x16_bf16((a), (b), (c), 0, 0, 0)

template <bool SAMPLE>
__device__ __forceinline__ void da_unit(lptr lds, const Params& p, const bf16_t* zA, bf16_t* OA, int b, int h, int qblk, float lam) {
    const int tid = threadIdx.x, lane = tid & 63, r32 = lane & 31, hi = lane >> 5, wid = __builtin_amdgcn_readfirstlane(tid >> 6), c = wid & 1, sub = wid >> 1;
    const bf16_t* QA = zA; const bf16_t* KA = zA + ZSEC; const bf16_t* VA = zA + 2 * ZSEC;
    const size_t qrow = SAMPLE ? (size_t)(M_P + b * 16 + (r32 & 15)) : (size_t)(b * 2048 + qblk * 128 + sub * 32 + r32);
    bf16x8 qr[4];
#pragma unroll
    for (int d0 = 0; d0 < 4; ++d0) qr[d0] = *(const bf16x8*)(QA + qrow * 512 + h * 128 + c * 64 + d0 * 16 + hi * 8);
    const int nt = SAMPLE ? 33 : 2 * qblk + 2;
    const int ntw = SAMPLE ? (sub == 0 ? 33 : 0) : 2 * qblk + 1 + (sub >> 1);
    f32x16 o[4];
#pragma unroll
    for (int i = 0; i < 4; ++i) o[i] = f32x16{};
    float m = -1e30f, l = 0.f;
    LAS float* wsf = (LAS float*)(lds + WSF) + wid * 64;
    const int vlane = ((lane >> 4) & 1) * 32 + (lane & 3) * 8 + (4 * hi + ((lane & 15) >> 2)) * DA_VS;
    DAStage<SAMPLE> st;
    st.load(p, KA, VA, b, h, 0, tid);
    for (int t = 0; t < nt; ++t) {
        __syncthreads();
        st.store(lds, tid);
        __syncthreads();
        if (t + 1 < nt) st.load(p, KA, VA, b, h, t + 1, tid);
        if (t < ntw) {
            f32x16 p0 = f32x16{}, p1 = f32x16{};
#pragma unroll
            for (int d0 = 0; d0 < 4; ++d0) {
                lptr ka = lds + DA_K + c * KMAP + (2 * d0 + hi) * KCH + r32 * 16;
                const bf16x8 b0 = *(const LAS bf16x8*)ka, b1 = *(const LAS bf16x8*)(ka + 512);
                p0 = MFMA32(b0, qr[d0], p0); p1 = MFMA32(b1, qr[d0], p1);
            }
            if (SAMPLE && t == 32) {
#pragma unroll
                for (int r = 8; r < 16; ++r) p0[r] = -1e30f;
#pragma unroll
                for (int r = 0; r < 16; ++r) p1[r] = -1e30f;
            }
            float rm = fmaxf(p0[0], p1[0]);
#pragma unroll
            for (int r = 1; r < 16; ++r) rm = fmaxf(rm, fmaxf(p0[r], p1[r]));
            rm = fmaxf(rm, __shfl_xor(rm, 32));
            const float mn = fmaxf(m, rm);
            if (__any(mn > m)) {
                const float alpha = fexp2(m - mn); l *= alpha;
                if (hi == 0) wsf[r32] = alpha;
                asm volatile("s_waitcnt lgkmcnt(0)" ::: "memory");
                float f[16];
#pragma unroll
                for (int r = 0; r < 16; ++r) f[r] = wsf[crow(r, hi)];
#pragma unroll
                for (int d0 = 0; d0 < 4; ++d0)
#pragma unroll
                    for (int r = 0; r < 16; ++r) o[d0][r] *= f[r];
                asm volatile("s_waitcnt lgkmcnt(0)" ::: "memory");
            }
            m = mn;
            float ls = 0.f;
#pragma unroll
            for (int r = 0; r < 16; ++r) { p0[r] = fexp2(p0[r] - m); p1[r] = fexp2(p1[r] - m); ls += p0[r] + p1[r]; }
            l += ls;
            bf16x8 pw[4];
            { u32x4 w;
              w.x = cvtpk(p0[0], p0[1]); w.y = cvtpk(p0[2], p0[3]); w.z = cvtpk(p0[4], p0[5]); w.w = cvtpk(p0[6], p0[7]); pw[0] = __builtin_bit_cast(bf16x8, w);
              w.x = cvtpk(p0[8], p0[9]); w.y = cvtpk(p0[10], p0[11]); w.z = cvtpk(p0[12], p0[13]); w.w = cvtpk(p0[14], p0[15]); pw[1] = __builtin_bit_cast(bf16x8, w);
              w.x = cvtpk(p1[0], p1[1]); w.y = cvtpk(p1[2], p1[3]); w.z = cvtpk(p1[4], p1[5]); w.w = cvtpk(p1[6], p1[7]); pw[2] = __builtin_bit_cast(bf16x8, w);
              w.x = cvtpk(p1[8], p1[9]); w.y = cvtpk(p1[10], p1[11]); w.z = cvtpk(p1[12], p1[13]); w.w = cvtpk(p1[14], p1[15]); pw[3] = __builtin_bit_cast(bf16x8, w); }
#pragma unroll
            for (int d0 = 0; d0 < 4; ++d0)
#pragma unroll
                for (int ks = 0; ks < 4; ++ks) {
                    lptr va = lds + DA_V + vlane + ks * 16 * DA_VS + d0 * 64;
                    const s16x4 lo = vtr(va), hh = vtr(va + 8 * DA_VS);
                    const bf16x8 vf = (bf16x8){lo[0], lo[1], lo[2], lo[3], hh[0], hh[1], hh[2], hh[3]};
                    o[d0] = MFMA32(pw[ks], vf, o[d0]);
                }
        }
    }
    l += __shfl_xor(l, 32);
    const bool live = !SAMPLE || sub == 0;
    if (live) {
        const float fac = (c == 0) ? frcp(l) : lam * frcp(l);
        if (hi == 0) wsf[r32] = fac;
        asm volatile("s_waitcnt lgkmcnt(0)" ::: "memory");
        float f[16];
#pragma unroll
        for (int r = 0; r < 16; ++r) f[r] = wsf[crow(r, hi)];
#pragma unroll
        for (int d0 = 0; d0 < 4; ++d0)
#pragma unroll
            for (int r = 0; r < 16; ++r) o[d0][r] *= f[r];
    }
    LAS float* ex = (LAS float*)(lds + EXCH) + sub * 32 * EXS;
    if (live && c == 1) {
#pragma unroll
        for (int d0 = 0; d0 < 4; ++d0)
#pragma unroll
            for (int r = 0; r < 16; ++r) ex[crow(r, hi) * EXS + d0 * 32 + r32] = o[d0][r];
    }
    __syncthreads();
    if (live && c == 0) {
#pragma unroll
        for (int d0 = 0; d0 < 4; ++d0)
#pragma unroll
            for (int r = 0; r < 16; ++r) { LAS float* e = ex + crow(r, hi) * EXS + d0 * 32 + r32; *e = o[d0][r] - *e; }
    }
    __syncthreads();
    if (live) {
        const f32x2 g = *(const f32x2*)(p.subln_g + 2 * lane);
#pragma unroll 4
        for (int rr = 0; rr < 16; ++rr) {
            const int row = c * 16 + rr;
            const f32x2 v = *(const LAS f32x2*)(ex + row * EXS + 2 * lane);
            const float ss = wave_sum(v.x * v.x + v.y * v.y);
            const float rs = rsqrtf(ss * (1.f / 128.f) + NEPS) * 0.8f;
            const bool ok = !SAMPLE || row < 16;
            const size_t grow = SAMPLE ? (size_t)(M_P + b * 16 + row) : (size_t)(b * 2048 + qblk * 128 + sub * 32 + row);
            if (ok) *(unsigned*)(OA + grow * 512 + h * 128 + 2 * lane) = cvtpk(v.x * rs * g.x, v.y * rs * g.y);
        }
    }
}

template <bool SAMPLE>
__device__ __forceinline__ void sb_unit(lptr lds, const Params& p, const bf16_t* zA, bf16_t* OB, int b, int h, int qblk) {
    const int tid = threadIdx.x, lane = tid & 63, r32 = lane & 31, hi = lane >> 5, wid = __builtin_amdgcn_readfirstlane(tid >> 6);
    const bf16_t* QB = zA + 3 * ZSEC; const bf16_t* KB = zA + 4 * ZSEC; const bf16_t* VB = zA + 5 * ZSEC;
    const int qw = SAMPLE ? 2048 : qblk * 256 + wid * 32;
    const int qpos = SAMPLE ? 2048 + (r32 & 15) : qw + r32;
    const size_t qrow = SAMPLE ? (size_t)(M_P + b * 16 + (r32 & 15)) : (size_t)(b * 2048 + qpos);
    bf16x8 qr[4];
#pragma unroll
    for (int d0 = 0; d0 < 4; ++d0) qr[d0] = *(const bf16x8*)(QB + qrow * 512 + h * 64 + d0 * 16 + hi * 8);
    const int t_hi = SAMPLE ? 32 : 4 * qblk + 3;
    const int tw = qw >> 6;
    const bool active = !SAMPLE || wid == 0;
    f32x16 o[2]; o[0] = f32x16{}; o[1] = f32x16{};
    float R = 0.f;
    bool mydone = !active;
    LAS int* flags = (LAS int*)(lds + CTL);
    if (lane == 0) flags[wid] = mydone ? 1 : 0;
    const int vlane = ((lane >> 4) & 1) * 32 + (lane & 3) * 8 + (4 * hi + ((lane & 15) >> 2)) * SB_VS;
    SBStage<SAMPLE> st;
    st.load(p, KB, VB, b, h, t_hi, tid);
    for (int t = t_hi; t >= 0; --t) {
        __syncthreads();
        { int nd = 0;
#pragma unroll
          for (int w = 0; w < 8; ++w) nd += flags[w];
          if (nd == 8) break; }
        st.store(lds, tid);
        __syncthreads();
        if (t > 0) st.load(p, KB, VB, b, h, t - 1, tid);
        if (!mydone && t <= tw) {
            f32x16 p0 = f32x16{}, p1 = f32x16{};
#pragma unroll
            for (int d0 = 0; d0 < 4; ++d0) {
                lptr ka = lds + SB_K + (2 * d0 + hi) * KCH + r32 * 16;
                const bf16x8 b0 = *(const LAS bf16x8*)ka, b1 = *(const LAS bf16x8*)(ka + 512);
                p0 = MFMA32(b0, qr[d0], p0); p1 = MFMA32(b1, qr[d0], p1);
            }
            float x[32], lk[32];
#pragma unroll
            for (int r = 0; r < 16; ++r) { x[r] = p0[r]; x[16 + r] = p1[r]; }
            const int kb = 64 * t + 4 * hi;
#pragma unroll
            for (int i = 0; i < 32; ++i) {
                const float z = x[i];
                const float e = fexp2(-fabsf(z) * L2E);
                const float sp = fmaxf(z, 0.f) + LN2 * flog2(1.f + e);
                const bool msk = (kb + 8 * (i >> 2) + (i & 3)) < qpos;
                lk[i] = msk ? -sp : 0.f;
                x[i] = msk ? (z - sp) : -1e30f;
            }
            float gs[8], gp[8];
#pragma unroll
            for (int k = 0; k < 8; ++k) { gs[k] = (lk[4 * k] + lk[4 * k + 1]) + (lk[4 * k + 2] + lk[4 * k + 3]); gp[k] = __shfl_xor(gs[k], 32); }
            float run = R;
#pragma unroll
            for (int k = 7; k >= 0; --k) {
                const float c3 = run + (hi == 0 ? gp[k] : 0.f), c2 = c3 + lk[4 * k + 3], c1 = c2 + lk[4 * k + 2], c0 = c1 + lk[4 * k + 1];
                x[4 * k + 3] += c3; x[4 * k + 2] += c2; x[4 * k + 1] += c1; x[4 * k] += c0;
                run += gs[k] + gp[k];
            }
            R = run;
#pragma unroll
            for (int i = 0; i < 32; ++i) x[i] = fexp2(x[i] * L2E);
            bf16x8 pw[4];
#pragma unroll
            for (int ks = 0; ks < 4; ++ks) { u32x4 w; w.x = cvtpk(x[8 * ks], x[8 * ks + 1]); w.y = cvtpk(x[8 * ks + 2], x[8 * ks + 3]); w.z = cvtpk(x[8 * ks + 4], x[8 * ks + 5]); w.w = cvtpk(x[8 * ks + 6], x[8 * ks + 7]); pw[ks] = __builtin_bit_cast(bf16x8, w); }
#pragma unroll
            for (int d0 = 0; d0 < 2; ++d0)
#pragma unroll
                for (int ks = 0; ks < 4; ++ks) {
                    lptr va = lds + SB_V + vlane + ks * 16 * SB_VS + d0 * 64;
                    const s16x4 lo = vtr(va), hh = vtr(va + 8 * SB_VS);
                    const bf16x8 vf = (bf16x8){lo[0], lo[1], lo[2], lo[3], hh[0], hh[1], hh[2], hh[3]};
                    o[d0] = MFMA32(pw[ks], vf, o[d0]);
                }
            if (__all(R < SB_THR)) { mydone = true; if (lane == 0) flags[wid] = 1; }
        }
    }
    __syncthreads();
    if (active) {
#pragma unroll
        for (int d0 = 0; d0 < 2; ++d0)
#pragma unroll
            for (int r = 0; r < 16; ++r) {
                const int q = crow(r, hi);
                const bool ok = !SAMPLE || q < 16;
                const size_t grow = SAMPLE ? (size_t)(M_P + b * 16 + q) : (size_t)(b * 2048 + qw + q);
                if (ok) OB[grow * 512 + h * 64 + d0 * 32 + r32] = (bf16_t)(cvtpk(o[d0][r], 0.f) & 0xffffu);
            }
    }
}

__device__ __forceinline__ void attention_phase(lptr lds, const Params& p, unsigned* counter) {
    const int tid = threadIdx.x, lane = tid & 63;
    bf16_t* zA = (bf16_t*)(p.ws + WS_A);
    bf16_t* OA = zA + 10 * ZSEC; bf16_t* OB = zA + 11 * ZSEC;
    const float d1 = wave_sum(p.lq1[lane] * p.lk1[lane]), d2 = wave_sum(p.lq2[lane] * p.lk2[lane]);
    const float lam = expf(d1) - expf(d2) + 0.2f;
    LAS int* ctl = (LAS int*)(lds + CTL);
    for (;;) {
        __syncthreads();
        if (tid == 0) ctl[8] = (int)atomicAdd(counter, 1u);
        __syncthreads();
        int u = __builtin_amdgcn_readfirstlane(ctl[8]);
        if (u >= NUNITS) break;
        if (u < NU_DAS) { da_unit<true>(lds, p, zA, OA, u >> 2, u & 3, 0, lam); continue; }
        u -= NU_DAS;
        if (u < NU_SBS) { sb_unit<true>(lds, p, zA, OB, u >> 3, u & 7, 0); continue; }
        u -= NU_SBS;
        if (u < NU_DAP) { const int bh = u & 63; da_unit<false>(lds, p, zA, OA, bh >> 2, bh & 3, 15 - (u >> 6), lam); continue; }
        u -= NU_DAP;
        { const int bh = u & 127; sb_unit<false>(lds, p, zA, OB, bh >> 3, bh & 7, 7 - (u >> 7)); }
    }
}
#undef MFMA32
}

#define XB_TMO      128
#define XB_XCNT(j)  (256  + 64 * (j))
#define XB_XSUB(j)  (1280 + 64 * (j))
#define XB_XGEN(j)  (2304 + 64 * (j))
#define XB_TOP      3328
#define XB_TOPGEN   3392
#define XCD_BAR_WORDS 3456
#define XB_SPIN_CAP (1u << 18)

__device__ __forceinline__ unsigned xb_ld(unsigned* p)              { return __hip_atomic_load(p, __ATOMIC_RELAXED, __HIP_MEMORY_SCOPE_AGENT); }
__device__ __forceinline__ unsigned xb_add(unsigned* p, unsigned v) { return __hip_atomic_fetch_add(p, v, __ATOMIC_RELAXED, __HIP_MEMORY_SCOPE_AGENT); }
__device__ __forceinline__ unsigned xb_xcc_id() { return (unsigned)__builtin_amdgcn_s_getreg((3 << 11) | 20) & 0xFu; }
#define XB_SPIN(cond, bar) do { unsigned _sp = 0; while (cond) { __builtin_amdgcn_s_sleep(1); \
    if ((++_sp & 255u) == 0u) { if (xb_ld(&(bar)[XB_TMO])) break; if (_sp > XB_SPIN_CAP) { atomicAdd(&(bar)[XB_TMO], 1u); break; } } } } while (0)

struct XcdBarrier {
    unsigned* bar; unsigned x;
    volatile LAS unsigned* st;
};

__device__ __forceinline__ XcdBarrier xcd_barrier_post(unsigned* bar, volatile LAS unsigned* st) {
    XcdBarrier b; b.bar = bar; b.x = xb_xcc_id(); b.st = st;
    if (threadIdx.x == 0) (void)xb_add(&bar[XB_XCNT(b.x)], 1u);
    return b;
}
__device__ __forceinline__ void xcd_barrier_complete(unsigned* bar, unsigned x, unsigned& nloc, unsigned& nx) {
    const unsigned G = gridDim.x * gridDim.y * gridDim.z;
    unsigned sum, cnt, mine, sp = 0u;
    for (;;) {
        sum = 0u; cnt = 0u; mine = 0u;
#pragma unroll
        for (unsigned j = 0; j < 16; ++j) { const unsigned c = xb_ld(&bar[XB_XCNT(j)]); sum += c; cnt += (c > 0u) ? 1u : 0u; mine = (j == x) ? c : mine; }
        if (sum == G) break;
        __builtin_amdgcn_s_sleep(1);
        if ((++sp & 255u) == 0u) { if (xb_ld(&bar[XB_TMO])) break; if (sp > XB_SPIN_CAP) { atomicAdd(&bar[XB_TMO], 1u); break; } }
    }
    nloc = mine > 0u ? mine : 1u; nx = cnt > 0u ? cnt : 1u;
}

__device__ __forceinline__ void xcd_barrier(const XcdBarrier& b) {
    asm volatile("s_waitcnt vmcnt(0)" ::: "memory");
    __syncthreads();
    if (threadIdx.x == 0) {
        unsigned* bar = b.bar;
        __builtin_amdgcn_s_waitcnt(0);
        unsigned nloc = b.st[0], nx = b.st[1];
        if (nloc == 0u) { xcd_barrier_complete(bar, b.x, nloc, nx); b.st[0] = nloc; b.st[1] = nx; }
        const unsigned old = xb_add(&bar[XB_XSUB(b.x)], 1u);
        const unsigned gen = old / nloc;
        if (old + 1u == (gen + 1u) * nloc) {
            __builtin_amdgcn_fence(__ATOMIC_RELEASE, "agent");
            asm volatile("s_waitcnt vmcnt(0)" ::: "memory");
            const unsigned og = xb_add(&bar[XB_TOP], 1u);
            const unsigned tg = og / nx;
            if (og + 1u == (tg + 1u) * nx) xb_add(&bar[XB_TOPGEN], 1u);
            else XB_SPIN(xb_ld(&bar[XB_TOPGEN]) == tg, bar);
            __builtin_amdgcn_fence(__ATOMIC_ACQUIRE, "agent");
            xb_add(&bar[XB_XGEN(b.x)], 1u);
            asm volatile("s_waitcnt vmcnt(0)" ::: "memory");
        } else {
            XB_SPIN(xb_ld(&bar[XB_XGEN(b.x)]) == gen, bar);
            __builtin_amdgcn_fence(__ATOMIC_ACQUIRE, "agent");
            asm volatile("s_waitcnt vmcnt(0)" ::: "memory");
        }
    }
    __syncthreads();
}

constexpr int LDS_BYTES = 147456;
__global__ void __launch_bounds__(512, 2) fwd_megakernel(Params p) {
    extern __shared__ __attribute__((aligned(16))) unsigned char lds_raw[];
    lptr lds = (lptr)lds_raw;
    cg::grid_group grid = cg::this_grid();
    const int tid = threadIdx.x, lane = tid & 63, wave = __builtin_amdgcn_readfirstlane(tid >> 6);
    const int G = gridDim.x, gw = blockIdx.x * 8 + wave, NGW = G * 8;
    unsigned char* ws = p.ws;
    float* rstd1 = (float*)(ws + WS_RSTD); float* ssq1 = (float*)(ws + WS_SSQ1); float* ssq2 = (float*)(ws + WS_SSQ2);
    bf16_t* WinT = (bf16_t*)(ws + WS_WIN); bf16_t* WaT = (bf16_t*)(ws + WS_WA); bf16_t* WbT = (bf16_t*)(ws + WS_WB); bf16_t* WoutT = (bf16_t*)(ws + WS_WOUT);
    bf16_t* WupT = (bf16_t*)(ws + WS_WUP); bf16_t* WdnT = (bf16_t*)(ws + WS_WDN);
    bf16_t* zA = (bf16_t*)(ws + WS_A); bf16_t* U = zA;
    bf16_t* XB = (bf16_t*)(ws + WS_B); bf16_t* MG = XB + (size_t)M_TOK * 1024; bf16_t* H = XB;
    bf16_t* X1B = (bf16_t*)(ws + WS_X1B);
    unsigned* counter = (unsigned*)(ws + WS_CTL);
    volatile LAS unsigned* bst = (volatile LAS unsigned*)(lds + 131072 + 512);
    if (tid == 0) { bst[0] = 0u; bst[1] = 0u; }
    __syncthreads();

    {
        if (blockIdx.x == 0) for (int i = tid; i < 4096; i += 512) counter[i] = 0u;
        LAS float* scr = (LAS float*)(lds + wave * 16384);
        constexpr int I_IN = 16 * 160, I_A = 8 * 32, I_O = 16 * 32, I_UP = 16 * 176, I_DN = 44 * 32, NITEMS = I_IN + 2 * I_A + I_O + I_UP + I_DN;
        for (int it = gw; it < NITEMS; it += NGW) {
            int r = it;
            if (r < I_IN) { transpose_item<true>(p.w_in, 1024, NIN, WinT, p.attn_g, scr, r, lane); continue; } r -= I_IN;
            if (r < I_A) { transpose_item<false>(p.w_a, 512, 1024, WaT, nullptr, scr, r, lane); continue; } r -= I_A;
            if (r < I_A) { transpose_item<false>(p.w_b, 512, 1024, WbT, nullptr, scr, r, lane); continue; } r -= I_A;
            if (r < I_O) { transpose_item<false>(p.w_out, 1024, 1024, WoutT, nullptr, scr, r, lane); continue; } r -= I_O;
            if (r < I_UP) { transpose_item<false>(p.w_up, 1024, NUP, WupT, p.ffn_g, scr, r, lane); continue; } r -= I_UP;
            transpose_item<false>(p.w_down, DFF, 1024, WdnT, nullptr, scr, r, lane);
        }
        for (int row = gw; row < M_TOK; row += NGW) {
            const float* xr = row < M_P ? p.x_prompt + (size_t)row * 1024 : p.x_sample + (size_t)(row - M_P) * 1024;
            f32x4 v[4]; float s = 0.f;
#pragma unroll
            for (int j = 0; j < 4; ++j) { v[j] = *(const f32x4*)(xr + 4 * lane + 256 * j); s += (v[j][0] * v[j][0] + v[j][1] * v[j][1]) + (v[j][2] * v[j][2] + v[j][3] * v[j][3]); }
            s = wave_sum(s);
            if (lane == 0) rstd1[row] = rsqrtf(s * (1.f / 1024.f) + NEPS);
#pragma unroll
            for (int j = 0; j < 4; ++j) { u32x2 w; w.x = cvtpk(v[j][0], v[j][1]); w.y = cvtpk(v[j][2], v[j][3]); *(u32x2*)(XB + (size_t)row * 1024 + 4 * lane + 256 * j) = w; }
        }
    }
    grid.sync();
    const XcdBarrier xbar = xcd_barrier_post(counter + 256, bst);
    {
        pg8::Gemm g{XB, WinT, M_TOK, NIN, 1024}; pg8::StaticOrder S; S.init(M_TOK, NIN, G, (int)blockIdx.x);
        EpiIn E{rstd1, zA, p.out};
        pg8::gemm_phase<EpiIn, pg8::StaticOrder, true, true>(lds, g, S, E);
    }
    xcd_barrier(xbar);
    att::attention_phase(lds, p, counter);
    xcd_barrier(xbar);
    {
        pg8::Gemm g{zA + 10 * ZSEC, WaT, M_TOK, 1024, 512}; pg8::StaticOrder S; S.init(M_TOK, 1024, G, (int)blockIdx.x);
        EpiMerge<true> E{zA + 6 * ZSEC, MG};
        pg8::gemm_phase<EpiMerge<true>, pg8::StaticOrder, true, true>(lds, g, S, E);
    }
    {
        pg8::Gemm g{zA + 11 * ZSEC, WbT, M_TOK, 1024, 512}; pg8::StaticOrder S; S.init(M_TOK, 1024, G, (int)blockIdx.x);
        EpiMerge<false> E{zA + 8 * ZSEC, MG};
        pg8::gemm_phase<EpiMerge<false>, pg8::StaticOrder, true, true>(lds, g, S, E);
    }
    xcd_barrier(xbar);
    {
        pg8::Gemm g{MG, WoutT, M_TOK, 1024, 1024}; pg8::StaticOrder S; S.init(M_TOK, 1024, G, (int)blockIdx.x);
        EpiRes<true> E{p.x_prompt, p.x_sample, p.out + O_Y, X1B, ssq1};
        pg8::gemm_phase<EpiRes<true>, pg8::StaticOrder, true, true>(lds, g, S, E);
    }
    xcd_barrier(xbar);
    {
        pg8::Gemm g{X1B, WupT, M_TOK, NUP, 1024}; pg8::StaticOrder S; S.init(M_TOK, NUP, G, (int)blockIdx.x);
        EpiUp E{ssq1, U, p.out};
        pg8::gemm_phase<EpiUp, pg8::StaticOrder, true, true>(lds, g, S, E);
    }
    xcd_barrier(xbar);
    {
        constexpr int NCH = DFF / 8, TOTAL = (M_TOK / 16) * NCH;
        for (int it = blockIdx.x * 512 + tid; it < TOTAL; it += G * 512) {
            const int run = it / NCH, ch = it - run * NCH, row0 = run * 16, j0 = ch * 8;
            const bool samp = row0 >= M_P; const int t0 = samp ? 0 : (row0 & 2047);
            float wg[3][8], wv[3][8], bg[8], bv[8];
#pragma unroll
            for (int j = 0; j < 3; ++j)
#pragma unroll
                for (int e = 0; e < 8; ++e) { wg[j][e] = p.conv_w[j * NUP + j0 + e]; wv[j][e] = p.conv_w[j * NUP + DFF + j0 + e]; }
#pragma unroll
            for (int e = 0; e < 8; ++e) { bg[e] = p.conv_b[j0 + e]; bv[e] = p.conv_b[DFF + j0 + e]; }
            f32x4 g2[2], g1[2], v2[2], v1[2];
            if (t0 == 0) {
                if (samp) { const float* sc = p.state_conv + (size_t)((row0 - M_P) >> 4) * 2 * NUP;
                    g2[0] = *(const f32x4*)(sc + j0); g2[1] = *(const f32x4*)(sc + j0 + 4); v2[0] = *(const f32x4*)(sc + DFF + j0); v2[1] = *(const f32x4*)(sc + DFF + j0 + 4);
                    g1[0] = *(const f32x4*)(sc + NUP + j0); g1[1] = *(const f32x4*)(sc + NUP + j0 + 4); v1[0] = *(const f32x4*)(sc + NUP + DFF + j0); v1[1] = *(const f32x4*)(sc + NUP + DFF + j0 + 4);
                } else { g2[0] = g2[1] = g1[0] = g1[1] = v2[0] = v2[1] = v1[0] = v1[1] = (f32x4){0.f, 0.f, 0.f, 0.f}; }
            } else {
                att::expand8(*(const u32x4*)(U + (size_t)(row0 - 2) * NUP + j0), g2[0], g2[1]); att::expand8(*(const u32x4*)(U + (size_t)(row0 - 2) * NUP + DFF + j0), v2[0], v2[1]);
                att::expand8(*(const u32x4*)(U + (size_t)(row0 - 1) * NUP + j0), g1[0], g1[1]); att::expand8(*(const u32x4*)(U + (size_t)(row0 - 1) * NUP + DFF + j0), v1[0], v1[1]);
            }
#pragma unroll 4
            for (int r = 0; r < 16; ++r) {
                f32x4 g0[2], v0[2];
                att::expand8(*(const u32x4*)(U + (size_t)(row0 + r) * NUP + j0), g0[0], g0[1]); att::expand8(*(const u32x4*)(U + (size_t)(row0 + r) * NUP + DFF + j0), v0[0], v0[1]);
                f32x4 hh[2];
#pragma unroll
                for (int q = 0; q < 2; ++q)
#pragma unroll
                    for (int e = 0; e < 4; ++e) {
                        const int i = 4 * q + e;
                        const float cgt = bg[i] + wg[0][i] * g2[q][e] + wg[1][i] * g1[q][e] + wg[2][i] * g0[q][e];
                        const float cvl = bv[i] + wv[0][i] * v2[q][e] + wv[1][i] * v1[q][e] + wv[2][i] * v0[q][e];
                        hh[q][e] = cgt * sigmoidf_(cgt) * cvl;
                    }
                *(u32x4*)(H + (size_t)(row0 + r) * DFF + j0) = pack8(hh[0], hh[1]);
                g2[0] = g1[0]; g2[1] = g1[1]; v2[0] = v1[0]; v2[1] = v1[1]; g1[0] = g0[0]; g1[1] = g0[1]; v1[0] = v0[0]; v1[1] = v0[1];
            }
        }
    }
    xcd_barrier(xbar);
    {
        pg8::Gemm g{H, WdnT, M_TOK, 1024, DFF}; pg8::StaticOrder S; S.init(M_TOK, 1024, G, (int)blockIdx.x);
        EpiRes<false> E{p.out + O_Y, p.out + O_Y + (size_t)M_P * 1024, p.out + O_Y, nullptr, ssq2};
        pg8::gemm_phase<EpiRes<false>, pg8::StaticOrder, true, true>(lds, g, S, E);
    }
    xcd_barrier(xbar);
    for (int row = gw; row < M_TOK; row += NGW) {
        const f32x4* sp = (const f32x4*)(ssq2 + (size_t)row * 16);
        const f32x4 s0 = sp[0], s1 = sp[1], s2 = sp[2], s3 = sp[3];
        const float tot = ((s0[0] + s0[1]) + (s0[2] + s0[3])) + ((s1[0] + s1[1]) + (s1[2] + s1[3])) + ((s2[0] + s2[1]) + (s2[2] + s2[3])) + ((s3[0] + s3[1]) + (s3[2] + s3[3]));
        const float rs = rsqrtf(tot * (1.f / 1024.f) + NEPS);
        float* yr = p.out + O_Y + (size_t)row * 1024;
#pragma unroll
        for (int j = 0; j < 4; ++j) { const int c = 4 * lane + 256 * j; const f32x4 g = *(const f32x4*)(p.final_g + c); f32x4 v = *(const f32x4*)(yr + c); v = v * rs * g; *(f32x4*)(yr + c) = v; }
    }
}

extern "C" void kernel_launch(void* const* d_in, const int* in_sizes, int n_in, void* d_out, int out_size, void* d_ws, size_t ws_size, hipStream_t stream) {
    static int grid = 0;
    if (grid == 0) {
        if (n_in != 23 || (size_t)out_size != O_END || ws_size < WS_END) { fprintf(stderr, "kernel_launch: unexpected sizes n_in %d out %d ws %zu (need %zu)\n", n_in, out_size, ws_size, (size_t)WS_END); grid = -1; return; }
        int dev = 0, cus = 0, per_cu = 0;
        hipGetDevice(&dev); hipDeviceGetAttribute(&cus, hipDeviceAttributeMultiprocessorCount, dev);
        if (hipFuncSetAttribute((const void*)fwd_megakernel, hipFuncAttributeMaxDynamicSharedMemorySize, LDS_BYTES) != hipSuccess) { fprintf(stderr, "kernel_launch: hipFuncSetAttribute failed\n"); grid = -1; return; }
        if (hipOccupancyMaxActiveBlocksPerMultiprocessor(&per_cu, (const void*)fwd_megakernel, 512, LDS_BYTES) != hipSuccess || per_cu < 1) { fprintf(stderr, "kernel_launch: occupancy query says %d\n", per_cu); per_cu = 1; }
        (void)hipGetLastError();
        grid = cus * 1;
    }
    if (grid < 0) return;
    Params p{};
    p.x_prompt = (const float*)d_in[0]; p.x_sample = (const float*)d_in[1]; p.cdk = (const float*)d_in[2]; p.cdv = (const float*)d_in[3]; p.csk = (const float*)d_in[4]; p.csv = (const float*)d_in[5];
    p.state_conv = (const float*)d_in[6]; p.attn_g = (const float*)d_in[7]; p.w_in = (const float*)d_in[8]; p.lq1 = (const float*)d_in[9]; p.lk1 = (const float*)d_in[10]; p.lq2 = (const float*)d_in[11];
    p.lk2 = (const float*)d_in[12]; p.subln_g = (const float*)d_in[13]; p.w_a = (const float*)d_in[14]; p.w_b = (const float*)d_in[15]; p.w_out = (const float*)d_in[16]; p.ffn_g = (const float*)d_in[17];
    p.w_up = (const float*)d_in[18]; p.conv_w = (const float*)d_in[19]; p.conv_b = (const float*)d_in[20]; p.w_down = (const float*)d_in[21]; p.final_g = (const float*)d_in[22];
    p.out = (float*)d_out; p.ws = (unsigned char*)d_ws;
    void* args[] = {&p};
    hipError_t e = hipLaunchCooperativeKernel((const void*)fwd_megakernel, dim3(grid), dim3(512), args, LDS_BYTES, stream);
    if (e != hipSuccess) fprintf(stderr, "cooperative launch failed: %s (grid %d)\n", hipGetErrorString(e), grid);
}
```

```cpp
#include <hip/hip_runtime.h>
#include <hip/hip_cooperative_groups.h>
#include <cstdio>
#include <cstdint>
namespace cg = cooperative_groups;
namespace pg8 {
#define PG8_LAS __attribute__((address_space(3)))
typedef unsigned short bf16_t;
typedef short bf16x8 __attribute__((ext_vector_type(8)));
typedef float f32x4 __attribute__((ext_vector_type(4)));
typedef unsigned u32x4 __attribute__((ext_vector_type(4)));
constexpr int BM = 256, BK = 64, HALF = 128, HTB = HALF * BK * 2  , STAGE_BYTES = 8 * HTB, NXCD = 8, WGM = 8;

__host__ __device__ __forceinline__ int lds_byte(int r, int c) { const int st = (r >> 4) * 2 + (c >> 5), rr = r & 15, cc = c & 31, ob = rr * 64 + cc * 2; return st * 1024 + (ob ^ (((ob >> 9) & 1) << 5)); }
__host__ __device__ __forceinline__ void stage_rc(int b, int& R, int& C) { const int st = b / 1024, sb = b % 1024, swz = sb ^ (((sb >> 9) & 1) << 5); R = (st >> 1) * 16 + swz / 64; C = (st & 1) * 32 + (swz % 64) / 2; }
__host__ __device__ __forceinline__ int perm32(int rho) { const int n = rho >> 4, i = rho & 15; return 8 * (i >> 2) + 4 * n + (i & 3); }

struct Unit { int pm, pn, kb, nt; };
struct Gemm { const bf16_t* A; const bf16_t* Bt; int M, N, K; };

struct StaticOrder {
    int nM, nN, nwg, G, c;
    __host__ __device__ void init(int M, int N, int G_, int c_) { nM = M / BM; nN = N / BM; nwg = nM * nN; G = G_; c = c_; }
    __host__ __device__ bool next(int i, Unit& u) const {
        const long L = (long)i * G + c; if (L >= nwg) return false;
        int wgid = (int)L; { const int q = nwg / NXCD, r = nwg % NXCD, xcd = wgid % NXCD, off = wgid / NXCD; wgid = (xcd < r ? xcd * (q + 1) : r * (q + 1) + (xcd - r) * q) + off; }
        const int nig = WGM * nN, gid = wgid / nig, fm = gid * WGM, gsz = (nM - fm) < WGM ? (nM - fm) : WGM;
        u.pm = fm + ((wgid % nig) % gsz); u.pn = (wgid % nig) / gsz; u.kb = 0; u.nt = 0; return true;
    }
    __device__ __forceinline__ void a_ready(const Unit&) const {}
    __device__ __forceinline__ void done(const Unit&) const {}
};

__device__ __forceinline__ unsigned cvt_pk_bf16(float lo, float hi) { unsigned r; asm volatile("v_cvt_pk_bf16_f32 %0, %1, %2" : "=v"(r) : "v"(lo), "v"(hi)); return r; }
typedef float f32x2 __attribute__((ext_vector_type(2)));
template <class Epi, class Sched, bool ALIGN_EPI = false, bool SP2 = false, int NTC = 0>
__device__ __forceinline__ void gemm_phase(PG8_LAS unsigned char* lds, const Gemm g, const Sched& S, const Epi& E) {
    const int tid = threadIdx.x, wid = __builtin_amdgcn_readfirstlane(tid >> 6), lane = tid & 63, wr = wid >> 2, wc = wid & 3, fr = lane & 15, fq = lane >> 4;
    const int K = g.K; int nt = NTC ? NTC : K / BK;
    if (NTC) asm volatile("" : "+s"(nt));
    unsigned voffA[2], voffB[2];
#pragma unroll
    for (int i = 0; i < 2; ++i) { int R, C; stage_rc(tid * 16 + i * 8192, R, C); const int Rb = Epi::PERM ? ((R & ~31) + perm32(R & 31)) : R;
        voffA[i] = (unsigned)(R * K + C) * 2u; voffB[i] = (unsigned)(Rb * K + C) * 2u; }
    const size_t kstep = (size_t)(BK * 2);
    const size_t hstep = (size_t)HALF * K * 2;
    const size_t tstep = 2 * hstep;
    const unsigned ldsw = (unsigned)wid * 1024u;
    const int aoff = lds_byte(wr * 64 + fr, fq * 8), boff = lds_byte(wc * 32 + fr, fq * 8);
#define PG8_SA(b, h) (((b) * 2 + (h)) * HTB)
#define PG8_SB(b, h) ((4 + (b) * 2 + (h)) * HTB)
#define PG8_STAGE(bufoff, gbase, voff) do { _Pragma("unroll") for (int _i = 0; _i < 2; ++_i) \
        __builtin_amdgcn_global_load_lds((const unsigned*)((const char*)(gbase) + (voff)[_i]), (PG8_LAS unsigned*)(lds + (bufoff) + ldsw + _i * 8192), 16, 0, 0); } while (0)
#define PG8_LDA(dst, b, h) do { _Pragma("unroll") for (int m = 0; m < 4; ++m) _Pragma("unroll") for (int k = 0; k < 2; ++k) dst[m][k] = *(const PG8_LAS bf16x8*)(lds + PG8_SA(b, h) + aoff + m * 2048 + k * 1024); } while (0)
#define PG8_LDB(dst, b, h) do { _Pragma("unroll") for (int n = 0; n < 2; ++n) _Pragma("unroll") for (int k = 0; k < 2; ++k) dst[n][k] = *(const PG8_LAS bf16x8*)(lds + PG8_SB(b, h) + boff + n * 2048 + k * 1024); } while (0)
#define PG8_MMA(ai, bj, At, Bt) do { __builtin_amdgcn_s_setprio(1); _Pragma("unroll") for (int m = 0; m < 4; ++m) _Pragma("unroll") for (int n = 0; n < 2; ++n) _Pragma("unroll") for (int k = 0; k < 2; ++k) \
        acc[ai][bj][m][n] = __builtin_amdgcn_mfma_f32_16x16x32_bf16(Bt[n][k], At[m][k], acc[ai][bj][m][n], 0, 0, 0); __builtin_amdgcn_s_setprio(0); } while (0)
#define PG8_WAIT_V(n) asm volatile("s_waitcnt vmcnt(" #n ")" ::: "memory")
#define PG8_WAIT_L(n) asm volatile("s_waitcnt lgkmcnt(" #n ")" ::: "memory")
#define PG8_BAR __builtin_amdgcn_s_barrier()
#define PG8_SCHED __builtin_amdgcn_sched_barrier(0)
    Unit cur, nxt; int ui = 0;
    if (!S.next(0, cur)) return;
    f32x4 acc[2][2][4][2];
#pragma unroll
    for (int a = 0; a < 2; ++a)
#pragma unroll
        for (int b = 0; b < 2; ++b)
#pragma unroll
            for (int m = 0; m < 4; ++m)
#pragma unroll
                for (int n = 0; n < 2; ++n) acc[a][b][m][n] = (f32x4){0.f, 0.f, 0.f, 0.f};
    bf16x8 At[4][2], B0[2][2], B1[2][2];
    const char* cA = (const char*)g.A + (size_t)cur.pm * tstep + (size_t)cur.kb * kstep; const char* cB = (const char*)g.Bt + (size_t)cur.pn * tstep + (size_t)cur.kb * kstep;
    S.a_ready(cur);
    if constexpr (SP2) {
        PG8_STAGE(PG8_SB(0, 0), cB, voffB); PG8_STAGE(PG8_SB(0, 1), cB + hstep, voffB); PG8_STAGE(PG8_SA(0, 0), cA, voffA); PG8_STAGE(PG8_SA(0, 1), cA + hstep, voffA);
        if (wr == 1) PG8_BAR;
        PG8_WAIT_V(2); PG8_BAR;
        PG8_STAGE(PG8_SB(1, 0), cB + kstep, voffB); PG8_STAGE(PG8_SA(1, 0), cA + kstep, voffA); PG8_STAGE(PG8_SB(1, 1), cB + hstep + kstep, voffB);
        PG8_WAIT_V(6); PG8_BAR;
    } else {
        PG8_STAGE(PG8_SB(0, 0), cB, voffB); PG8_STAGE(PG8_SA(0, 0), cA, voffA); PG8_STAGE(PG8_SB(0, 1), cB + hstep, voffB); PG8_STAGE(PG8_SA(0, 1), cA + hstep, voffA);
        if (wr == 1) PG8_BAR;
        PG8_WAIT_V(4); PG8_BAR;
        PG8_STAGE(PG8_SB(1, 0), cB + kstep, voffB); PG8_STAGE(PG8_SA(1, 0), cA + kstep, voffA); PG8_STAGE(PG8_SB(1, 1), cB + hstep + kstep, voffB);
        PG8_WAIT_V(6); PG8_BAR;
    }
    for (;;) {
        const bool has_next = S.next(ui + 1, nxt);
        const char* nA = has_next ? (const char*)g.A + (size_t)nxt.pm * tstep + (size_t)nxt.kb * kstep : cA; const char* nB = has_next ? (const char*)g.Bt + (size_t)nxt.pn * tstep + (size_t)nxt.kb * kstep : cB;
        for (int t = 0; t < nt; t += 2) {
            const bool last = (t == nt - 2);
            const char* a1 = cA + (size_t)(t + 1) * kstep;
            const char* a2 = last ? nA : cA + (size_t)(t + 2) * kstep; const char* b2 = last ? nB : cB + (size_t)(t + 2) * kstep;
            const char* a3 = a2 + kstep; const char* b3 = b2 + kstep;
            if (last && has_next) S.a_ready(nxt);
            if constexpr (SP2) {
            PG8_LDB(B0, 0, 0); PG8_LDB(B1, 0, 1); PG8_SCHED; PG8_LDA(At, 0, 0); PG8_STAGE(PG8_SA(1, 1), a1 + hstep, voffA);
            PG8_WAIT_V(8); PG8_WAIT_L(0); PG8_BAR; PG8_MMA(0, 0, At, B0); PG8_MMA(0, 1, At, B1); PG8_BAR; PG8_SCHED;
            PG8_LDA(At, 0, 1); PG8_STAGE(PG8_SB(0, 0), b2, voffB); PG8_STAGE(PG8_SB(0, 1), b2 + hstep, voffB); PG8_STAGE(PG8_SA(0, 0), a2, voffA);
            PG8_WAIT_V(8); PG8_WAIT_L(0); PG8_BAR; PG8_MMA(1, 0, At, B0); PG8_MMA(1, 1, At, B1); PG8_BAR; PG8_SCHED;
            PG8_LDB(B0, 1, 0); PG8_LDB(B1, 1, 1); PG8_SCHED; PG8_LDA(At, 1, 0); PG8_STAGE(PG8_SA(0, 1), a2 + hstep, voffA);
            PG8_WAIT_V(8); PG8_WAIT_L(0); PG8_BAR; PG8_MMA(0, 0, At, B0); PG8_MMA(0, 1, At, B1); PG8_BAR; PG8_SCHED;
            PG8_LDA(At, 1, 1); PG8_STAGE(PG8_SB(1, 0), b3, voffB); PG8_STAGE(PG8_SB(1, 1), b3 + hstep, voffB); PG8_STAGE(PG8_SA(1, 0), a3, voffA);
            PG8_WAIT_V(8); PG8_WAIT_L(0); PG8_BAR; PG8_MMA(1, 0, At, B0); PG8_MMA(1, 1, At, B1); PG8_BAR; PG8_SCHED;
            } else {
            PG8_LDB(B0, 0, 0); PG8_SCHED; PG8_LDA(At, 0, 0); PG8_STAGE(PG8_SA(1, 1), a1 + hstep, voffA);
            PG8_WAIT_L(8); PG8_BAR; PG8_WAIT_L(0); PG8_MMA(0, 0, At, B0); PG8_BAR; PG8_SCHED;
            PG8_LDB(B1, 0, 1); PG8_STAGE(PG8_SB(0, 0), b2, voffB);
            PG8_BAR; PG8_WAIT_L(0); PG8_MMA(0, 1, At, B1); PG8_BAR;
            PG8_LDA(At, 0, 1); PG8_STAGE(PG8_SA(0, 0), a2, voffA);
            PG8_BAR; PG8_WAIT_L(0); PG8_MMA(1, 0, At, B0); PG8_BAR; PG8_SCHED;
            PG8_STAGE(PG8_SB(0, 1), b2 + hstep, voffB);
            PG8_WAIT_V(6); PG8_BAR; PG8_MMA(1, 1, At, B1); PG8_BAR;
            PG8_LDB(B0, 1, 0); PG8_SCHED; PG8_LDA(At, 1, 0); PG8_STAGE(PG8_SA(0, 1), a2 + hstep, voffA);
            PG8_WAIT_L(8); PG8_BAR; PG8_WAIT_L(0); PG8_MMA(0, 0, At, B0); PG8_BAR; PG8_SCHED;
            PG8_LDB(B1, 1, 1); PG8_STAGE(PG8_SB(1, 0), b3, voffB);
            PG8_BAR; PG8_WAIT_L(0); PG8_MMA(0, 1, At, B1); PG8_BAR;
            PG8_LDA(At, 1, 1); PG8_STAGE(PG8_SA(1, 0), a3, voffA);
            PG8_BAR; PG8_WAIT_L(0); PG8_MMA(1, 0, At, B0); PG8_BAR; PG8_SCHED;
            PG8_STAGE(PG8_SB(1, 1), b3 + hstep, voffB);
            PG8_WAIT_V(6); PG8_BAR; PG8_MMA(1, 1, At, B1); PG8_BAR;
            }
        }
        if constexpr (ALIGN_EPI) { if (wr == 0) PG8_BAR; }
        if constexpr (!Epi::AFTER_DRAIN) { E(acc, cur, wr, wc, fr, fq); S.done(cur); }
        if (!has_next) break;
#pragma unroll
        for (int a = 0; a < 2; ++a)
#pragma unroll
            for (int b = 0; b < 2; ++b)
#pragma unroll
                for (int m = 0; m < 4; ++m)
#pragma unroll
                    for (int n = 0; n < 2; ++n) acc[a][b][m][n] = (f32x4){0.f, 0.f, 0.f, 0.f};
        cur = nxt; cA = nA; cB = nB; ++ui;
        if constexpr (ALIGN_EPI) { if (wr == 1) PG8_BAR; }
    }
    PG8_WAIT_V(0);
    if constexpr (!ALIGN_EPI) { if (wr == 0) PG8_BAR; }
    PG8_BAR;
    if constexpr (Epi::AFTER_DRAIN) { E.fused(acc, cur, wr, wc, fr, fq, lds, wid, lane); S.done(cur); }
#undef PG8_SA
#undef PG8_SB
#undef PG8_STAGE
#undef PG8_LDA
#undef PG8_LDB
#undef PG8_MMA
#undef PG8_WAIT_V
#undef PG8_WAIT_L
#undef PG8_BAR
#undef PG8_SCHED
}
}

#define LAS __attribute__((address_space(3)))
typedef LAS unsigned char* lptr;
typedef unsigned short bf16_t;
typedef float f32x4 __attribute__((ext_vector_type(4)));
typedef float f32x2 __attribute__((ext_vector_type(2)));
typedef float f32x16 __attribute__((ext_vector_type(16)));
typedef unsigned u32x4 __attribute__((ext_vector_type(4)));
typedef unsigned u32x2 __attribute__((ext_vector_type(2)));
typedef short bf16x8 __attribute__((ext_vector_type(8)));
typedef short s16x4 __attribute__((ext_vector_type(4)));
typedef short v4i16_t __attribute__((ext_vector_type(4)));

constexpr int M_TOK = 33280, M_P = 32768, DM = 1024, NIN = 5120, DFF = 2816, NUP = 5632;
constexpr float L2E = 1.4426950408889634f, LN2 = 0.6931471805599453f, NEPS = 1e-6f;
constexpr size_t O_Y = 0, O_PDK = 34078720, O_PDV = O_PDK + 16777216, O_PSK = O_PDV + 16777216, O_PSV = O_PSK + 16777216,
                 O_PCONV = O_PSV + 16777216, O_SDK = O_PCONV + 180224, O_SDV = O_SDK + 262144, O_SSK = O_SDV + 262144, O_SSV = O_SSK + 262144,
                 O_SCONV = O_SSV + 262144, O_END = O_SCONV + 360448;
constexpr size_t WS_CTL = 0, WS_RSTD = 16384, WS_SSQ1 = WS_RSTD + 133120, WS_SSQ2 = WS_SSQ1 + 2129920, WS_WIN = WS_SSQ2 + 2129920,
                 WS_WA = WS_WIN + 10485760, WS_WB = WS_WA + 1048576, WS_WOUT = WS_WB + 1048576, WS_WUP = WS_WOUT + 2097152,
                 WS_WDN = WS_WUP + 11534336, WS_A = WS_WDN + 5767168, WS_B = WS_A + 408944640, WS_X1B = WS_B + 187432960, WS_END = WS_X1B + 68157440;
constexpr size_t ZSEC = (size_t)M_TOK * 512;

struct Params {
    const float* x_prompt; const float* x_sample; const float* cdk; const float* cdv; const float* csk; const float* csv; const float* state_conv;
    const float* attn_g; const float* w_in; const float* lq1; const float* lk1; const float* lq2; const float* lk2; const float* subln_g;
    const float* w_a; const float* w_b; const float* w_out; const float* ffn_g; const float* w_up; const float* conv_w; const float* conv_b;
    const float* w_down; const float* final_g; float* out; unsigned char* ws;
};

__device__ __forceinline__ float bflo(unsigned w) { return __uint_as_float(w << 16); }
__device__ __forceinline__ float bfhi(unsigned w) { return __uint_as_float(w & 0xffff0000u); }
__device__ __forceinline__ unsigned cvtpk(float lo, float hi) { unsigned r; asm volatile("v_cvt_pk_bf16_f32 %0, %1, %2" : "=v"(r) : "v"(lo), "v"(hi)); return r; }
__device__ __forceinline__ u32x4 pack8(f32x4 a, f32x4 b) { u32x4 w; w.x = cvtpk(a[0], a[1]); w.y = cvtpk(a[2], a[3]); w.z = cvtpk(b[0], b[1]); w.w = cvtpk(b[2], b[3]); return w; }
__device__ __forceinline__ float wave_sum(float v) {
#pragma unroll
    for (int o = 1; o < 64; o <<= 1) v += __shfl_xor(v, o);
    return v;
}
__device__ __forceinline__ float fexp2(float x) { return __builtin_amdgcn_exp2f(x); }
__device__ __forceinline__ float flog2(float x) { return __builtin_amdgcn_logf(x); }
__device__ __forceinline__ float frcp(float x) { return __builtin_amdgcn_rcpf(x); }
__device__ __forceinline__ float sigmoidf_(float x) { return frcp(1.f + fexp2(-x * L2E)); }

struct EpiIn {
    static constexpr bool PERM = true, AFTER_DRAIN = false;
    const float* rstd; bf16_t* z; float* out;
    __device__ __forceinline__ void operator()(const pg8::f32x4 (&acc)[2][2][4][2], const pg8::Unit& u, int wr, int wc, int fr, int fq) const {
        const int pn = u.pn; const bool samp = u.pm >= 128;
        bf16_t* zb; int ld, tcol; float* fo = nullptr; float sc = 1.f; int mode = 0;
        if (pn < 12) {
            const int sec = pn >> 1; zb = z + (size_t)sec * ZSEC; ld = 512; tcol = (pn & 1) * 256;
            if (sec < 2) mode = 1;
            if (sec == 0) sc = 0.125f * L2E; else if (sec == 3) sc = 0.125f;
            if (sec == 1) fo = out + (samp ? O_SDK : O_PDK); else if (sec == 2) fo = out + (samp ? O_SDV : O_PDV);
            else if (sec == 4) fo = out + (samp ? O_SSK : O_PSK); else if (sec == 5) fo = out + (samp ? O_SSV : O_PSV);
        } else { const int gs = (pn - 12) >> 2; zb = z + (size_t)(6 + 2 * gs) * ZSEC; ld = 1024; tcol = ((pn - 12) & 3) * 256; mode = 2; }
        const int cb = tcol + wc * 64 + fq * 8;
        float ir[2][4];
#pragma unroll
        for (int n = 0; n < 2; ++n)
#pragma unroll
            for (int e = 0; e < 4; ++e) ir[n][e] = exp2f(-(float)(8 * fq + 4 * n + e) * (13.287712379549449f / 32.f)) * 0.15915494309189535f;
#pragma unroll
        for (int ai = 0; ai < 2; ++ai)
#pragma unroll
            for (int m = 0; m < 4; ++m) {
                const int row = u.pm * 256 + ai * 128 + wr * 64 + m * 16 + fr;
                const float rs = rstd[row] * sc;
                f32x4 v[2][2];
#pragma unroll
                for (int bj = 0; bj < 2; ++bj)
#pragma unroll
                    for (int n = 0; n < 2; ++n) v[bj][n] = acc[ai][bj][m][n] * rs;
                if (mode == 1) {
                    const float pos = samp ? (float)(2048 + (row & 15)) : (float)(row & 2047);
#pragma unroll
                    for (int n = 0; n < 2; ++n)
#pragma unroll
                        for (int e = 0; e < 4; ++e) {
                            float rev = pos * ir[n][e]; rev -= rintf(rev);
                            const float sn = __builtin_amdgcn_sinf(rev), cs = __builtin_amdgcn_cosf(rev);
                            const float x1 = v[0][n][e], x2 = v[1][n][e];
                            v[0][n][e] = x1 * cs - x2 * sn; v[1][n][e] = x2 * cs + x1 * sn;
                        }
                } else if (mode == 2) {
#pragma unroll
                    for (int bj = 0; bj < 2; ++bj)
#pragma unroll
                        for (int n = 0; n < 2; ++n)
#pragma unroll
                            for (int e = 0; e < 4; ++e) v[bj][n][e] = sigmoidf_(v[bj][n][e]);
                }
                const size_t rl = samp ? (size_t)(row - M_P) : (size_t)row;
#pragma unroll
                for (int bj = 0; bj < 2; ++bj) {
                    *(u32x4*)(zb + (size_t)row * ld + cb + 32 * bj) = pack8(v[bj][0], v[bj][1]);
                    if (fo) { float* d = fo + rl * 512 + cb + 32 * bj; *(f32x4*)d = v[bj][0]; *(f32x4*)(d + 4) = v[bj][1]; }
                }
            }
    }
};
template <bool FIRST> struct EpiMerge {
    static constexpr bool PERM = true, AFTER_DRAIN = false;
    const bf16_t* gate; bf16_t* mg;
    __device__ __forceinline__ void operator()(const pg8::f32x4 (&acc)[2][2][4][2], const pg8::Unit& u, int wr, int wc, int fr, int fq) const {
#pragma unroll
        for (int ai = 0; ai < 2; ++ai)
#pragma unroll
            for (int m = 0; m < 4; ++m) {
                const int row = u.pm * 256 + ai * 128 + wr * 64 + m * 16 + fr;
#pragma unroll
                for (int bj = 0; bj < 2; ++bj) {
                    const size_t off = (size_t)row * 1024 + u.pn * 256 + bj * 128 + wc * 32 + fq * 8;
                    const u32x4 g = *(const u32x4*)(gate + off);
                    f32x4 a = acc[ai][bj][m][0], b = acc[ai][bj][m][1];
                    a[0] *= bflo(g.x); a[1] *= bfhi(g.x); a[2] *= bflo(g.y); a[3] *= bfhi(g.y);
                    b[0] *= bflo(g.z); b[1] *= bfhi(g.z); b[2] *= bflo(g.w); b[3] *= bfhi(g.w);
                    if (!FIRST) { const u32x4 o = *(const u32x4*)(mg + off);
                        a[0] += bflo(o.x); a[1] += bfhi(o.x); a[2] += bflo(o.y); a[3] += bfhi(o.y);
                        b[0] += bflo(o.z); b[1] += bfhi(o.z); b[2] += bflo(o.w); b[3] += bfhi(o.w); }
                    *(u32x4*)(mg + off) = pack8(a, b);
                }
            }
    }
};
template <bool WRITE_BF> struct EpiRes {
    static constexpr bool PERM = true, AFTER_DRAIN = false;
    const float* base_p; const float* base_s; float* y; bf16_t* yb; float* ssq;
    __device__ __forceinline__ void operator()(const pg8::f32x4 (&acc)[2][2][4][2], const pg8::Unit& u, int wr, int wc, int fr, int fq) const {
        const bool samp = u.pm >= 128;
#pragma unroll
        for (int ai = 0; ai < 2; ++ai)
#pragma unroll
            for (int m = 0; m < 4; ++m) {
                const int row = u.pm * 256 + ai * 128 + wr * 64 + m * 16 + fr;
                const float* brow = samp ? base_s + (size_t)(row - M_P) * 1024 : base_p + (size_t)row * 1024;
                float s = 0.f;
#pragma unroll
                for (int bj = 0; bj < 2; ++bj) {
                    const int col = u.pn * 256 + bj * 128 + wc * 32 + fq * 8;
                    f32x4 a = acc[ai][bj][m][0] + *(const f32x4*)(brow + col), b = acc[ai][bj][m][1] + *(const f32x4*)(brow + col + 4);
                    s += (a[0] * a[0] + a[1] * a[1]) + (a[2] * a[2] + a[3] * a[3]) + (b[0] * b[0] + b[1] * b[1]) + (b[2] * b[2] + b[3] * b[3]);
                    float* d = y + (size_t)row * 1024 + col; *(f32x4*)d = a; *(f32x4*)(d + 4) = b;
                    if (WRITE_BF) *(u32x4*)(yb + (size_t)row * 1024 + col) = pack8(a, b);
                }
                s += __shfl_xor(s, 16); s += __shfl_xor(s, 32);
                if (fq == 0) ssq[(size_t)row * 16 + u.pn * 4 + wc] = s;
            }
    }
};
struct EpiUp {
    static constexpr bool PERM = true, AFTER_DRAIN = false;
    const float* ssq; bf16_t* U; float* out;
    __device__ __forceinline__ void operator()(const pg8::f32x4 (&acc)[2][2][4][2], const pg8::Unit& u, int wr, int wc, int fr, int fq) const {
        const bool samp = u.pm >= 128;
#pragma unroll
        for (int ai = 0; ai < 2; ++ai)
#pragma unroll
            for (int m = 0; m < 4; ++m) {
                const int row = u.pm * 256 + ai * 128 + wr * 64 + m * 16 + fr;
                const f32x4* sp = (const f32x4*)(ssq + (size_t)row * 16);
                const f32x4 s0 = sp[0], s1 = sp[1], s2 = sp[2], s3 = sp[3];
                const float tot = ((s0[0] + s0[1]) + (s0[2] + s0[3])) + ((s1[0] + s1[1]) + (s1[2] + s1[3])) + ((s2[0] + s2[1]) + (s2[2] + s2[3])) + ((s3[0] + s3[1]) + (s3[2] + s3[3]));
                const float rs = rsqrtf(tot * (1.f / 1024.f) + NEPS);
                float* cs = nullptr;
                if (!samp) { const int t = row & 2047; if (t >= 2046) cs = out + O_PCONV + (size_t)((row >> 11) * 2 + (t - 2046)) * NUP; }
                else { const int t = row & 15; if (t >= 14) cs = out + O_SCONV + (size_t)(((row - M_P) >> 4) * 2 + (t - 14)) * NUP; }
#pragma unroll
                for (int bj = 0; bj < 2; ++bj) {
                    const int col = u.pn * 256 + bj * 128 + wc * 32 + fq * 8;
                    const f32x4 a = acc[ai][bj][m][0] * rs, b = acc[ai][bj][m][1] * rs;
                    *(u32x4*)(U + (size_t)row * NUP + col) = pack8(a, b);
                    if (cs) { *(f32x4*)(cs + col) = a; *(f32x4*)(cs + col + 4) = b; }
                }
            }
    }
};


struct EpiDown {
    static constexpr bool PERM = true, AFTER_DRAIN = false;
    float* y; float* part;
    __device__ __forceinline__ void operator()(const pg8::f32x4 (&acc)[2][2][4][2], const pg8::Unit& u, int wr, int wc, int fr, int fq) const {
        const bool split = u.pm >= 128;
#pragma unroll
        for (int ai = 0; ai < 2; ++ai)
#pragma unroll
            for (int m = 0; m < 4; ++m) {
                const int row = u.pm * 256 + ai * 128 + wr * 64 + m * 16 + fr;
#pragma unroll
                for (int bj = 0; bj < 2; ++bj) {
                    float* d = y + (size_t)row * 1024 + u.pn * 256 + bj * 128 + wc * 32 + fq * 8;
                    if (!split) { const f32x4 a = acc[ai][bj][m][0] + *(const f32x4*)d, b = acc[ai][bj][m][1] + *(const f32x4*)(d + 4); *(f32x4*)d = a; *(f32x4*)(d + 4) = b; }
                    else { float* q = part + ((size_t)(u.kb >> 2) * 512 + (row - M_P)) * 1024 + u.pn * 256 + bj * 128 + wc * 32 + fq * 8; *(f32x4*)q = acc[ai][bj][m][0]; *(f32x4*)(q + 4) = acc[ai][bj][m][1]; }
                }
            }
    }
};
struct DownOrder {
    int G, c;
    __device__ void init(int G_, int c_) { G = G_; c = c_; }
    __device__ bool next(int i, pg8::Unit& u) const {
        const int s = i * G + c; if (s >= 88) return false;
        u.pm = 128 + (s & 1); u.pn = (s >> 1) & 3; u.kb = 4 * (s >> 3); u.nt = 4; return true;
    }
    __device__ __forceinline__ void a_ready(const pg8::Unit&) const {}
    __device__ __forceinline__ void done(const pg8::Unit&) const {}
};

template <bool PERMROWS>
__device__ __forceinline__ void transpose_item(const float* W, int K, int N, bf16_t* WT, const float* g, LAS float* scr, int item, int lane) {
    const int nblk = N / 32, kb = item / nblk, nb = item % nblk, k0 = 64 * kb, n0 = 32 * nb;
#pragma unroll 8
    for (int i = 0; i < 32; ++i) { const int kk = 2 * i + (lane >> 5); float v = W[(size_t)(k0 + kk) * N + n0 + (lane & 31)]; if (g) v *= g[k0 + kk]; scr[kk * 33 + (lane & 31)] = v; }
    asm volatile("s_waitcnt lgkmcnt(0)" ::: "memory");
    const int c = lane & 7;
#pragma unroll
    for (int j = 0; j < 4; ++j) {
        const int n = (lane >> 3) + 8 * j; const LAS float* s = scr + (8 * c) * 33 + n;
        u32x4 o; o.x = cvtpk(s[0 * 33], s[1 * 33]); o.y = cvtpk(s[2 * 33], s[3 * 33]); o.z = cvtpk(s[4 * 33], s[5 * 33]); o.w = cvtpk(s[6 * 33], s[7 * 33]);
        int nn = n0 + n;
        if (PERMROWS) { const int p = nn & 255; nn = (nn & ~255) + ((p >> 5) & 1) * 128 + (p >> 6) * 32 + (p & 31); }
        *(u32x4*)(WT + (size_t)nn * K + k0 + 8 * c) = o;
    }
    asm volatile("s_waitcnt lgkmcnt(0)" ::: "memory");
}

namespace att {
constexpr int KCH = 1040, KMAP = 8 * KCH;
constexpr int DA_K = 0, DA_V = 2 * KMAP, DA_VS = 320;
constexpr int SB_K = 0, SB_V = KMAP, SB_VS = 192;
constexpr int WSF = 37376, CTL = 39424, EXCH = 40960, EXS = 132;
constexpr int NU_DAS = 128, NU_SBS = 256, NU_DAP = 1024, NU_SBP = 1024, NUNITS = NU_DAS + NU_SBS + NU_DAP + NU_SBP;
constexpr float SB_THR = -88.0f;

__device__ __forceinline__ s16x4 vtr(lptr p) { return __builtin_bit_cast(s16x4, __builtin_amdgcn_ds_read_tr16_b64_v4i16((LAS v4i16_t*)p)); }
__device__ __forceinline__ int crow(int r, int hi) { return (r & 3) + 8 * (r >> 2) + 4 * hi; }
__device__ __forceinline__ void expand8(u32x4 w, f32x4& a, f32x4& b) { a[0] = bflo(w.x); a[1] = bfhi(w.x); a[2] = bflo(w.y); a[3] = bfhi(w.y); b[0] = bflo(w.z); b[1] = bfhi(w.z); b[2] = bflo(w.w); b[3] = bfhi(w.w); }

template <bool SAMPLE> struct DAStage;
template <> struct DAStage<false> {
    u32x4 k[2], v[2];
    __device__ __forceinline__ void load(const Params& p, const bf16_t* KA, const bf16_t* VA, int b, int h, int t, int tid) {
#pragma unroll
        for (int i = 0; i < 2; ++i) { const int id = tid + 512 * i, row = id >> 4, ch = id & 15; const size_t off = (size_t)(b * 2048 + 64 * t + row) * 512 + h * 128 + ch * 8;
            k[i] = *(const u32x4*)(KA + off); v[i] = *(const u32x4*)(VA + off); }
    }
    __device__ __forceinline__ void store(lptr lds, int tid) {
#pragma unroll
        for (int i = 0; i < 2; ++i) { const int id = tid + 512 * i, row = id >> 4, ch = id & 15;
            *(LAS u32x4*)(lds + DA_K + (ch >> 3) * KMAP + (ch & 7) * KCH + row * 16) = k[i]; *(LAS u32x4*)(lds + DA_V + row * DA_VS + ch * 16) = v[i]; }
    }
};
template <> struct DAStage<true> {
    f32x4 k[2][2], v[2][2];
    __device__ __forceinline__ void load(const Params& p, const bf16_t* KA, const bf16_t* VA, int b, int h, int t, int tid) {
#pragma unroll
        for (int i = 0; i < 2; ++i) { const int id = tid + 512 * i, row = id >> 4, ch = id & 15;
            if (t < 32) { const size_t off = ((size_t)(b * 2048 + 64 * t + row) * 4 + h) * 128 + ch * 8;
                k[i][0] = *(const f32x4*)(p.cdk + off); k[i][1] = *(const f32x4*)(p.cdk + off + 4); v[i][0] = *(const f32x4*)(p.cdv + off); v[i][1] = *(const f32x4*)(p.cdv + off + 4); }
            else if (row < 16) { const size_t off = (size_t)(M_P + b * 16 + row) * 512 + h * 128 + ch * 8; expand8(*(const u32x4*)(KA + off), k[i][0], k[i][1]); expand8(*(const u32x4*)(VA + off), v[i][0], v[i][1]); }
            else { k[i][0] = k[i][1] = v[i][0] = v[i][1] = (f32x4){0.f, 0.f, 0.f, 0.f}; } }
    }
    __device__ __forceinline__ void store(lptr lds, int tid) {
#pragma unroll
        for (int i = 0; i < 2; ++i) { const int id = tid + 512 * i, row = id >> 4, ch = id & 15;
            *(LAS u32x4*)(lds + DA_K + (ch >> 3) * KMAP + (ch & 7) * KCH + row * 16) = pack8(k[i][0], k[i][1]); *(LAS u32x4*)(lds + DA_V + row * DA_VS + ch * 16) = pack8(v[i][0], v[i][1]); }
    }
};
template <bool SAMPLE> struct SBStage;
template <> struct SBStage<false> {
    u32x4 k, v;
    __device__ __forceinline__ void load(const Params& p, const bf16_t* KB, const bf16_t* VB, int b, int h, int t, int tid) {
        const int row = tid >> 3, ch = tid & 7; const size_t off = (size_t)(b * 2048 + 64 * t + row) * 512 + h * 64 + ch * 8;
        k = *(const u32x4*)(KB + off); v = *(const u32x4*)(VB + off);
    }
    __device__ __forceinline__ void store(lptr lds, int tid) {
        const int row = tid >> 3, ch = tid & 7;
        *(LAS u32x4*)(lds + SB_K + ch * KCH + row * 16) = k; *(LAS u32x4*)(lds + SB_V + row * SB_VS + ch * 16) = v;
    }
};
template <> struct SBStage<true> {
    f32x4 k[2], v[2];
    __device__ __forceinline__ void load(const Params& p, const bf16_t* KB, const bf16_t* VB, int b, int h, int t, int tid) {
        const int row = tid >> 3, ch = tid & 7;
        if (t < 32) { const size_t off = ((size_t)(b * 2048 + 64 * t + row) * 8 + h) * 64 + ch * 8;
            k[0] = *(const f32x4*)(p.csk + off); k[1] = *(const f32x4*)(p.csk + off + 4); v[0] = *(const f32x4*)(p.csv + off); v[1] = *(const f32x4*)(p.csv + off + 4); }
        else if (row < 16) { const size_t off = (size_t)(M_P + b * 16 + row) * 512 + h * 64 + ch * 8; expand8(*(const u32x4*)(KB + off), k[0], k[1]); expand8(*(const u32x4*)(VB + off), v[0], v[1]); }
        else { k[0] = k[1] = v[0] = v[1] = (f32x4){0.f, 0.f, 0.f, 0.f}; }
    }
    __device__ __forceinline__ void store(lptr lds, int tid) {
        const int row = tid >> 3, ch = tid & 7;
        *(LAS u32x4*)(lds + SB_K + ch * KCH + row * 16) = pack8(k[0], k[1]); *(LAS u32x4*)(lds + SB_V + row * SB_VS + ch * 16) = pack8(v[0], v[1]);
    }
};

#define MFMA32(a, b, c) __builtin_amdgcn_mfma_f32_32x32x16_bf16((a), (b), (c), 0, 0, 0)

template <bool SAMPLE>
__device__ __forceinline__ void da_unit(lptr lds, const Params& p, const bf16_t* zA, bf16_t* OA, int b, int h, int qblk, float lam) {
    const int tid = threadIdx.x, lane = tid & 63, r32 = lane & 31, hi = lane >> 5, wid = __builtin_amdgcn_readfirstlane(tid >> 6), c = wid & 1, sub = wid >> 1;
    const bf16_t* QA = zA; const bf16_t* KA = zA + ZSEC; const bf16_t* VA = zA + 2 * ZSEC;
    const size_t qrow = SAMPLE ? (size_t)(M_P + b * 16 + (r32 & 15)) : (size_t)(b * 2048 + qblk * 128 + sub * 32 + r32);
    bf16x8 qr[4];
#pragma unroll
    for (int d0 = 0; d0 < 4; ++d0) qr[d0] = *(const bf16x8*)(QA + qrow * 512 + h * 128 + c * 64 + d0 * 16 + hi * 8);
    const int nt = SAMPLE ? 33 : 2 * qblk + 2;
    const int ntw = SAMPLE ? (sub == 0 ? 33 : 0) : 2 * qblk + 1 + (sub >> 1);
    f32x16 o[4];
#pragma unroll
    for (int i = 0; i < 4; ++i) o[i] = f32x16{};
    float m = -1e30f, l = 0.f;
    LAS float* wsf = (LAS float*)(lds + WSF) + wid * 64;
    const int vlane = ((lane >> 4) & 1) * 32 + (lane & 3) * 8 + (4 * hi + ((lane & 15) >> 2)) * DA_VS;
    DAStage<SAMPLE> st;
    st.load(p, KA, VA, b, h, 0, tid);
    for (int t = 0; t < nt; ++t) {
        __syncthreads();
        st.store(lds, tid);
        __syncthreads();
        if (t + 1 < nt) st.load(p, KA, VA, b, h, t + 1, tid);
        if (t < ntw) {
            f32x16 p0 = f32x16{}, p1 = f32x16{};
#pragma unroll
            for (int d0 = 0; d0 < 4; ++d0) {
                lptr ka = lds + DA_K + c * KMAP + (2 * d0 + hi) * KCH + r32 * 16;
                const bf16x8 b0 = *(const LAS bf16x8*)ka, b1 = *(const LAS bf16x8*)(ka + 512);
                p0 = MFMA32(b0, qr[d0], p0); p1 = MFMA32(b1, qr[d0], p1);
            }
            if (SAMPLE && t == 32) {
#pragma unroll
                for (int r = 8; r < 16; ++r) p0[r] = -1e30f;
#pragma unroll
                for (int r = 0; r < 16; ++r) p1[r] = -1e30f;
            }
            float rm = fmaxf(p0[0], p1[0]);
#pragma unroll
            for (int r = 1; r < 16; ++r) rm = fmaxf(rm, fmaxf(p0[r], p1[r]));
            rm = fmaxf(rm, __shfl_xor(rm, 32));
            const float mn = fmaxf(m, rm);
            if (__any(mn > m)) {
                const float alpha = fexp2(m - mn); l *= alpha;
                if (hi == 0) wsf[r32] = alpha;
                asm volatile("s_waitcnt lgkmcnt(0)" ::: "memory");
                float f[16];
#pragma unroll
                for (int r = 0; r < 16; ++r) f[r] = wsf[crow(r, hi)];
#pragma unroll
                for (int d0 = 0; d0 < 4; ++d0)
#pragma unroll
                    for (int r = 0; r < 16; ++r) o[d0][r] *= f[r];
                asm volatile("s_waitcnt lgkmcnt(0)" ::: "memory");
            }
            m = mn;
            float ls = 0.f;
#pragma unroll
            for (int r = 0; r < 16; ++r) { p0[r] = fexp2(p0[r] - m); p1[r] = fexp2(p1[r] - m); ls += p0[r] + p1[r]; }
            l += ls;
            bf16x8 pw[4];
            { u32x4 w;
              w.x = cvtpk(p0[0], p0[1]); w.y = cvtpk(p0[2], p0[3]); w.z = cvtpk(p0[4], p0[5]); w.w = cvtpk(p0[6], p0[7]); pw[0] = __builtin_bit_cast(bf16x8, w);
              w.x = cvtpk(p0[8], p0[9]); w.y = cvtpk(p0[10], p0[11]); w.z = cvtpk(p0[12], p0[13]); w.w = cvtpk(p0[14], p0[15]); pw[1] = __builtin_bit_cast(bf16x8, w);
              w.x = cvtpk(p1[0], p1[1]); w.y = cvtpk(p1[2], p1[3]); w.z = cvtpk(p1[4], p1[5]); w.w = cvtpk(p1[6], p1[7]); pw[2] = __builtin_bit_cast(bf16x8, w);
              w.x = cvtpk(p1[8], p1[9]); w.y = cvtpk(p1[10], p1[11]); w.z = cvtpk(p1[12], p1[13]); w.w = cvtpk(p1[14], p1[15]); pw[3] = __builtin_bit_cast(bf16x8, w); }
#pragma unroll
            for (int d0 = 0; d0 < 4; ++d0)
#pragma unroll
                for (int ks = 0; ks < 4; ++ks) {
                    lptr va = lds + DA_V + vlane + ks * 16 * DA_VS + d0 * 64;
                    const s16x4 lo = vtr(va), hh = vtr(va + 8 * DA_VS);
                    const bf16x8 vf = (bf16x8){lo[0], lo[1], lo[2], lo[3], hh[0], hh[1], hh[2], hh[3]};
                    o[d0] = MFMA32(pw[ks], vf, o[d0]);
                }
        }
    }
    l += __shfl_xor(l, 32);
    const bool live = !SAMPLE || sub == 0;
    if (live) {
        const float fac = (c == 0) ? frcp(l) : lam * frcp(l);
        if (hi == 0) wsf[r32] = fac;
        asm volatile("s_waitcnt lgkmcnt(0)" ::: "memory");
        float f[16];
#pragma unroll
        for (int r = 0; r < 16; ++r) f[r] = wsf[crow(r, hi)];
#pragma unroll
        for (int d0 = 0; d0 < 4; ++d0)
#pragma unroll
            for (int r = 0; r < 16; ++r) o[d0][r] *= f[r];
    }
    LAS float* ex = (LAS float*)(lds + EXCH) + sub * 32 * EXS;
    if (live && c == 1) {
#pragma unroll
        for (int d0 = 0; d0 < 4; ++d0)
#pragma unroll
            for (int r = 0; r < 16; ++r) ex[crow(r, hi) * EXS + d0 * 32 + r32] = o[d0][r];
    }
    __syncthreads();
    if (live && c == 0) {
#pragma unroll
        for (int d0 = 0; d0 < 4; ++d0)
#pragma unroll
            for (int r = 0; r < 16; ++r) { LAS float* e = ex + crow(r, hi) * EXS + d0 * 32 + r32; *e = o[d0][r] - *e; }
    }
    __syncthreads();
    if (live) {
        const f32x2 g = *(const f32x2*)(p.subln_g + 2 * lane);
#pragma unroll 4
        for (int rr = 0; rr < 16; ++rr) {
            const int row = c * 16 + rr;
            const f32x2 v = *(const LAS f32x2*)(ex + row * EXS + 2 * lane);
            const float ss = wave_sum(v.x * v.x + v.y * v.y);
            const float rs = rsqrtf(ss * (1.f / 128.f) + NEPS) * 0.8f;
            const bool ok = !SAMPLE || row < 16;
            const size_t grow = SAMPLE ? (size_t)(M_P + b * 16 + row) : (size_t)(b * 2048 + qblk * 128 + sub * 32 + row);
            if (ok) *(unsigned*)(OA + grow * 512 + h * 128 + 2 * lane) = cvtpk(v.x * rs * g.x, v.y * rs * g.y);
        }
    }
}

template <bool SAMPLE>
__device__ __forceinline__ void sb_unit(lptr lds, const Params& p, const bf16_t* zA, bf16_t* OB, int b, int h, int qblk) {
    const int tid = threadIdx.x, lane = tid & 63, r32 = lane & 31, hi = lane >> 5, wid = __builtin_amdgcn_readfirstlane(tid >> 6);
    const bf16_t* QB = zA + 3 * ZSEC; const bf16_t* KB = zA + 4 * ZSEC; const bf16_t* VB = zA + 5 * ZSEC;
    const int qw = SAMPLE ? 2048 : qblk * 256 + wid * 32;
    const int qpos = SAMPLE ? 2048 + (r32 & 15) : qw + r32;
    const size_t qrow = SAMPLE ? (size_t)(M_P + b * 16 + (r32 & 15)) : (size_t)(b * 2048 + qpos);
    bf16x8 qr[4];
#pragma unroll
    for (int d0 = 0; d0 < 4; ++d0) qr[d0] = *(const bf16x8*)(QB + qrow * 512 + h * 64 + d0 * 16 + hi * 8);
    const int t_hi = SAMPLE ? 32 : 4 * qblk + 3;
    const int tw = qw >> 6;
    const bool active = !SAMPLE || wid == 0;
    f32x16 o[2]; o[0] = f32x16{}; o[1] = f32x16{};
    float R = 0.f;
    bool mydone = !active;
    LAS int* flags = (LAS int*)(lds + CTL);
    if (lane == 0) flags[wid] = mydone ? 1 : 0;
    const int vlane = ((lane >> 4) & 1) * 32 + (lane & 3) * 8 + (4 * hi + ((lane & 15) >> 2)) * SB_VS;
    SBStage<SAMPLE> st;
    st.load(p, KB, VB, b, h, t_hi, tid);
    for (int t = t_hi; t >= 0; --t) {
        __syncthreads();
        { int nd = 0;
#pragma unroll
          for (int w = 0; w < 8; ++w) nd += flags[w];
          if (nd == 8) break; }
        st.store(lds, tid);
        __syncthreads();
        if (t > 0) st.load(p, KB, VB, b, h, t - 1, tid);
        if (!mydone && t <= tw) {
            f32x16 p0 = f32x16{}, p1 = f32x16{};
#pragma unroll
            for (int d0 = 0; d0 < 4; ++d0) {
                lptr ka = lds + SB_K + (2 * d0 + hi) * KCH + r32 * 16;
                const bf16x8 b0 = *(const LAS bf16x8*)ka, b1 = *(const LAS bf16x8*)(ka + 512);
                p0 = MFMA32(b0, qr[d0], p0); p1 = MFMA32(b1, qr[d0], p1);
            }
            float x[32], lk[32];
#pragma unroll
            for (int r = 0; r < 16; ++r) { x[r] = p0[r]; x[16 + r] = p1[r]; }
            const int kb = 64 * t + 4 * hi;
#pragma unroll
            for (int i = 0; i < 32; ++i) {
                const float z = x[i];
                const float e = fexp2(-fabsf(z) * L2E);
                const float sp = fmaxf(z, 0.f) + LN2 * flog2(1.f + e);
                const bool msk = (kb + 8 * (i >> 2) + (i & 3)) < qpos;
                lk[i] = msk ? -sp : 0.f;
                x[i] = msk ? (z - sp) : -1e30f;
            }
            float gs[8], gp[8];
#pragma unroll
            for (int k = 0; k < 8; ++k) { gs[k] = (lk[4 * k] + lk[4 * k + 1]) + (lk[4 * k + 2] + lk[4 * k + 3]); gp[k] = __shfl_xor(gs[k], 32); }
            float run = R;
#pragma unroll
            for (int k = 7; k >= 0; --k) {
                const float c3 = run + (hi == 0 ? gp[k] : 0.f), c2 = c3 + lk[4 * k + 3], c1 = c2 + lk[4 * k + 2], c0 = c1 + lk[4 * k + 1];
                x[4 * k + 3] += c3; x[4 * k + 2] += c2; x[4 * k + 1] += c1; x[4 * k] += c0;
                run += gs[k] + gp[k];
            }
            R = run;
#pragma unroll
            for (int i = 0; i < 32; ++i) x[i] = fexp2(x[i] * L2E);
            bf16x8 pw[4];
#pragma unroll
            for (int ks = 0; ks < 4; ++ks) { u32x4 w; w.x = cvtpk(x[8 * ks], x[8 * ks + 1]); w.y = cvtpk(x[8 * ks + 2], x[8 * ks + 3]); w.z = cvtpk(x[8 * ks + 4], x[8 * ks + 5]); w.w = cvtpk(x[8 * ks + 6], x[8 * ks + 7]); pw[ks] = __builtin_bit_cast(bf16x8, w); }
#pragma unroll
            for (int d0 = 0; d0 < 2; ++d0)
#pragma unroll
                for (int ks = 0; ks < 4; ++ks) {
                    lptr va = lds + SB_V + vlane + ks * 16 * SB_VS + d0 * 64;
                    const s16x4 lo = vtr(va), hh = vtr(va + 8 * SB_VS);
                    const bf16x8 vf = (bf16x8){lo[0], lo[1], lo[2], lo[3], hh[0], hh[1], hh[2], hh[3]};
                    o[d0] = MFMA32(pw[ks], vf, o[d0]);
                }
            if (__all(R < SB_THR)) { mydone = true; if (lane == 0) flags[wid] = 1; }
        }
    }
    __syncthreads();
    if (active) {
#pragma unroll
        for (int d0 = 0; d0 < 2; ++d0)
#pragma unroll
            for (int r = 0; r < 16; ++r) {
                const int q = crow(r, hi);
                const bool ok = !SAMPLE || q < 16;
                const size_t grow = SAMPLE ? (size_t)(M_P + b * 16 + q) : (size_t)(b * 2048 + qw + q);
                if (ok) OB[grow * 512 + h * 64 + d0 * 32 + r32] = (bf16_t)(cvtpk(o[d0][r], 0.f) & 0xffffu);
            }
    }
}

__device__ __forceinline__ void attention_phase(lptr lds, const Params& p, unsigned* counter) {
    const int tid = threadIdx.x, lane = tid & 63;
    bf16_t* zA = (bf16_t*)(p.ws + WS_A);
    bf16_t* OA = zA + 10 * ZSEC; bf16_t* OB = zA + 11 * ZSEC;
    const float d1 = wave_sum(p.lq1[lane] * p.lk1[lane]), d2 = wave_sum(p.lq2[lane] * p.lk2[lane]);
    const float lam = expf(d1) - expf(d2) + 0.2f;
    LAS int* ctl = (LAS int*)(lds + CTL);
    for (;;) {
        __syncthreads();
        if (tid == 0) ctl[8] = (int)atomicAdd(counter, 1u);
        __syncthreads();
        int u = __builtin_amdgcn_readfirstlane(ctl[8]);
        if (u >= NUNITS) break;
        if (u < NU_DAS) { da_unit<true>(lds, p, zA, OA, u >> 2, u & 3, 0, lam); continue; }
        u -= NU_DAS;
        if (u < NU_SBS) { sb_unit<true>(lds, p, zA, OB, u >> 3, u & 7, 0); continue; }
        u -= NU_SBS;
        if (u < NU_DAP) { const int bh = u & 63; da_unit<false>(lds, p, zA, OA, bh >> 2, bh & 3, 15 - (u >> 6), lam); continue; }
        u -= NU_DAP;
        { const int bh = u & 127; sb_unit<false>(lds, p, zA, OB, bh >> 3, bh & 7, 7 - (u >> 7)); }
    }
}
#undef MFMA32
}

#define XB_TMO      128
#define XB_XCNT(j)  (256  + 64 * (j))
#define XB_XSUB(j)  (1280 + 64 * (j))
#define XB_XGEN(j)  (2304 + 64 * (j))
#define XB_TOP      3328
#define XB_TOPGEN   3392
#define XCD_BAR_WORDS 3456
#define XB_SPIN_CAP (1u << 18)

__device__ __forceinline__ unsigned xb_ld(unsigned* p)              { return __hip_atomic_load(p, __ATOMIC_RELAXED, __HIP_MEMORY_SCOPE_AGENT); }
__device__ __forceinline__ unsigned xb_add(unsigned* p, unsigned v) { return __hip_atomic_fetch_add(p, v, __ATOMIC_RELAXED, __HIP_MEMORY_SCOPE_AGENT); }
__device__ __forceinline__ unsigned xb_xcc_id() { return (unsigned)__builtin_amdgcn_s_getreg((3 << 11) | 20) & 0xFu; }
#define XB_SPIN(cond, bar) do { unsigned _sp = 0; while (cond) { __builtin_amdgcn_s_sleep(1); \
    if ((++_sp & 255u) == 0u) { if (xb_ld(&(bar)[XB_TMO])) break; if (_sp > XB_SPIN_CAP) { atomicAdd(&(bar)[XB_TMO], 1u); break; } } } } while (0)

struct XcdBarrier {
    unsigned* bar; unsigned x;
    volatile LAS unsigned* st;
};

__device__ __forceinline__ XcdBarrier xcd_barrier_post(unsigned* bar, volatile LAS unsigned* st) {
    XcdBarrier b; b.bar = bar; b.x = xb_xcc_id(); b.st = st;
    if (threadIdx.x == 0) (void)xb_add(&bar[XB_XCNT(b.x)], 1u);
    return b;
}
__device__ __forceinline__ void xcd_barrier_complete(unsigned* bar, unsigned x, unsigned& nloc, unsigned& nx) {
    const unsigned G = gridDim.x * gridDim.y * gridDim.z;
    unsigned sum, cnt, mine, sp = 0u;
    for (;;) {
        sum = 0u; cnt = 0u; mine = 0u;
#pragma unroll
        for (unsigned j = 0; j < 16; ++j) { const unsigned c = xb_ld(&bar[XB_XCNT(j)]); sum += c; cnt += (c > 0u) ? 1u : 0u; mine = (j == x) ? c : mine; }
        if (sum == G) break;
        __builtin_amdgcn_s_sleep(1);
        if ((++sp & 255u) == 0u) { if (xb_ld(&bar[XB_TMO])) break; if (sp > XB_SPIN_CAP) { atomicAdd(&bar[XB_TMO], 1u); break; } }
    }
    nloc = mine > 0u ? mine : 1u; nx = cnt > 0u ? cnt : 1u;
}

__device__ __forceinline__ void xcd_barrier(const XcdBarrier& b) {
    asm volatile("s_waitcnt vmcnt(0)" ::: "memory");
    __syncthreads();
    if (threadIdx.x == 0) {
        unsigned* bar = b.bar;
        __builtin_amdgcn_s_waitcnt(0);
        unsigned nloc = b.st[0], nx = b.st[1];
        if (nloc == 0u) { xcd_barrier_complete(bar, b.x, nloc, nx); b.st[0] = nloc; b.st[1] = nx; }
        const unsigned old = xb_add(&bar[XB_XSUB(b.x)], 1u);
        const unsigned gen = old / nloc;
        if (old + 1u == (gen + 1u) * nloc) {
            __builtin_amdgcn_fence(__ATOMIC_RELEASE, "agent");
            asm volatile("s_waitcnt vmcnt(0)" ::: "memory");
            const unsigned og = xb_add(&bar[XB_TOP], 1u);
            const unsigned tg = og / nx;
            if (og + 1u == (tg + 1u) * nx) xb_add(&bar[XB_TOPGEN], 1u);
            else XB_SPIN(xb_ld(&bar[XB_TOPGEN]) == tg, bar);
            __builtin_amdgcn_fence(__ATOMIC_ACQUIRE, "agent");
            xb_add(&bar[XB_XGEN(b.x)], 1u);
            asm volatile("s_waitcnt vmcnt(0)" ::: "memory");
        } else {
            XB_SPIN(xb_ld(&bar[XB_XGEN(b.x)]) == gen, bar);
            __builtin_amdgcn_fence(__ATOMIC_ACQUIRE, "agent");
            asm volatile("s_waitcnt vmcnt(0)" ::: "memory");
        }
    }
    __syncthreads();
}

constexpr int LDS_BYTES = 147456;
__global__ void __launch_bounds__(512, 2) fwd_megakernel(Params p) {
    extern __shared__ __attribute__((aligned(16))) unsigned char lds_raw[];
    lptr lds = (lptr)lds_raw;
    cg::grid_group grid = cg::this_grid();
    const int tid = threadIdx.x, lane = tid & 63, wave = __builtin_amdgcn_readfirstlane(tid >> 6);
    const int G = gridDim.x, gw = blockIdx.x * 8 + wave, NGW = G * 8;
    unsigned char* ws = p.ws;
    float* rstd1 = (float*)(ws + WS_RSTD); float* ssq1 = (float*)(ws + WS_SSQ1);
    bf16_t* WinT = (bf16_t*)(ws + WS_WIN); bf16_t* WaT = (bf16_t*)(ws + WS_WA); bf16_t* WbT = (bf16_t*)(ws + WS_WB); bf16_t* WoutT = (bf16_t*)(ws + WS_WOUT);
    bf16_t* WupT = (bf16_t*)(ws + WS_WUP); bf16_t* WdnT = (bf16_t*)(ws + WS_WDN);
    bf16_t* zA = (bf16_t*)(ws + WS_A); bf16_t* U = zA;
    bf16_t* XB = (bf16_t*)(ws + WS_B); bf16_t* MG = XB + (size_t)M_TOK * 1024; bf16_t* H = XB;
    bf16_t* X1B = (bf16_t*)(ws + WS_X1B);
    unsigned* counter = (unsigned*)(ws + WS_CTL);
    volatile LAS unsigned* bst = (volatile LAS unsigned*)(lds + 131072 + 512);
    if (tid == 0) { bst[0] = 0u; bst[1] = 0u; }
    __syncthreads();

    {
        if (blockIdx.x == 0) for (int i = tid; i < 4096; i += 512) counter[i] = 0u;
        LAS float* scr = (LAS float*)(lds + wave * 16384);
        constexpr int I_IN = 16 * 160, I_A = 8 * 32, I_O = 16 * 32, I_UP = 16 * 176, I_DN = 44 * 32, NITEMS = I_IN + 2 * I_A + I_O + I_UP + I_DN;
        for (int it = gw; it < NITEMS; it += NGW) {
            int r = it;
            if (r < I_IN) { transpose_item<true>(p.w_in, 1024, NIN, WinT, p.attn_g, scr, r, lane); continue; } r -= I_IN;
            if (r < I_A) { transpose_item<false>(p.w_a, 512, 1024, WaT, nullptr, scr, r, lane); continue; } r -= I_A;
            if (r < I_A) { transpose_item<false>(p.w_b, 512, 1024, WbT, nullptr, scr, r, lane); continue; } r -= I_A;
            if (r < I_O) { transpose_item<false>(p.w_out, 1024, 1024, WoutT, nullptr, scr, r, lane); continue; } r -= I_O;
            if (r < I_UP) { transpose_item<false>(p.w_up, 1024, NUP, WupT, p.ffn_g, scr, r, lane); continue; } r -= I_UP;
            transpose_item<false>(p.w_down, DFF, 1024, WdnT, nullptr, scr, r, lane);
        }
        for (int row = gw; row < M_TOK; row += NGW) {
            const float* xr = row < M_P ? p.x_prompt + (size_t)row * 1024 : p.x_sample + (size_t)(row - M_P) * 1024;
            f32x4 v[4]; float s = 0.f;
#pragma unroll
            for (int j = 0; j < 4; ++j) { v[j] = *(const f32x4*)(xr + 4 * lane + 256 * j); s += (v[j][0] * v[j][0] + v[j][1] * v[j][1]) + (v[j][2] * v[j][2] + v[j][3] * v[j][3]); }
            s = wave_sum(s);
            if (lane == 0) rstd1[row] = rsqrtf(s * (1.f / 1024.f) + NEPS);
#pragma unroll
            for (int j = 0; j < 4; ++j) { u32x2 w; w.x = cvtpk(v[j][0], v[j][1]); w.y = cvtpk(v[j][2], v[j][3]); *(u32x2*)(XB + (size_t)row * 1024 + 4 * lane + 256 * j) = w; }
        }
    }
    grid.sync();
    const XcdBarrier xbar = xcd_barrier_post(counter + 256, bst);
    {
        pg8::Gemm g{XB, WinT, M_TOK, NIN, 1024}; pg8::StaticOrder S; S.init(M_TOK, NIN, G, (int)blockIdx.x);
        EpiIn E{rstd1, zA, p.out};
        pg8::gemm_phase<EpiIn, pg8::StaticOrder, true, true>(lds, g, S, E);
    }
    xcd_barrier(xbar);
    att::attention_phase(lds, p, counter);
    xcd_barrier(xbar);
    {
        pg8::Gemm g{zA + 10 * ZSEC, WaT, M_TOK, 1024, 512}; pg8::StaticOrder S; S.init(M_TOK, 1024, G, (int)blockIdx.x);
        EpiMerge<true> E{zA + 6 * ZSEC, MG};
        pg8::gemm_phase<EpiMerge<true>, pg8::StaticOrder, true, true>(lds, g, S, E);
    }
    {
        pg8::Gemm g{zA + 11 * ZSEC, WbT, M_TOK, 1024, 512}; pg8::StaticOrder S; S.init(M_TOK, 1024, G, (int)blockIdx.x);
        EpiMerge<false> E{zA + 8 * ZSEC, MG};
        pg8::gemm_phase<EpiMerge<false>, pg8::StaticOrder, true, true>(lds, g, S, E);
    }
    xcd_barrier(xbar);
    {
        pg8::Gemm g{MG, WoutT, M_TOK, 1024, 1024}; pg8::StaticOrder S; S.init(M_TOK, 1024, G, (int)blockIdx.x);
        EpiRes<true> E{p.x_prompt, p.x_sample, p.out + O_Y, X1B, ssq1};
        pg8::gemm_phase<EpiRes<true>, pg8::StaticOrder, true, true>(lds, g, S, E);
    }
    xcd_barrier(xbar);
    {
        pg8::Gemm g{X1B, WupT, M_TOK, NUP, 1024}; pg8::StaticOrder S; S.init(M_TOK, NUP, G, (int)blockIdx.x);
        EpiUp E{ssq1, U, p.out};
        pg8::gemm_phase<EpiUp, pg8::StaticOrder, true, true>(lds, g, S, E);
    }
    xcd_barrier(xbar);
    {
        constexpr int NCH = DFF / 8, TOTAL = (M_TOK / 16) * NCH;
        for (int it = blockIdx.x * 512 + tid; it < TOTAL; it += G * 512) {
            const int run = it / NCH, ch = it - run * NCH, row0 = run * 16, j0 = ch * 8;
            const bool samp = row0 >= M_P; const int t0 = samp ? 0 : (row0 & 2047);
            float wg[3][8], wv[3][8], bg[8], bv[8];
#pragma unroll
            for (int j = 0; j < 3; ++j)
#pragma unroll
                for (int e = 0; e < 8; ++e) { wg[j][e] = p.conv_w[j * NUP + j0 + e]; wv[j][e] = p.conv_w[j * NUP + DFF + j0 + e]; }
#pragma unroll
            for (int e = 0; e < 8; ++e) { bg[e] = p.conv_b[j0 + e]; bv[e] = p.conv_b[DFF + j0 + e]; }
            f32x4 g2[2], g1[2], v2[2], v1[2];
            if (t0 == 0) {
                if (samp) { const float* sc = p.state_conv + (size_t)((row0 - M_P) >> 4) * 2 * NUP;
                    g2[0] = *(const f32x4*)(sc + j0); g2[1] = *(const f32x4*)(sc + j0 + 4); v2[0] = *(const f32x4*)(sc + DFF + j0); v2[1] = *(const f32x4*)(sc + DFF + j0 + 4);
                    g1[0] = *(const f32x4*)(sc + NUP + j0); g1[1] = *(const f32x4*)(sc + NUP + j0 + 4); v1[0] = *(const f32x4*)(sc + NUP + DFF + j0); v1[1] = *(const f32x4*)(sc + NUP + DFF + j0 + 4);
                } else { g2[0] = g2[1] = g1[0] = g1[1] = v2[0] = v2[1] = v1[0] = v1[1] = (f32x4){0.f, 0.f, 0.f, 0.f}; }
            } else {
                att::expand8(*(const u32x4*)(U + (size_t)(row0 - 2) * NUP + j0), g2[0], g2[1]); att::expand8(*(const u32x4*)(U + (size_t)(row0 - 2) * NUP + DFF + j0), v2[0], v2[1]);
                att::expand8(*(const u32x4*)(U + (size_t)(row0 - 1) * NUP + j0), g1[0], g1[1]); att::expand8(*(const u32x4*)(U + (size_t)(row0 - 1) * NUP + DFF + j0), v1[0], v1[1]);
            }
#pragma unroll 4
            for (int r = 0; r < 16; ++r) {
                f32x4 g0[2], v0[2];
                att::expand8(*(const u32x4*)(U + (size_t)(row0 + r) * NUP + j0), g0[0], g0[1]); att::expand8(*(const u32x4*)(U + (size_t)(row0 + r) * NUP + DFF + j0), v0[0], v0[1]);
                f32x4 hh[2];
#pragma unroll
                for (int q = 0; q < 2; ++q)
#pragma unroll
                    for (int e = 0; e < 4; ++e) {
                        const int i = 4 * q + e;
                        const float cgt = bg[i] + wg[0][i] * g2[q][e] + wg[1][i] * g1[q][e] + wg[2][i] * g0[q][e];
                        const float cvl = bv[i] + wv[0][i] * v2[q][e] + wv[1][i] * v1[q][e] + wv[2][i] * v0[q][e];
                        hh[q][e] = cgt * sigmoidf_(cgt) * cvl;
                    }
                *(u32x4*)(H + (size_t)(row0 + r) * DFF + j0) = pack8(hh[0], hh[1]);
                g2[0] = g1[0]; g2[1] = g1[1]; v2[0] = v1[0]; v2[1] = v1[1]; g1[0] = g0[0]; g1[1] = g0[1]; v1[0] = v0[0]; v1[1] = v0[1];
            }
        }
    }
    xcd_barrier(xbar);
    {
        pg8::Gemm g{H, WdnT, M_TOK, 1024, DFF}; pg8::StaticOrder S; S.init(M_P, 1024, G, (int)blockIdx.x);
        EpiDown E{p.out + O_Y, (float*)(ws + WS_A)};
        pg8::gemm_phase<EpiDown, pg8::StaticOrder, true, true>(lds, g, S, E);
        DownOrder S2; S2.init(G, (int)blockIdx.x);
        pg8::gemm_phase<EpiDown, DownOrder, true, true, 4>(lds, g, S2, E);
    }
    xcd_barrier(xbar);
    for (int row = gw; row < M_TOK; row += NGW) {
        float* yr = p.out + O_Y + (size_t)row * 1024;
        f32x4 v[4]; float s = 0.f;
#pragma unroll
        for (int j = 0; j < 4; ++j) {
            v[j] = *(const f32x4*)(yr + 4 * lane + 256 * j);
            if (row >= M_P) {
#pragma unroll
                for (int ks = 0; ks < 11; ++ks) v[j] += *(const f32x4*)((const float*)(ws + WS_A) + ((size_t)ks * 512 + (row - M_P)) * 1024 + 4 * lane + 256 * j);
            }
            s += (v[j][0] * v[j][0] + v[j][1] * v[j][1]) + (v[j][2] * v[j][2] + v[j][3] * v[j][3]);
        }
        const float rs = rsqrtf(wave_sum(s) * (1.f / 1024.f) + NEPS);
#pragma unroll
        for (int j = 0; j < 4; ++j) { const int c = 4 * lane + 256 * j; const f32x4 g = *(const f32x4*)(p.final_g + c); *(f32x4*)(yr + c) = v[j] * rs * g; }
    }
}

extern "C" void kernel_launch(void* const* d_in, const int* in_sizes, int n_in, void* d_out, int out_size, void* d_ws, size_t ws_size, hipStream_t stream) {
    static int grid = 0;
    if (grid == 0) {
        if (n_in != 23 || (size_t)out_size != O_END || ws_size < WS_END) { fprintf(stderr, "kernel_launch: unexpected sizes n_in %d out %d ws %zu (need %zu)\n", n_in, out_size, ws_size, (size_t)WS_END); grid = -1; return; }
        int dev = 0, cus = 0, per_cu = 0;
        hipGetDevice(&dev); hipDeviceGetAttribute(&cus, hipDeviceAttributeMultiprocessorCount, dev);
        if (hipFuncSetAttribute((const void*)fwd_megakernel, hipFuncAttributeMaxDynamicSharedMemorySize, LDS_BYTES) != hipSuccess) { fprintf(stderr, "kernel_launch: hipFuncSetAttribute failed\n"); grid = -1; return; }
        if (hipOccupancyMaxActiveBlocksPerMultiprocessor(&per_cu, (const void*)fwd_megakernel, 512, LDS_BYTES) != hipSuccess || per_cu < 1) { fprintf(stderr, "kernel_launch: occupancy query says %d\n", per_cu); per_cu = 1; }
        (void)hipGetLastError();
        grid = cus * 1;
    }
    if (grid < 0) return;
    Params p{};
    p.x_prompt = (const float*)d_in[0]; p.x_sample = (const float*)d_in[1]; p.cdk = (const float*)d_in[2]; p.cdv = (const float*)d_in[3]; p.csk = (const float*)d_in[4]; p.csv = (const float*)d_in[5];
    p.state_conv = (const float*)d_in[6]; p.attn_g = (const float*)d_in[7]; p.w_in = (const float*)d_in[8]; p.lq1 = (const float*)d_in[9]; p.lk1 = (const float*)d_in[10]; p.lq2 = (const float*)d_in[11];
    p.lk2 = (const float*)d_in[12]; p.subln_g = (const float*)d_in[13]; p.w_a = (const float*)d_in[14]; p.w_b = (const float*)d_in[15]; p.w_out = (const float*)d_in[16]; p.ffn_g = (const float*)d_in[17];
    p.w_up = (const float*)d_in[18]; p.conv_w = (const float*)d_in[19]; p.conv_b = (const float*)d_in[20]; p.w_down = (const float*)d_in[21]; p.final_g = (const float*)d_in[22];
    p.out = (float*)d_out; p.ws = (unsigned char*)d_ws;
    void* args[] = {&p};
    hipError_t e = hipLaunchCooperativeKernel((const void*)fwd_megakernel, dim3(grid), dim3(512), args, LDS_BYTES, stream);
    if (e != hipSuccess) fprintf(stderr, "cooperative launch failed: %s (grid %d)\n", hipGetErrorString(e), grid);
}
```

```cpp
#include <hip/hip_runtime.h>
#include <hip/hip_cooperative_groups.h>
#include <cstdio>
#include <cstdint>
namespace cg = cooperative_groups;
__device__ __forceinline__ int tid_fresh() { int t = (int)threadIdx.x; asm volatile("" : "+v"(t)); return t; }
namespace pg8 {
#define PG8_LAS __attribute__((address_space(3)))
typedef unsigned short bf16_t;
typedef short bf16x8 __attribute__((ext_vector_type(8)));
typedef float f32x4 __attribute__((ext_vector_type(4)));
typedef unsigned u32x4 __attribute__((ext_vector_type(4)));
constexpr int BM = 256, BK = 64, HALF = 128, HTB = HALF * BK * 2  , STAGE_BYTES = 8 * HTB, NXCD = 8, WGM = 8;

__host__ __device__ __forceinline__ int lds_byte(int r, int c) { const int st = (r >> 4) * 2 + (c >> 5), rr = r & 15, cc = c & 31, ob = rr * 64 + cc * 2; return st * 1024 + (ob ^ (((ob >> 9) & 1) << 5)); }
__host__ __device__ __forceinline__ void stage_rc(int b, int& R, int& C) { const int st = b / 1024, sb = b % 1024, swz = sb ^ (((sb >> 9) & 1) << 5); R = (st >> 1) * 16 + swz / 64; C = (st & 1) * 32 + (swz % 64) / 2; }
__host__ __device__ __forceinline__ int perm32(int rho) { const int n = rho >> 4, i = rho & 15; return 8 * (i >> 2) + 4 * n + (i & 3); }

struct Unit { int pm, pn, kb, nt; };
struct Gemm { const bf16_t* A; const bf16_t* Bt; int M, N, K; };

struct StaticOrder {
    int nM, nN, nwg, G, c;
    __host__ __device__ void init(int M, int N, int G_, int c_) { nM = M / BM; nN = N / BM; nwg = nM * nN; G = G_; c = c_; }
    __host__ __device__ bool next(int i, Unit& u) const {
        const long L = (long)i * G + c; if (L >= nwg) return false;
        int wgid = (int)L; { const int q = nwg / NXCD, r = nwg % NXCD, xcd = wgid % NXCD, off = wgid / NXCD; wgid = (xcd < r ? xcd * (q + 1) : r * (q + 1) + (xcd - r) * q) + off; }
        const int nig = WGM * nN, gid = wgid / nig, fm = gid * WGM, gsz = (nM - fm) < WGM ? (nM - fm) : WGM;
        u.pm = fm + ((wgid % nig) % gsz); u.pn = (wgid % nig) / gsz; u.kb = 0; u.nt = 0; return true;
    }
    __device__ __forceinline__ void a_ready(const Unit&) const {}
    __device__ __forceinline__ void done(const Unit&) const {}
};

__device__ __forceinline__ unsigned cvt_pk_bf16(float lo, float hi) { unsigned r; asm volatile("v_cvt_pk_bf16_f32 %0, %1, %2" : "=v"(r) : "v"(lo), "v"(hi)); return r; }
typedef float f32x2 __attribute__((ext_vector_type(2)));
template <class Epi, class Sched, bool ALIGN_EPI = false, bool SP2 = false, int NTC = 0>
__device__ __forceinline__ void gemm_phase(PG8_LAS unsigned char* lds, const Gemm g, const Sched& S, const Epi& E) {
    const int tid = tid_fresh(), wid = __builtin_amdgcn_readfirstlane(tid >> 6), lane = tid & 63, wr = wid >> 2, wc = wid & 3, fr = lane & 15, fq = lane >> 4;
    const int K = g.K; int nt = NTC ? NTC : K / BK;
    if (NTC) asm volatile("" : "+s"(nt));
    unsigned voffA[2], voffB[2];
#pragma unroll
    for (int i = 0; i < 2; ++i) { int R, C; stage_rc(tid * 16 + i * 8192, R, C); const int Rb = Epi::PERM ? ((R & ~31) + perm32(R & 31)) : R;
        voffA[i] = (unsigned)(R * K + C) * 2u; voffB[i] = (unsigned)(Rb * K + C) * 2u; }
    const size_t kstep = (size_t)(BK * 2);
    const size_t hstep = (size_t)HALF * K * 2;
    const size_t tstep = 2 * hstep;
    const unsigned ldsw = (unsigned)wid * 1024u;
    const int aoff = lds_byte(wr * 64 + fr, fq * 8), boff = lds_byte(wc * 32 + fr, fq * 8);
#define PG8_SA(b, h) (((b) * 2 + (h)) * HTB)
#define PG8_SB(b, h) ((4 + (b) * 2 + (h)) * HTB)
#define PG8_STAGE(bufoff, gbase, voff) do { _Pragma("unroll") for (int _i = 0; _i < 2; ++_i) \
        __builtin_amdgcn_global_load_lds((const unsigned*)((const char*)(gbase) + (voff)[_i]), (PG8_LAS unsigned*)(lds + (bufoff) + ldsw + _i * 8192), 16, 0, 0); } while (0)
#define PG8_LDA(dst, b, h) do { _Pragma("unroll") for (int m = 0; m < 4; ++m) _Pragma("unroll") for (int k = 0; k < 2; ++k) dst[m][k] = *(const PG8_LAS bf16x8*)(lds + PG8_SA(b, h) + aoff + m * 2048 + k * 1024); } while (0)
#define PG8_LDB(dst, b, h) do { _Pragma("unroll") for (int n = 0; n < 2; ++n) _Pragma("unroll") for (int k = 0; k < 2; ++k) dst[n][k] = *(const PG8_LAS bf16x8*)(lds + PG8_SB(b, h) + boff + n * 2048 + k * 1024); } while (0)
#define PG8_MMA(ai, bj, At, Bt) do { __builtin_amdgcn_s_setprio(1); _Pragma("unroll") for (int m = 0; m < 4; ++m) _Pragma("unroll") for (int n = 0; n < 2; ++n) _Pragma("unroll") for (int k = 0; k < 2; ++k) \
        acc[ai][bj][m][n] = __builtin_amdgcn_mfma_f32_16x16x32_bf16(Bt[n][k], At[m][k], acc[ai][bj][m][n], 0, 0, 0); __builtin_amdgcn_s_setprio(0); } while (0)
#define PG8_WAIT_V(n) asm volatile("s_waitcnt vmcnt(" #n ")" ::: "memory")
#define PG8_WAIT_L(n) asm volatile("s_waitcnt lgkmcnt(" #n ")" ::: "memory")
#define PG8_BAR __builtin_amdgcn_s_barrier()
#define PG8_SCHED __builtin_amdgcn_sched_barrier(0)
    Unit cur, nxt; int ui = 0;
    if (!S.next(0, cur)) return;
    f32x4 acc[2][2][4][2];
#pragma unroll
    for (int a = 0; a < 2; ++a)
#pragma unroll
        for (int b = 0; b < 2; ++b)
#pragma unroll
            for (int m = 0; m < 4; ++m)
#pragma unroll
                for (int n = 0; n < 2; ++n) acc[a][b][m][n] = (f32x4){0.f, 0.f, 0.f, 0.f};
    bf16x8 At[4][2], B0[2][2], B1[2][2];
    const char* cA = (const char*)g.A + (size_t)cur.pm * tstep + (size_t)cur.kb * kstep; const char* cB = (const char*)g.Bt + (size_t)cur.pn * tstep + (size_t)cur.kb * kstep;
    S.a_ready(cur);
    if constexpr (SP2) {
        PG8_STAGE(PG8_SB(0, 0), cB, voffB); PG8_STAGE(PG8_SB(0, 1), cB + hstep, voffB); PG8_STAGE(PG8_SA(0, 0), cA, voffA); PG8_STAGE(PG8_SA(0, 1), cA + hstep, voffA);
        if (wr == 1) PG8_BAR;
        PG8_WAIT_V(2); PG8_BAR;
        PG8_STAGE(PG8_SB(1, 0), cB + kstep, voffB); PG8_STAGE(PG8_SA(1, 0), cA + kstep, voffA); PG8_STAGE(PG8_SB(1, 1), cB + hstep + kstep, voffB);
        PG8_WAIT_V(6); PG8_BAR;
    } else {
        PG8_STAGE(PG8_SB(0, 0), cB, voffB); PG8_STAGE(PG8_SA(0, 0), cA, voffA); PG8_STAGE(PG8_SB(0, 1), cB + hstep, voffB); PG8_STAGE(PG8_SA(0, 1), cA + hstep, voffA);
        if (wr == 1) PG8_BAR;
        PG8_WAIT_V(4); PG8_BAR;
        PG8_STAGE(PG8_SB(1, 0), cB + kstep, voffB); PG8_STAGE(PG8_SA(1, 0), cA + kstep, voffA); PG8_STAGE(PG8_SB(1, 1), cB + hstep + kstep, voffB);
        PG8_WAIT_V(6); PG8_BAR;
    }
    for (;;) {
        const bool has_next = S.next(ui + 1, nxt);
        const char* nA = has_next ? (const char*)g.A + (size_t)nxt.pm * tstep + (size_t)nxt.kb * kstep : cA; const char* nB = has_next ? (const char*)g.Bt + (size_t)nxt.pn * tstep + (size_t)nxt.kb * kstep : cB;
        for (int t = 0; t < nt; t += 2) {
            const bool last = (t == nt - 2);
            const char* a1 = cA + (size_t)(t + 1) * kstep;
            const char* a2 = last ? nA : cA + (size_t)(t + 2) * kstep; const char* b2 = last ? nB : cB + (size_t)(t + 2) * kstep;
            const char* a3 = a2 + kstep; const char* b3 = b2 + kstep;
            if (last && has_next) S.a_ready(nxt);
            if constexpr (SP2) {
            PG8_LDB(B0, 0, 0); PG8_LDB(B1, 0, 1); PG8_SCHED; PG8_LDA(At, 0, 0); PG8_STAGE(PG8_SA(1, 1), a1 + hstep, voffA);
            PG8_WAIT_V(8); PG8_WAIT_L(0); PG8_BAR; PG8_MMA(0, 0, At, B0); PG8_MMA(0, 1, At, B1); PG8_BAR; PG8_SCHED;
            PG8_LDA(At, 0, 1); PG8_STAGE(PG8_SB(0, 0), b2, voffB); PG8_STAGE(PG8_SB(0, 1), b2 + hstep, voffB); PG8_STAGE(PG8_SA(0, 0), a2, voffA);
            PG8_WAIT_V(8); PG8_WAIT_L(0); PG8_BAR; PG8_MMA(1, 0, At, B0); PG8_MMA(1, 1, At, B1); PG8_BAR; PG8_SCHED;
            PG8_LDB(B0, 1, 0); PG8_LDB(B1, 1, 1); PG8_SCHED; PG8_LDA(At, 1, 0); PG8_STAGE(PG8_SA(0, 1), a2 + hstep, voffA);
            PG8_WAIT_V(8); PG8_WAIT_L(0); PG8_BAR; PG8_MMA(0, 0, At, B0); PG8_MMA(0, 1, At, B1); PG8_BAR; PG8_SCHED;
            PG8_LDA(At, 1, 1); PG8_STAGE(PG8_SB(1, 0), b3, voffB); PG8_STAGE(PG8_SB(1, 1), b3 + hstep, voffB); PG8_STAGE(PG8_SA(1, 0), a3, voffA);
            PG8_WAIT_V(8); PG8_WAIT_L(0); PG8_BAR; PG8_MMA(1, 0, At, B0); PG8_MMA(1, 1, At, B1); PG8_BAR; PG8_SCHED;
            } else {
            PG8_LDB(B0, 0, 0); PG8_SCHED; PG8_LDA(At, 0, 0); PG8_STAGE(PG8_SA(1, 1), a1 + hstep, voffA);
            PG8_WAIT_L(8); PG8_BAR; PG8_WAIT_L(0); PG8_MMA(0, 0, At, B0); PG8_BAR; PG8_SCHED;
            PG8_LDB(B1, 0, 1); PG8_STAGE(PG8_SB(0, 0), b2, voffB);
            PG8_BAR; PG8_WAIT_L(0); PG8_MMA(0, 1, At, B1); PG8_BAR;
            PG8_LDA(At, 0, 1); PG8_STAGE(PG8_SA(0, 0), a2, voffA);
            PG8_BAR; PG8_WAIT_L(0); PG8_MMA(1, 0, At, B0); PG8_BAR; PG8_SCHED;
            PG8_STAGE(PG8_SB(0, 1), b2 + hstep, voffB);
            PG8_WAIT_V(6); PG8_BAR; PG8_MMA(1, 1, At, B1); PG8_BAR;
            PG8_LDB(B0, 1, 0); PG8_SCHED; PG8_LDA(At, 1, 0); PG8_STAGE(PG8_SA(0, 1), a2 + hstep, voffA);
            PG8_WAIT_L(8); PG8_BAR; PG8_WAIT_L(0); PG8_MMA(0, 0, At, B0); PG8_BAR; PG8_SCHED;
            PG8_LDB(B1, 1, 1); PG8_STAGE(PG8_SB(1, 0), b3, voffB);
            PG8_BAR; PG8_WAIT_L(0); PG8_MMA(0, 1, At, B1); PG8_BAR;
            PG8_LDA(At, 1, 1); PG8_STAGE(PG8_SA(1, 0), a3, voffA);
            PG8_BAR; PG8_WAIT_L(0); PG8_MMA(1, 0, At, B0); PG8_BAR; PG8_SCHED;
            PG8_STAGE(PG8_SB(1, 1), b3 + hstep, voffB);
            PG8_WAIT_V(6); PG8_BAR; PG8_MMA(1, 1, At, B1); PG8_BAR;
            }
        }
        if constexpr (ALIGN_EPI) { if (wr == 0) PG8_BAR; }
        if constexpr (!Epi::AFTER_DRAIN) { E(acc, cur, wr, wc, fr, fq); S.done(cur); }
        if (!has_next) break;
#pragma unroll
        for (int a = 0; a < 2; ++a)
#pragma unroll
            for (int b = 0; b < 2; ++b)
#pragma unroll
                for (int m = 0; m < 4; ++m)
#pragma unroll
                    for (int n = 0; n < 2; ++n) acc[a][b][m][n] = (f32x4){0.f, 0.f, 0.f, 0.f};
        cur = nxt; cA = nA; cB = nB; ++ui;
        if constexpr (ALIGN_EPI) { if (wr == 1) PG8_BAR; }
    }
    PG8_WAIT_V(0);
    if constexpr (!ALIGN_EPI) { if (wr == 0) PG8_BAR; }
    PG8_BAR;
    if constexpr (Epi::AFTER_DRAIN) { E.fused(acc, cur, wr, wc, fr, fq, lds, wid, lane); S.done(cur); }
#undef PG8_SA
#undef PG8_SB
#undef PG8_STAGE
#undef PG8_LDA
#undef PG8_LDB
#undef PG8_MMA
#undef PG8_WAIT_V
#undef PG8_WAIT_L
#undef PG8_BAR
#undef PG8_SCHED
}
}

#define LAS __attribute__((address_space(3)))
typedef LAS unsigned char* lptr;
typedef unsigned short bf16_t;
typedef float f32x4 __attribute__((ext_vector_type(4)));
typedef float f32x2 __attribute__((ext_vector_type(2)));
typedef float f32x16 __attribute__((ext_vector_type(16)));
typedef unsigned u32x4 __attribute__((ext_vector_type(4)));
typedef unsigned u32x2 __attribute__((ext_vector_type(2)));
typedef short bf16x8 __attribute__((ext_vector_type(8)));
typedef short s16x4 __attribute__((ext_vector_type(4)));
typedef short v4i16_t __attribute__((ext_vector_type(4)));

constexpr int M_TOK = 33280, M_P = 32768, DM = 1024, NIN = 5120, DFF = 2816, NUP = 5632;
constexpr float L2E = 1.4426950408889634f, LN2 = 0.6931471805599453f, NEPS = 1e-6f;
constexpr size_t O_Y = 0, O_PDK = 34078720, O_PDV = O_PDK + 16777216, O_PSK = O_PDV + 16777216, O_PSV = O_PSK + 16777216,
                 O_PCONV = O_PSV + 16777216, O_SDK = O_PCONV + 180224, O_SDV = O_SDK + 262144, O_SSK = O_SDV + 262144, O_SSV = O_SSK + 262144,
                 O_SCONV = O_SSV + 262144, O_END = O_SCONV + 360448;
constexpr size_t WS_CTL = 0, WS_RSTD = 16384, WS_SSQ1 = WS_RSTD + 133120, WS_SSQ2 = WS_SSQ1 + 2129920, WS_WIN = WS_SSQ2 + 2129920,
                 WS_WA = WS_WIN + 10485760, WS_WB = WS_WA + 1048576, WS_WOUT = WS_WB + 1048576, WS_WUP = WS_WOUT + 2097152,
                 WS_WDN = WS_WUP + 11534336, WS_A = WS_WDN + 5767168, WS_B = WS_A + 408944640, WS_X1B = WS_B + 187432960, WS_END = WS_X1B + 68157440;
constexpr size_t ZSEC = (size_t)M_TOK * 512;

struct Params {
    const float* x_prompt; const float* x_sample; const float* cdk; const float* cdv; const float* csk; const float* csv; const float* state_conv;
    const float* attn_g; const float* w_in; const float* lq1; const float* lk1; const float* lq2; const float* lk2; const float* subln_g;
    const float* w_a; const float* w_b; const float* w_out; const float* ffn_g; const float* w_up; const float* conv_w; const float* conv_b;
    const float* w_down; const float* final_g; float* out; unsigned char* ws;
};

constexpr int PRM_OFF = 131072 + 1024;
template <class T> __device__ __forceinline__ T prm_ld(lptr lds, int off) {
    const LAS unsigned* q = (const LAS unsigned*)(lds + PRM_OFF + off); unsigned lo = q[0], hi = q[1];
    lo = __builtin_amdgcn_readfirstlane(lo); hi = __builtin_amdgcn_readfirstlane(hi);
    return (T)(((unsigned long long)hi << 32) | lo);
}
template <class T> __device__ __forceinline__ void prm_st(lptr lds, int off, T v) { *(LAS unsigned long long*)(lds + PRM_OFF + off) = (unsigned long long)v; }
#define PRM(f) prm_ld<decltype(Params::f)>(lds, (int)offsetof(Params, f))
__device__ __forceinline__ float bflo(unsigned w) { return __uint_as_float(w << 16); }
__device__ __forceinline__ float bfhi(unsigned w) { return __uint_as_float(w & 0xffff0000u); }
__device__ __forceinline__ unsigned cvtpk(float lo, float hi) { unsigned r; asm volatile("v_cvt_pk_bf16_f32 %0, %1, %2" : "=v"(r) : "v"(lo), "v"(hi)); return r; }
__device__ __forceinline__ u32x4 pack8(f32x4 a, f32x4 b) { u32x4 w; w.x = cvtpk(a[0], a[1]); w.y = cvtpk(a[2], a[3]); w.z = cvtpk(b[0], b[1]); w.w = cvtpk(b[2], b[3]); return w; }
__device__ __forceinline__ float wave_sum(float v) {
#pragma unroll
    for (int o = 1; o < 64; o <<= 1) v += __shfl_xor(v, o);
    return v;
}
__device__ __forceinline__ float fexp2(float x) { return __builtin_amdgcn_exp2f(x); }
__device__ __forceinline__ float flog2(float x) { return __builtin_amdgcn_logf(x); }
__device__ __forceinline__ float frcp(float x) { return __builtin_amdgcn_rcpf(x); }
__device__ __forceinline__ float sigmoidf_(float x) { return frcp(1.f + fexp2(-x * L2E)); }

struct EpiIn {
    static constexpr bool PERM = true, AFTER_DRAIN = false;
    const float* rstd; bf16_t* z; float* out;
    __device__ __forceinline__ void operator()(const pg8::f32x4 (&acc)[2][2][4][2], const pg8::Unit& u, int wr, int wc, int fr, int fq) const {
        const int pn = u.pn; const bool samp = u.pm >= 128;
        bf16_t* zb; int ld, tcol; float* fo = nullptr; float sc = 1.f; int mode = 0;
        if (pn < 12) {
            const int sec = pn >> 1; zb = z + (size_t)sec * ZSEC; ld = 512; tcol = (pn & 1) * 256;
            if (sec < 2) mode = 1;
            if (sec == 0) sc = 0.125f * L2E; else if (sec == 3) sc = 0.125f;
            if (sec == 1) fo = out + (samp ? O_SDK : O_PDK); else if (sec == 2) fo = out + (samp ? O_SDV : O_PDV);
            else if (sec == 4) fo = out + (samp ? O_SSK : O_PSK); else if (sec == 5) fo = out + (samp ? O_SSV : O_PSV);
        } else { const int gs = (pn - 12) >> 2; zb = z + (size_t)(6 + 2 * gs) * ZSEC; ld = 1024; tcol = ((pn - 12) & 3) * 256; mode = 2; }
        const int cb = tcol + wc * 64 + fq * 8;
        float ir[2][4];
#pragma unroll
        for (int n = 0; n < 2; ++n)
#pragma unroll
            for (int e = 0; e < 4; ++e) ir[n][e] = exp2f(-(float)(8 * fq + 4 * n + e) * (13.287712379549449f / 32.f)) * 0.15915494309189535f;
#pragma unroll
        for (int ai = 0; ai < 2; ++ai)
#pragma unroll
            for (int m = 0; m < 4; ++m) {
                const int row = u.pm * 256 + ai * 128 + wr * 64 + m * 16 + fr;
                const float rs = rstd[row] * sc;
                f32x4 v[2][2];
#pragma unroll
                for (int bj = 0; bj < 2; ++bj)
#pragma unroll
                    for (int n = 0; n < 2; ++n) v[bj][n] = acc[ai][bj][m][n] * rs;
                if (mode == 1) {
                    const float pos = samp ? (float)(2048 + (row & 15)) : (float)(row & 2047);
#pragma unroll
                    for (int n = 0; n < 2; ++n)
#pragma unroll
                        for (int e = 0; e < 4; ++e) {
                            float rev = pos * ir[n][e]; rev -= rintf(rev);
                            const float sn = __builtin_amdgcn_sinf(rev), cs = __builtin_amdgcn_cosf(rev);
                            const float x1 = v[0][n][e], x2 = v[1][n][e];
                            v[0][n][e] = x1 * cs - x2 * sn; v[1][n][e] = x2 * cs + x1 * sn;
                        }
                } else if (mode == 2) {
#pragma unroll
                    for (int bj = 0; bj < 2; ++bj)
#pragma unroll
                        for (int n = 0; n < 2; ++n)
#pragma unroll
                            for (int e = 0; e < 4; ++e) v[bj][n][e] = sigmoidf_(v[bj][n][e]);
                }
                const size_t rl = samp ? (size_t)(row - M_P) : (size_t)row;
#pragma unroll
                for (int bj = 0; bj < 2; ++bj) {
                    *(u32x4*)(zb + (size_t)row * ld + cb + 32 * bj) = pack8(v[bj][0], v[bj][1]);
                    if (fo) { float* d = fo + rl * 512 + cb + 32 * bj; *(f32x4*)d = v[bj][0]; *(f32x4*)(d + 4) = v[bj][1]; }
                }
            }
    }
};
template <bool FIRST> struct EpiMerge {
    static constexpr bool PERM = true, AFTER_DRAIN = false;
    const bf16_t* gate; bf16_t* mg;
    __device__ __forceinline__ void operator()(const pg8::f32x4 (&acc)[2][2][4][2], const pg8::Unit& u, int wr, int wc, int fr, int fq) const {
#pragma unroll
        for (int ai = 0; ai < 2; ++ai)
#pragma unroll
            for (int m = 0; m < 4; ++m) {
                const int row = u.pm * 256 + ai * 128 + wr * 64 + m * 16 + fr;
#pragma unroll
                for (int bj = 0; bj < 2; ++bj) {
                    const size_t off = (size_t)row * 1024 + u.pn * 256 + bj * 128 + wc * 32 + fq * 8;
                    const u32x4 g = *(const u32x4*)(gate + off);
                    f32x4 a = acc[ai][bj][m][0], b = acc[ai][bj][m][1];
                    a[0] *= bflo(g.x); a[1] *= bfhi(g.x); a[2] *= bflo(g.y); a[3] *= bfhi(g.y);
                    b[0] *= bflo(g.z); b[1] *= bfhi(g.z); b[2] *= bflo(g.w); b[3] *= bfhi(g.w);
                    if (!FIRST) { const u32x4 o = *(const u32x4*)(mg + off);
                        a[0] += bflo(o.x); a[1] += bfhi(o.x); a[2] += bflo(o.y); a[3] += bfhi(o.y);
                        b[0] += bflo(o.z); b[1] += bfhi(o.z); b[2] += bflo(o.w); b[3] += bfhi(o.w); }
                    *(u32x4*)(mg + off) = pack8(a, b);
                }
            }
    }
};
template <bool WRITE_BF> struct EpiRes {
    static constexpr bool PERM = true, AFTER_DRAIN = false;
    const float* base_p; const float* base_s; float* y; bf16_t* yb; float* ssq;
    __device__ __forceinline__ void operator()(const pg8::f32x4 (&acc)[2][2][4][2], const pg8::Unit& u, int wr, int wc, int fr, int fq) const {
        const bool samp = u.pm >= 128;
#pragma unroll
        for (int ai = 0; ai < 2; ++ai)
#pragma unroll
            for (int m = 0; m < 4; ++m) {
                const int row = u.pm * 256 + ai * 128 + wr * 64 + m * 16 + fr;
                const float* brow = samp ? base_s + (size_t)(row - M_P) * 1024 : base_p + (size_t)row * 1024;
                float s = 0.f;
#pragma unroll
                for (int bj = 0; bj < 2; ++bj) {
                    const int col = u.pn * 256 + bj * 128 + wc * 32 + fq * 8;
                    f32x4 a = acc[ai][bj][m][0] + *(const f32x4*)(brow + col), b = acc[ai][bj][m][1] + *(const f32x4*)(brow + col + 4);
                    s += (a[0] * a[0] + a[1] * a[1]) + (a[2] * a[2] + a[3] * a[3]) + (b[0] * b[0] + b[1] * b[1]) + (b[2] * b[2] + b[3] * b[3]);
                    float* d = y + (size_t)row * 1024 + col; *(f32x4*)d = a; *(f32x4*)(d + 4) = b;
                    if (WRITE_BF) *(u32x4*)(yb + (size_t)row * 1024 + col) = pack8(a, b);
                }
                s += __shfl_xor(s, 16); s += __shfl_xor(s, 32);
                if (fq == 0) ssq[(size_t)row * 16 + u.pn * 4 + wc] = s;
            }
    }
};
struct EpiUp {
    static constexpr bool PERM = true, AFTER_DRAIN = false;
    const float* ssq; bf16_t* U; float* out;
    __device__ __forceinline__ void operator()(const pg8::f32x4 (&acc)[2][2][4][2], const pg8::Unit& u, int wr, int wc, int fr, int fq) const {
        const bool samp = u.pm >= 128;
#pragma unroll
        for (int ai = 0; ai < 2; ++ai)
#pragma unroll
            for (int m = 0; m < 4; ++m) {
                const int row = u.pm * 256 + ai * 128 + wr * 64 + m * 16 + fr;
                const f32x4* sp = (const f32x4*)(ssq + (size_t)row * 16);
                const f32x4 s0 = sp[0], s1 = sp[1], s2 = sp[2], s3 = sp[3];
                const float tot = ((s0[0] + s0[1]) + (s0[2] + s0[3])) + ((s1[0] + s1[1]) + (s1[2] + s1[3])) + ((s2[0] + s2[1]) + (s2[2] + s2[3])) + ((s3[0] + s3[1]) + (s3[2] + s3[3]));
                const float rs = rsqrtf(tot * (1.f / 1024.f) + NEPS);
                float* cs = nullptr;
                if (!samp) { const int t = row & 2047; if (t >= 2046) cs = out + O_PCONV + (size_t)((row >> 11) * 2 + (t - 2046)) * NUP; }
                else { const int t = row & 15; if (t >= 14) cs = out + O_SCONV + (size_t)(((row - M_P) >> 4) * 2 + (t - 14)) * NUP; }
#pragma unroll
                for (int bj = 0; bj < 2; ++bj) {
                    const int col = u.pn * 256 + bj * 128 + wc * 32 + fq * 8;
                    const f32x4 a = acc[ai][bj][m][0] * rs, b = acc[ai][bj][m][1] * rs;
                    *(u32x4*)(U + (size_t)row * NUP + col) = pack8(a, b);
                    if (cs) { *(f32x4*)(cs + col) = a; *(f32x4*)(cs + col + 4) = b; }
                }
            }
    }
};


__device__ __forceinline__ float dpp_ror1(float v) { return __int_as_float(__builtin_amdgcn_update_dpp(0, __float_as_int(v), 0x121, 0xf, 0xf, false)); }
__device__ __forceinline__ float dpp_ror2(float v) { return __int_as_float(__builtin_amdgcn_update_dpp(0, __float_as_int(v), 0x122, 0xf, 0xf, false)); }
struct EpiUpConv {
    static constexpr bool PERM = true, AFTER_DRAIN = false;
    const float* ssq; bf16_t* U; bf16_t* H; float* out; const float* cw; const float* cb; lptr wl;
    __device__ __forceinline__ void operator()(const pg8::f32x4 (&acc)[2][2][4][2], const pg8::Unit& u, int wr, int wc, int fr, int fq) const {
        const bool samp = u.pm >= 128;
        const int j0 = u.pn * 128 + wc * 32 + fq * 8;
        {
            const int t_ = (wr * 4 + wc) * 64 + fq * 16 + fr;
#pragma unroll
            for (int i = 0; i < 2; ++i) { const int idx = t_ + 512 * i, k = idx >> 8, p = idx & 255, col = (p >> 7) * DFF + u.pn * 128 + (p & 127);
                ((LAS float*)wl)[idx] = k < 3 ? cw[k * NUP + col] : cb[col]; }
            asm volatile("s_waitcnt lgkmcnt(0)\n\ts_barrier" ::: "memory");
        }
        const LAS float* wq = (const LAS float*)wl + wc * 32 + fq * 8;
        float rs[2][4];
#pragma unroll
        for (int ai = 0; ai < 2; ++ai)
#pragma unroll
            for (int m = 0; m < 4; ++m) {
                const int row = u.pm * 256 + ai * 128 + wr * 64 + m * 16 + fr;
                const f32x4 s0 = *((const f32x4*)(ssq + (size_t)row * 16) + fq);
                float tot = (s0[0] + s0[1]) + (s0[2] + s0[3]);
                tot += __shfl_xor(tot, 16); tot += __shfl_xor(tot, 32);
                rs[ai][m] = rsqrtf(tot * (1.f / 1024.f) + NEPS);
            }
        __builtin_amdgcn_sched_barrier(0);
#pragma unroll
        for (int n = 0; n < 2; ++n) {
            const int jc = j0 + 4 * n;
#pragma unroll
            for (int ai = 0; ai < 2; ++ai) {
                f32x4 k1g = (f32x4){0.f, 0.f, 0.f, 0.f}, k2g = k1g, k1v = k1g, k2v = k1g;
#pragma unroll
                for (int m = 0; m < 4; ++m) {
                    const int row = u.pm * 256 + ai * 128 + wr * 64 + m * 16 + fr;
                    const f32x4 ug = acc[ai][0][m][n] * rs[ai][m], uv = acc[ai][1][m][n] * rs[ai][m];
                    float* cs = nullptr;
                    if (!samp) { const int t = row & 2047; if (t >= 2046) cs = out + O_PCONV + (size_t)((row >> 11) * 2 + (t - 2046)) * NUP; }
                    else { const int t = row & 15; if (t >= 14) cs = out + O_SCONV + (size_t)(((row - M_P) >> 4) * 2 + (t - 14)) * NUP; }
                    if (cs) { *(f32x4*)(cs + jc) = ug; *(f32x4*)(cs + DFF + jc) = uv; }
                    const int lr = samp ? (row & 15) : (row & 63);
                    const bool keep = samp ? (lr < 2) : (lr < 2 || lr >= 62);
                    if (keep) { u32x2 wg, wv; wg.x = cvtpk(ug[0], ug[1]); wg.y = cvtpk(ug[2], ug[3]); wv.x = cvtpk(uv[0], uv[1]); wv.y = cvtpk(uv[2], uv[3]);
                        *(u32x2*)(U + (size_t)row * NUP + jc) = wg; *(u32x2*)(U + (size_t)row * NUP + DFF + jc) = wv; }
                    f32x4 c1g, c2g, c1v, c2v;
#pragma unroll
                    for (int e = 0; e < 4; ++e) { c1g[e] = dpp_ror1(ug[e]); c2g[e] = dpp_ror2(ug[e]); c1v[e] = dpp_ror1(uv[e]); c2v[e] = dpp_ror2(uv[e]); }
                    f32x4 p1g, p2g, p1v, p2v;
#pragma unroll
                    for (int e = 0; e < 4; ++e) { p1g[e] = fr >= 1 ? c1g[e] : k1g[e]; p2g[e] = fr >= 2 ? c2g[e] : k2g[e]; p1v[e] = fr >= 1 ? c1v[e] : k1v[e]; p2v[e] = fr >= 2 ? c2v[e] : k2v[e]; }
                    k1g = c1g; k2g = c2g; k1v = c1v; k2v = c2v;
                    f32x4 hh;
                    { const f32x4 w0g = *(const LAS f32x4*)(wq + 4 * n), w1g = *(const LAS f32x4*)(wq + 256 + 4 * n), w2g = *(const LAS f32x4*)(wq + 512 + 4 * n), bg = *(const LAS f32x4*)(wq + 768 + 4 * n);
                      const f32x4 cg = bg + w0g * p2g + w1g * p1g + w2g * ug;
#pragma unroll
                      for (int e = 0; e < 4; ++e) hh[e] = cg[e] * sigmoidf_(cg[e]); }
                    __builtin_amdgcn_sched_barrier(0);
                    { const f32x4 w0v = *(const LAS f32x4*)(wq + 128 + 4 * n), w1v = *(const LAS f32x4*)(wq + 384 + 4 * n), w2v = *(const LAS f32x4*)(wq + 640 + 4 * n), bv = *(const LAS f32x4*)(wq + 896 + 4 * n);
                      const f32x4 cv = bv + w0v * p2v + w1v * p1v + w2v * uv;
                      hh = hh * cv; }
                    const bool deferred = samp ? (fr < 2) : (m == 0 && fr < 2);
                    if (!deferred) { u32x2 w; w.x = cvtpk(hh[0], hh[1]); w.y = cvtpk(hh[2], hh[3]); *(u32x2*)(H + (size_t)row * DFF + jc) = w; }
                    __builtin_amdgcn_sched_barrier(0);
                }
            }
        }
    }
};

struct EpiDown {
    static constexpr bool PERM = true, AFTER_DRAIN = false;
    float* y; float* part;
    __device__ __forceinline__ void operator()(const pg8::f32x4 (&acc)[2][2][4][2], const pg8::Unit& u, int wr, int wc, int fr, int fq) const {
        const bool split = u.pm >= 128;
#pragma unroll
        for (int ai = 0; ai < 2; ++ai)
#pragma unroll
            for (int m = 0; m < 4; ++m) {
                const int row = u.pm * 256 + ai * 128 + wr * 64 + m * 16 + fr;
#pragma unroll
                for (int bj = 0; bj < 2; ++bj) {
                    float* d = y + (size_t)row * 1024 + u.pn * 256 + bj * 128 + wc * 32 + fq * 8;
                    if (!split) { const f32x4 a = acc[ai][bj][m][0] + *(const f32x4*)d, b = acc[ai][bj][m][1] + *(const f32x4*)(d + 4); *(f32x4*)d = a; *(f32x4*)(d + 4) = b; }
                    else { float* q = part + ((size_t)(u.kb >> 2) * 512 + (row - M_P)) * 1024 + u.pn * 256 + bj * 128 + wc * 32 + fq * 8; *(f32x4*)q = acc[ai][bj][m][0]; *(f32x4*)(q + 4) = acc[ai][bj][m][1]; }
                }
            }
    }
};
struct DownOrder {
    int G, c;
    __device__ void init(int G_, int c_) { G = G_; c = c_; }
    __device__ bool next(int i, pg8::Unit& u) const {
        const int s = i * G + c; if (s >= 88) return false;
        u.pm = 128 + (s & 1); u.pn = (s >> 1) & 3; u.kb = 4 * (s >> 3); u.nt = 4; return true;
    }
    __device__ __forceinline__ void a_ready(const pg8::Unit&) const {}
    __device__ __forceinline__ void done(const pg8::Unit&) const {}
};

template <int PERMROWS>
__device__ __forceinline__ void transpose_item(const float* W, int K, int N, bf16_t* WT, const float* g, LAS float* scr, int item, int lane) {
    const int nblk = N / 32, kb = item / nblk, nb = item % nblk, k0 = 64 * kb, n0 = 32 * nb;
#pragma unroll 8
    for (int i = 0; i < 32; ++i) { const int kk = 2 * i + (lane >> 5); float v = W[(size_t)(k0 + kk) * N + n0 + (lane & 31)]; if (g) v *= g[k0 + kk]; scr[kk * 33 + (lane & 31)] = v; }
    asm volatile("s_waitcnt lgkmcnt(0)" ::: "memory");
    const int c = lane & 7;
#pragma unroll
    for (int j = 0; j < 4; ++j) {
        const int n = (lane >> 3) + 8 * j; const LAS float* s = scr + (8 * c) * 33 + n;
        u32x4 o; o.x = cvtpk(s[0 * 33], s[1 * 33]); o.y = cvtpk(s[2 * 33], s[3 * 33]); o.z = cvtpk(s[4 * 33], s[5 * 33]); o.w = cvtpk(s[6 * 33], s[7 * 33]);
        int nn = n0 + n;
        if (PERMROWS == 1) { const int p = nn & 255; nn = (nn & ~255) + ((p >> 5) & 1) * 128 + (p >> 6) * 32 + (p & 31); }
        if (PERMROWS == 2) { const int bj = nn >= DFF ? 1 : 0, j = nn - DFF * bj; nn = (j >> 7) * 256 + bj * 128 + (j & 127); }
        *(u32x4*)(WT + (size_t)nn * K + k0 + 8 * c) = o;
    }
    asm volatile("s_waitcnt lgkmcnt(0)" ::: "memory");
}

namespace att {
constexpr int KCH = 1040, KMAP = 8 * KCH;
constexpr int DA_K = 0, DA_V = 2 * KMAP, DA_VS = 320;
constexpr int SB_K = 0, SB_V = KMAP, SB_VS = 192;
constexpr int BUFB = 37376, WSF = 2 * BUFB, CTL = WSF + 2048, EXCH = 0, EXS = 132;
constexpr int NU_DAS = 128, NU_SBS = 256, NU_DAP = 1024, NU_SBP = 1024, NUNITS = NU_DAS + NU_SBS + NU_DAP + NU_SBP;
constexpr float SB_THR = -88.0f;

__device__ __forceinline__ s16x4 vtr(lptr p) { return __builtin_bit_cast(s16x4, __builtin_amdgcn_ds_read_tr16_b64_v4i16((LAS v4i16_t*)p)); }
__device__ __forceinline__ int crow(int r, int hi) { return (r & 3) + 8 * (r >> 2) + 4 * hi; }
__device__ __forceinline__ void expand8(u32x4 w, f32x4& a, f32x4& b) { a[0] = bflo(w.x); a[1] = bfhi(w.x); a[2] = bflo(w.y); a[3] = bfhi(w.y); b[0] = bflo(w.z); b[1] = bfhi(w.z); b[2] = bflo(w.w); b[3] = bfhi(w.w); }

template <bool SAMPLE> struct DAStage;
template <> struct DAStage<false> {
    u32x4 k[2], v[2];
    __device__ __forceinline__ void load(const float* ck, const float* cv, const bf16_t* KA, const bf16_t* VA, int b, int h, int t, int tid) {
#pragma unroll
        for (int i = 0; i < 2; ++i) { const int id = tid + 512 * i, row = id >> 4, ch = id & 15; const size_t off = (size_t)(b * 2048 + 64 * t + row) * 512 + h * 128 + ch * 8;
            k[i] = *(const u32x4*)(KA + off); v[i] = *(const u32x4*)(VA + off); }
    }
    __device__ __forceinline__ void store(lptr lds, int tid) {
#pragma unroll
        for (int i = 0; i < 2; ++i) { const int id = tid + 512 * i, row = id >> 4, ch = id & 15;
            *(LAS u32x4*)(lds + DA_K + (ch >> 3) * KMAP + (ch & 7) * KCH + row * 16) = k[i]; *(LAS u32x4*)(lds + DA_V + row * DA_VS + ch * 16) = v[i]; }
    }
};
template <> struct DAStage<true> {
    f32x4 k[2][2], v[2][2];
    __device__ __forceinline__ void load(const float* ck, const float* cv, const bf16_t* KA, const bf16_t* VA, int b, int h, int t, int tid) {
#pragma unroll
        for (int i = 0; i < 2; ++i) { const int id = tid + 512 * i, row = id >> 4, ch = id & 15;
            if (t < 32) { const size_t off = ((size_t)(b * 2048 + 64 * t + row) * 4 + h) * 128 + ch * 8;
                k[i][0] = *(const f32x4*)(ck + off); k[i][1] = *(const f32x4*)(ck + off + 4); v[i][0] = *(const f32x4*)(cv + off); v[i][1] = *(const f32x4*)(cv + off + 4); }
            else if (row < 16) { const size_t off = (size_t)(M_P + b * 16 + row) * 512 + h * 128 + ch * 8; expand8(*(const u32x4*)(KA + off), k[i][0], k[i][1]); expand8(*(const u32x4*)(VA + off), v[i][0], v[i][1]); }
            else { k[i][0] = k[i][1] = v[i][0] = v[i][1] = (f32x4){0.f, 0.f, 0.f, 0.f}; } }
    }
    __device__ __forceinline__ void store(lptr lds, int tid) {
#pragma unroll
        for (int i = 0; i < 2; ++i) { const int id = tid + 512 * i, row = id >> 4, ch = id & 15;
            *(LAS u32x4*)(lds + DA_K + (ch >> 3) * KMAP + (ch & 7) * KCH + row * 16) = pack8(k[i][0], k[i][1]); *(LAS u32x4*)(lds + DA_V + row * DA_VS + ch * 16) = pack8(v[i][0], v[i][1]); }
    }
};
template <bool SAMPLE> struct SBStage;
template <> struct SBStage<false> {
    u32x4 k, v;
    __device__ __forceinline__ void load(const float* ck, const float* cv, const bf16_t* KB, const bf16_t* VB, int b, int h, int t, int tid) {
        const int row = tid >> 3, ch = tid & 7; const size_t off = (size_t)(b * 2048 + 64 * t + row) * 512 + h * 64 + ch * 8;
        k = *(const u32x4*)(KB + off); v = *(const u32x4*)(VB + off);
    }
    __device__ __forceinline__ void store(lptr lds, int tid) {
        const int row = tid >> 3, ch = tid & 7;
        *(LAS u32x4*)(lds + SB_K + ch * KCH + row * 16) = k; *(LAS u32x4*)(lds + SB_V + row * SB_VS + ch * 16) = v;
    }
};
template <> struct SBStage<true> {
    f32x4 k[2], v[2];
    __device__ __forceinline__ void load(const float* ck, const float* cv, const bf16_t* KB, const bf16_t* VB, int b, int h, int t, int tid) {
        const int row = tid >> 3, ch = tid & 7;
        if (t < 32) { const size_t off = ((size_t)(b * 2048 + 64 * t + row) * 8 + h) * 64 + ch * 8;
            k[0] = *(const f32x4*)(ck + off); k[1] = *(const f32x4*)(ck + off + 4); v[0] = *(const f32x4*)(cv + off); v[1] = *(const f32x4*)(cv + off + 4); }
        else if (row < 16) { const size_t off = (size_t)(M_P + b * 16 + row) * 512 + h * 64 + ch * 8; expand8(*(const u32x4*)(KB + off), k[0], k[1]); expand8(*(const u32x4*)(VB + off), v[0], v[1]); }
        else { k[0] = k[1] = v[0] = v[1] = (f32x4){0.f, 0.f, 0.f, 0.f}; }
    }
    __device__ __forceinline__ void store(lptr lds, int tid) {
        const int row = tid >> 3, ch = tid & 7;
        *(LAS u32x4*)(lds + SB_K + ch * KCH + row * 16) = pack8(k[0], k[1]); *(LAS u32x4*)(lds + SB_V + row * SB_VS + ch * 16) = pack8(v[0], v[1]);
    }
};

#define MFMA32(a, b, c) __builtin_amdgcn_mfma_f32_32x32x16_bf16((a), (b), (c), 0, 0, 0)

template <bool SAMPLE>
__device__ __forceinline__ void da_unit(lptr lds, const bf16_t* zA, bf16_t* OA, int b, int h, int qblk, float lam) {
    const int tid = tid_fresh(), lane = tid & 63, r32 = lane & 31, hi = lane >> 5, wid = __builtin_amdgcn_readfirstlane(tid >> 6), c = wid & 1, sub = wid >> 1;
    const bf16_t* QA = zA; const bf16_t* KA = zA + ZSEC; const bf16_t* VA = zA + 2 * ZSEC;
    const size_t qrow = SAMPLE ? (size_t)(M_P + b * 16 + (r32 & 15)) : (size_t)(b * 2048 + qblk * 128 + sub * 32 + r32);
    bf16x8 qr[4];
#pragma unroll
    for (int d0 = 0; d0 < 4; ++d0) qr[d0] = *(const bf16x8*)(QA + qrow * 512 + h * 128 + c * 64 + d0 * 16 + hi * 8);
    const int nt = SAMPLE ? 33 : 2 * qblk + 2;
    const int ntw = SAMPLE ? (sub == 0 ? 33 : 0) : 2 * qblk + 1 + (sub >> 1);
    f32x16 o[4];
#pragma unroll
    for (int i = 0; i < 4; ++i) o[i] = f32x16{};
    float m = -1e30f, l = 0.f;
    LAS float* wsf = (LAS float*)(lds + WSF) + wid * 64;
    const int vlane = ((lane >> 4) & 1) * 32 + (lane & 3) * 8 + (4 * hi + ((lane & 15) >> 2)) * DA_VS;
    const float* ck = SAMPLE ? PRM(cdk) : nullptr; const float* cv = SAMPLE ? PRM(cdv) : nullptr;
    DAStage<SAMPLE> st;
    st.load(ck, cv, KA, VA, b, h, 0, tid);
    for (int t = 0; t < nt; ++t) {
        __syncthreads();
        lptr tb = lds;
        st.store(lds, tid);
        __syncthreads();
        if (t + 1 < nt) st.load(ck, cv, KA, VA, b, h, t + 1, tid);
        if (t < ntw) {
            f32x16 p0 = f32x16{}, p1 = f32x16{};
#pragma unroll
            for (int d0 = 0; d0 < 4; ++d0) {
                lptr ka = tb + DA_K + c * KMAP + (2 * d0 + hi) * KCH + r32 * 16;
                const bf16x8 b0 = *(const LAS bf16x8*)ka, b1 = *(const LAS bf16x8*)(ka + 512);
                p0 = MFMA32(b0, qr[d0], p0); p1 = MFMA32(b1, qr[d0], p1);
            }
            if (SAMPLE && t == 32) {
#pragma unroll
                for (int r = 8; r < 16; ++r) p0[r] = -1e30f;
#pragma unroll
                for (int r = 0; r < 16; ++r) p1[r] = -1e30f;
            }
            float rm = fmaxf(p0[0], p1[0]);
#pragma unroll
            for (int r = 1; r < 16; ++r) rm = fmaxf(rm, fmaxf(p0[r], p1[r]));
            rm = fmaxf(rm, __shfl_xor(rm, 32));
            const float mn = fmaxf(m, rm);
            if (__any(mn > m)) {
                const float alpha = fexp2(m - mn); l *= alpha;
                if (hi == 0) wsf[r32] = alpha;
                asm volatile("s_waitcnt lgkmcnt(0)" ::: "memory");
                float f[16];
#pragma unroll
                for (int r = 0; r < 16; ++r) f[r] = wsf[crow(r, hi)];
#pragma unroll
                for (int d0 = 0; d0 < 4; ++d0)
#pragma unroll
                    for (int r = 0; r < 16; ++r) o[d0][r] *= f[r];
                asm volatile("s_waitcnt lgkmcnt(0)" ::: "memory");
            }
            m = mn;
            float ls = 0.f;
#pragma unroll
            for (int r = 0; r < 16; ++r) { p0[r] = fexp2(p0[r] - m); p1[r] = fexp2(p1[r] - m); ls += p0[r] + p1[r]; }
            l += ls;
            bf16x8 pw[4];
            { u32x4 w;
              w.x = cvtpk(p0[0], p0[1]); w.y = cvtpk(p0[2], p0[3]); w.z = cvtpk(p0[4], p0[5]); w.w = cvtpk(p0[6], p0[7]); pw[0] = __builtin_bit_cast(bf16x8, w);
              w.x = cvtpk(p0[8], p0[9]); w.y = cvtpk(p0[10], p0[11]); w.z = cvtpk(p0[12], p0[13]); w.w = cvtpk(p0[14], p0[15]); pw[1] = __builtin_bit_cast(bf16x8, w);
              w.x = cvtpk(p1[0], p1[1]); w.y = cvtpk(p1[2], p1[3]); w.z = cvtpk(p1[4], p1[5]); w.w = cvtpk(p1[6], p1[7]); pw[2] = __builtin_bit_cast(bf16x8, w);
              w.x = cvtpk(p1[8], p1[9]); w.y = cvtpk(p1[10], p1[11]); w.z = cvtpk(p1[12], p1[13]); w.w = cvtpk(p1[14], p1[15]); pw[3] = __builtin_bit_cast(bf16x8, w); }
#pragma unroll
            for (int d0 = 0; d0 < 4; ++d0)
#pragma unroll
                for (int ks = 0; ks < 4; ++ks) {
                    lptr va = tb + DA_V + vlane + ks * 16 * DA_VS + d0 * 64;
                    const s16x4 lo = vtr(va), hh = vtr(va + 8 * DA_VS);
                    const bf16x8 vf = (bf16x8){lo[0], lo[1], lo[2], lo[3], hh[0], hh[1], hh[2], hh[3]};
                    o[d0] = MFMA32(pw[ks], vf, o[d0]);
                }
        }
    }
    __syncthreads();
    l += __shfl_xor(l, 32);
    const bool live = !SAMPLE || sub == 0;
    if (live) {
        const float fac = (c == 0) ? frcp(l) : lam * frcp(l);
        if (hi == 0) wsf[r32] = fac;
        asm volatile("s_waitcnt lgkmcnt(0)" ::: "memory");
        float f[16];
#pragma unroll
        for (int r = 0; r < 16; ++r) f[r] = wsf[crow(r, hi)];
#pragma unroll
        for (int d0 = 0; d0 < 4; ++d0)
#pragma unroll
            for (int r = 0; r < 16; ++r) o[d0][r] *= f[r];
    }
    LAS float* ex = (LAS float*)(lds + EXCH) + sub * 32 * EXS;
    if (live && c == 1) {
#pragma unroll
        for (int d0 = 0; d0 < 4; ++d0)
#pragma unroll
            for (int r = 0; r < 16; ++r) ex[crow(r, hi) * EXS + d0 * 32 + r32] = o[d0][r];
    }
    __syncthreads();
    if (live && c == 0) {
#pragma unroll
        for (int d0 = 0; d0 < 4; ++d0)
#pragma unroll
            for (int r = 0; r < 16; ++r) { LAS float* e = ex + crow(r, hi) * EXS + d0 * 32 + r32; *e = o[d0][r] - *e; }
    }
    __syncthreads();
    if (live) {
        const f32x2 g = *(const f32x2*)(PRM(subln_g) + 2 * lane);
#pragma unroll 4
        for (int rr = 0; rr < 16; ++rr) {
            const int row = c * 16 + rr;
            const f32x2 v = *(const LAS f32x2*)(ex + row * EXS + 2 * lane);
            const float ss = wave_sum(v.x * v.x + v.y * v.y);
            const float rs = rsqrtf(ss * (1.f / 128.f) + NEPS) * 0.8f;
            const bool ok = !SAMPLE || row < 16;
            const size_t grow = SAMPLE ? (size_t)(M_P + b * 16 + row) : (size_t)(b * 2048 + qblk * 128 + sub * 32 + row);
            if (ok) *(unsigned*)(OA + grow * 512 + h * 128 + 2 * lane) = cvtpk(v.x * rs * g.x, v.y * rs * g.y);
        }
    }
    __syncthreads();
}

template <bool SAMPLE>
__device__ __forceinline__ void sb_unit(lptr lds, const bf16_t* zA, bf16_t* OB, int b, int h, int qblk) {
    const int tid = tid_fresh(), lane = tid & 63, r32 = lane & 31, hi = lane >> 5, wid = __builtin_amdgcn_readfirstlane(tid >> 6);
    const bf16_t* QB = zA + 3 * ZSEC; const bf16_t* KB = zA + 4 * ZSEC; const bf16_t* VB = zA + 5 * ZSEC;
    const int qw = SAMPLE ? 2048 : qblk * 256 + wid * 32;
    const int qpos = SAMPLE ? 2048 + (r32 & 15) : qw + r32;
    const size_t qrow = SAMPLE ? (size_t)(M_P + b * 16 + (r32 & 15)) : (size_t)(b * 2048 + qpos);
    bf16x8 qr[4];
#pragma unroll
    for (int d0 = 0; d0 < 4; ++d0) qr[d0] = *(const bf16x8*)(QB + qrow * 512 + h * 64 + d0 * 16 + hi * 8);
    const int t_hi = SAMPLE ? 32 : 4 * qblk + 3;
    const int tw = qw >> 6;
    const bool active = !SAMPLE || wid == 0;
    f32x16 o[2]; o[0] = f32x16{}; o[1] = f32x16{};
    float R = 0.f;
    bool mydone = !active;
    LAS int* flags = (LAS int*)(lds + CTL);
    if (lane == 0) { flags[wid] = mydone ? 1 : 0; flags[8 + wid] = mydone ? 1 : 0; }
    const int vlane = ((lane >> 4) & 1) * 32 + (lane & 3) * 8 + (4 * hi + ((lane & 15) >> 2)) * SB_VS;
    const float* ck = SAMPLE ? PRM(csk) : nullptr; const float* cv = SAMPLE ? PRM(csv) : nullptr;
    SBStage<SAMPLE> st;
    st.load(ck, cv, KB, VB, b, h, t_hi, tid);
    st.store(lds + (t_hi & 1) * BUFB, tid);
    if (t_hi > 0) st.load(ck, cv, KB, VB, b, h, t_hi - 1, tid);
    for (int t = t_hi; t >= 0; --t) {
        __syncthreads();
        { int nd = 0;
#pragma unroll
          for (int w = 0; w < 8; ++w) nd += flags[((t + 1) & 1) * 8 + w];
          if (nd == 8) break; }
        lptr tb = lds + (t & 1) * BUFB;
        if (t > 0) { st.store(lds + ((t - 1) & 1) * BUFB, tid); if (t > 1) st.load(ck, cv, KB, VB, b, h, t - 2, tid); }
        if (!mydone && t <= tw) {
            f32x16 p0 = f32x16{}, p1 = f32x16{};
#pragma unroll
            for (int d0 = 0; d0 < 4; ++d0) {
                lptr ka = tb + SB_K + (2 * d0 + hi) * KCH + r32 * 16;
                const bf16x8 b0 = *(const LAS bf16x8*)ka, b1 = *(const LAS bf16x8*)(ka + 512);
                p0 = MFMA32(b0, qr[d0], p0); p1 = MFMA32(b1, qr[d0], p1);
            }
            float x[32], lk[32];
#pragma unroll
            for (int r = 0; r < 16; ++r) { x[r] = p0[r]; x[16 + r] = p1[r]; }
            const int kb = 64 * t + 4 * hi;
#pragma unroll
            for (int i = 0; i < 32; ++i) {
                const float z = x[i];
                const float e = fexp2(-fabsf(z) * L2E);
                const float sp = fmaxf(z, 0.f) + LN2 * flog2(1.f + e);
                const bool msk = (kb + 8 * (i >> 2) + (i & 3)) < qpos;
                lk[i] = msk ? -sp : 0.f;
                x[i] = msk ? (z - sp) : -1e30f;
            }
            float gs[8], gp[8];
#pragma unroll
            for (int k = 0; k < 8; ++k) { gs[k] = (lk[4 * k] + lk[4 * k + 1]) + (lk[4 * k + 2] + lk[4 * k + 3]); gp[k] = __shfl_xor(gs[k], 32); }
            float run = R;
#pragma unroll
            for (int k = 7; k >= 0; --k) {
                const float c3 = run + (hi == 0 ? gp[k] : 0.f), c2 = c3 + lk[4 * k + 3], c1 = c2 + lk[4 * k + 2], c0 = c1 + lk[4 * k + 1];
                x[4 * k + 3] += c3; x[4 * k + 2] += c2; x[4 * k + 1] += c1; x[4 * k] += c0;
                run += gs[k] + gp[k];
            }
            R = run;
#pragma unroll
            for (int i = 0; i < 32; ++i) x[i] = fexp2(x[i] * L2E);
            bf16x8 pw[4];
#pragma unroll
            for (int ks = 0; ks < 4; ++ks) { u32x4 w; w.x = cvtpk(x[8 * ks], x[8 * ks + 1]); w.y = cvtpk(x[8 * ks + 2], x[8 * ks + 3]); w.z = cvtpk(x[8 * ks + 4], x[8 * ks + 5]); w.w = cvtpk(x[8 * ks + 6], x[8 * ks + 7]); pw[ks] = __builtin_bit_cast(bf16x8, w); }
#pragma unroll
            for (int d0 = 0; d0 < 2; ++d0)
#pragma unroll
                for (int ks = 0; ks < 4; ++ks) {
                    lptr va = tb + SB_V + vlane + ks * 16 * SB_VS + d0 * 64;
                    const s16x4 lo = vtr(va), hh = vtr(va + 8 * SB_VS);
                    const bf16x8 vf = (bf16x8){lo[0], lo[1], lo[2], lo[3], hh[0], hh[1], hh[2], hh[3]};
                    o[d0] = MFMA32(pw[ks], vf, o[d0]);
                }
            if (__all(R < SB_THR)) mydone = true;
        }
        if (lane == 0) flags[(t & 1) * 8 + wid] = mydone ? 1 : 0;
    }
    __syncthreads();
    if (active) {
#pragma unroll
        for (int d0 = 0; d0 < 2; ++d0)
#pragma unroll
            for (int r = 0; r < 16; ++r) {
                const int q = crow(r, hi);
                const bool ok = !SAMPLE || q < 16;
                const size_t grow = SAMPLE ? (size_t)(M_P + b * 16 + q) : (size_t)(b * 2048 + qw + q);
                if (ok) OB[grow * 512 + h * 64 + d0 * 32 + r32] = (bf16_t)(cvtpk(o[d0][r], 0.f) & 0xffffu);
            }
    }
}

__device__ __forceinline__ void attention_phase(lptr lds, unsigned* counter) {
    const int tid = tid_fresh(), lane = tid & 63;
    bf16_t* zA = (bf16_t*)(PRM(ws) + WS_A);
    bf16_t* OA = zA + 10 * ZSEC; bf16_t* OB = zA + 11 * ZSEC;
    const float d1 = wave_sum(PRM(lq1)[lane] * PRM(lk1)[lane]), d2 = wave_sum(PRM(lq2)[lane] * PRM(lk2)[lane]);
    const float lam = expf(d1) - expf(d2) + 0.2f;
    LAS int* ctl = (LAS int*)(lds + CTL);
    for (;;) {
        __syncthreads();
        if (tid == 0) ctl[16] = (int)atomicAdd(counter, 1u);
        __syncthreads();
        int u = __builtin_amdgcn_readfirstlane(ctl[16]);
        if (u >= NUNITS) break;
        if (u < NU_DAS) { da_unit<true>(lds, zA, OA, u >> 2, u & 3, 0, lam); continue; }
        u -= NU_DAS;
        if (u < NU_SBS) { sb_unit<true>(lds, zA, OB, u >> 3, u & 7, 0); continue; }
        u -= NU_SBS;
        if (u < NU_DAP) { const int bh = u & 63; da_unit<false>(lds, zA, OA, bh >> 2, bh & 3, 15 - (u >> 6), lam); continue; }
        u -= NU_DAP;
        { const int bh = u & 127; sb_unit<false>(lds, zA, OB, bh >> 3, bh & 7, 7 - (u >> 7)); }
    }
}
#undef MFMA32
}

#define XB_TMO      128
#define XB_XCNT(j)  (256  + 64 * (j))
#define XB_XSUB(j)  (1280 + 64 * (j))
#define XB_XGEN(j)  (2304 + 64 * (j))
#define XB_TOP      3328
#define XB_TOPGEN   3392
#define XCD_BAR_WORDS 3456
#define XB_SPIN_CAP (1u << 18)

__device__ __forceinline__ unsigned xb_ld(unsigned* p)              { return __hip_atomic_load(p, __ATOMIC_RELAXED, __HIP_MEMORY_SCOPE_AGENT); }
__device__ __forceinline__ unsigned xb_add(unsigned* p, unsigned v) { return __hip_atomic_fetch_add(p, v, __ATOMIC_RELAXED, __HIP_MEMORY_SCOPE_AGENT); }
__device__ __forceinline__ unsigned xb_xcc_id() { return (unsigned)__builtin_amdgcn_s_getreg((3 << 11) | 20) & 0xFu; }
#define XB_SPIN(cond, bar) do { unsigned _sp = 0; while (cond) { __builtin_amdgcn_s_sleep(1); \
    if ((++_sp & 255u) == 0u) { if (xb_ld(&(bar)[XB_TMO])) break; if (_sp > XB_SPIN_CAP) { atomicAdd(&(bar)[XB_TMO], 1u); break; } } } } while (0)

struct XcdBarrier {
    unsigned* bar; unsigned x;
    volatile LAS unsigned* st;
};

__device__ __forceinline__ XcdBarrier xcd_barrier_post(unsigned* bar, volatile LAS unsigned* st) {
    XcdBarrier b; b.bar = bar; b.x = xb_xcc_id(); b.st = st;
    if (threadIdx.x == 0) (void)xb_add(&bar[XB_XCNT(b.x)], 1u);
    return b;
}
__device__ __forceinline__ void xcd_barrier_complete(unsigned* bar, unsigned x, unsigned& nloc, unsigned& nx) {
    const unsigned G = gridDim.x * gridDim.y * gridDim.z;
    unsigned sum, cnt, mine, sp = 0u;
    for (;;) {
        sum = 0u; cnt = 0u; mine = 0u;
#pragma unroll
        for (unsigned j = 0; j < 16; ++j) { const unsigned c = xb_ld(&bar[XB_XCNT(j)]); sum += c; cnt += (c > 0u) ? 1u : 0u; mine = (j == x) ? c : mine; }
        if (sum == G) break;
        __builtin_amdgcn_s_sleep(1);
        if ((++sp & 255u) == 0u) { if (xb_ld(&bar[XB_TMO])) break; if (sp > XB_SPIN_CAP) { atomicAdd(&bar[XB_TMO], 1u); break; } }
    }
    nloc = mine > 0u ? mine : 1u; nx = cnt > 0u ? cnt : 1u;
}

__device__ __forceinline__ void xcd_barrier(const XcdBarrier& b) {
    asm volatile("s_waitcnt vmcnt(0)" ::: "memory");
    __syncthreads();
    if (threadIdx.x == 0) {
        unsigned* bar = b.bar;
        __builtin_amdgcn_s_waitcnt(0);
        unsigned nloc = b.st[0], nx = b.st[1];
        if (nloc == 0u) { xcd_barrier_complete(bar, b.x, nloc, nx); b.st[0] = nloc; b.st[1] = nx; }
        const unsigned old = xb_add(&bar[XB_XSUB(b.x)], 1u);
        const unsigned gen = old / nloc;
        if (old + 1u == (gen + 1u) * nloc) {
            __builtin_amdgcn_fence(__ATOMIC_RELEASE, "agent");
            asm volatile("s_waitcnt vmcnt(0)" ::: "memory");
            const unsigned og = xb_add(&bar[XB_TOP], 1u);
            const unsigned tg = og / nx;
            if (og + 1u == (tg + 1u) * nx) xb_add(&bar[XB_TOPGEN], 1u);
            else XB_SPIN(xb_ld(&bar[XB_TOPGEN]) == tg, bar);
            __builtin_amdgcn_fence(__ATOMIC_ACQUIRE, "agent");
            xb_add(&bar[XB_XGEN(b.x)], 1u);
            asm volatile("s_waitcnt vmcnt(0)" ::: "memory");
        } else {
            XB_SPIN(xb_ld(&bar[XB_XGEN(b.x)]) == gen, bar);
            __builtin_amdgcn_fence(__ATOMIC_ACQUIRE, "agent");
            asm volatile("s_waitcnt vmcnt(0)" ::: "memory");
        }
    }
    __syncthreads();
}

constexpr int LDS_BYTES = 147456;
__global__ void __launch_bounds__(512, 2) fwd_megakernel(Params p) {
    extern __shared__ __attribute__((aligned(16))) unsigned char lds_raw[];
    lptr lds = (lptr)lds_raw;
    cg::grid_group grid = cg::this_grid();
    const int tid = threadIdx.x, lane = tid & 63, wave = __builtin_amdgcn_readfirstlane(tid >> 6);
    const int G = gridDim.x, gw = blockIdx.x * 8 + wave, NGW = G * 8;
    if (tid == 0) {
        prm_st(lds, offsetof(Params, x_prompt), p.x_prompt); prm_st(lds, offsetof(Params, x_sample), p.x_sample); prm_st(lds, offsetof(Params, cdk), p.cdk); prm_st(lds, offsetof(Params, cdv), p.cdv);
        prm_st(lds, offsetof(Params, csk), p.csk); prm_st(lds, offsetof(Params, csv), p.csv); prm_st(lds, offsetof(Params, state_conv), p.state_conv); prm_st(lds, offsetof(Params, attn_g), p.attn_g);
        prm_st(lds, offsetof(Params, w_in), p.w_in); prm_st(lds, offsetof(Params, lq1), p.lq1); prm_st(lds, offsetof(Params, lk1), p.lk1); prm_st(lds, offsetof(Params, lq2), p.lq2); prm_st(lds, offsetof(Params, lk2), p.lk2);
        prm_st(lds, offsetof(Params, subln_g), p.subln_g); prm_st(lds, offsetof(Params, w_a), p.w_a); prm_st(lds, offsetof(Params, w_b), p.w_b); prm_st(lds, offsetof(Params, w_out), p.w_out); prm_st(lds, offsetof(Params, ffn_g), p.ffn_g);
        prm_st(lds, offsetof(Params, w_up), p.w_up); prm_st(lds, offsetof(Params, conv_w), p.conv_w); prm_st(lds, offsetof(Params, conv_b), p.conv_b); prm_st(lds, offsetof(Params, w_down), p.w_down); prm_st(lds, offsetof(Params, final_g), p.final_g);
        prm_st(lds, offsetof(Params, out), p.out); prm_st(lds, offsetof(Params, ws), p.ws);
    }
    __syncthreads();
#define ws PRM(ws)
    float* rstd1 = (float*)(ws + WS_RSTD); float* ssq1 = (float*)(ws + WS_SSQ1);
    bf16_t* WinT = (bf16_t*)(ws + WS_WIN); bf16_t* WaT = (bf16_t*)(ws + WS_WA); bf16_t* WbT = (bf16_t*)(ws + WS_WB); bf16_t* WoutT = (bf16_t*)(ws + WS_WOUT);
    bf16_t* WupT = (bf16_t*)(ws + WS_WUP); bf16_t* WdnT = (bf16_t*)(ws + WS_WDN);
    bf16_t* zA = (bf16_t*)(ws + WS_A); bf16_t* U = zA;
    bf16_t* XB = (bf16_t*)(ws + WS_B); bf16_t* MG = XB + (size_t)M_TOK * 1024; bf16_t* H = XB;
    bf16_t* X1B = (bf16_t*)(ws + WS_X1B);
    unsigned* counter = (unsigned*)(ws + WS_CTL);
    volatile LAS unsigned* bst = (volatile LAS unsigned*)(lds + 131072 + 512);
    if (tid == 0) { bst[0] = 0u; bst[1] = 0u; }
    __syncthreads();

    {
        if (blockIdx.x == 0) for (int i = tid; i < 4096; i += 512) counter[i] = 0u;
        LAS float* scr = (LAS float*)(lds + wave * 16384);
        constexpr int I_IN = 16 * 160, I_A = 8 * 32, I_O = 16 * 32, I_UP = 16 * 176, I_DN = 44 * 32, NITEMS = I_IN + 2 * I_A + I_O + I_UP + I_DN;
        for (int it = gw; it < NITEMS; it += NGW) {
            int r = it;
            if (r < I_IN) { transpose_item<1>(PRM(w_in), 1024, NIN, WinT, PRM(attn_g), scr, r, lane); continue; } r -= I_IN;
            if (r < I_A) { transpose_item<0>(PRM(w_a), 512, 1024, WaT, nullptr, scr, r, lane); continue; } r -= I_A;
            if (r < I_A) { transpose_item<0>(PRM(w_b), 512, 1024, WbT, nullptr, scr, r, lane); continue; } r -= I_A;
            if (r < I_O) { transpose_item<0>(PRM(w_out), 1024, 1024, WoutT, nullptr, scr, r, lane); continue; } r -= I_O;
            if (r < I_UP) { transpose_item<2>(PRM(w_up), 1024, NUP, WupT, PRM(ffn_g), scr, r, lane); continue; } r -= I_UP;
            transpose_item<0>(PRM(w_down), DFF, 1024, WdnT, nullptr, scr, r, lane);
        }
        for (int row = gw; row < M_TOK; row += NGW) {
            const float* xr = row < M_P ? PRM(x_prompt) + (size_t)row * 1024 : PRM(x_sample) + (size_t)(row - M_P) * 1024;
            f32x4 v[4]; float s = 0.f;
#pragma unroll
            for (int j = 0; j < 4; ++j) { v[j] = *(const f32x4*)(xr + 4 * lane + 256 * j); s += (v[j][0] * v[j][0] + v[j][1] * v[j][1]) + (v[j][2] * v[j][2] + v[j][3] * v[j][3]); }
            s = wave_sum(s);
            if (lane == 0) rstd1[row] = rsqrtf(s * (1.f / 1024.f) + NEPS);
#pragma unroll
            for (int j = 0; j < 4; ++j) { u32x2 w; w.x = cvtpk(v[j][0], v[j][1]); w.y = cvtpk(v[j][2], v[j][3]); *(u32x2*)(XB + (size_t)row * 1024 + 4 * lane + 256 * j) = w; }
        }
    }
    grid.sync();
    const XcdBarrier xbar = xcd_barrier_post(counter + 256, bst);
    {
        pg8::Gemm g{XB, WinT, M_TOK, NIN, 1024}; pg8::StaticOrder S; S.init(M_TOK, NIN, G, (int)blockIdx.x);
        EpiIn E{rstd1, zA, PRM(out)};
        pg8::gemm_phase<EpiIn, pg8::StaticOrder, true, true>(lds, g, S, E);
    }
    xcd_barrier(xbar);
    att::attention_phase(lds, counter);
    xcd_barrier(xbar);
    {
        pg8::Gemm g{zA + 10 * ZSEC, WaT, M_TOK, 1024, 512}; pg8::StaticOrder S; S.init(M_TOK, 1024, G, (int)blockIdx.x);
        EpiMerge<true> E{zA + 6 * ZSEC, MG};
        pg8::gemm_phase<EpiMerge<true>, pg8::StaticOrder, true, true>(lds, g, S, E);
    }
    {
        pg8::Gemm g{zA + 11 * ZSEC, WbT, M_TOK, 1024, 512}; pg8::StaticOrder S; S.init(M_TOK, 1024, G, (int)blockIdx.x);
        EpiMerge<false> E{zA + 8 * ZSEC, MG};
        pg8::gemm_phase<EpiMerge<false>, pg8::StaticOrder, true, true>(lds, g, S, E);
    }
    xcd_barrier(xbar);
    {
        pg8::Gemm g{MG, WoutT, M_TOK, 1024, 1024}; pg8::StaticOrder S; S.init(M_TOK, 1024, G, (int)blockIdx.x);
        EpiRes<true> E{PRM(x_prompt), PRM(x_sample), PRM(out) + O_Y, X1B, ssq1};
        pg8::gemm_phase<EpiRes<true>, pg8::StaticOrder, true, true>(lds, g, S, E);
    }
    xcd_barrier(xbar);
    {
        pg8::Gemm g{X1B, WupT, M_TOK, NUP, 1024}; pg8::StaticOrder S; S.init(M_TOK, NUP, G, (int)blockIdx.x);
        EpiUpConv E{ssq1, U, H, PRM(out), PRM(conv_w), PRM(conv_b), lds + 131072 + 4096};
        pg8::gemm_phase<EpiUpConv, pg8::StaticOrder, true, true>(lds, g, S, E);
    }
    xcd_barrier(xbar);
    {
        constexpr int NCH = DFF / 8, NPAIR = M_P / 64 + 512 / 16, TOTAL = NPAIR * NCH;
        for (int it = blockIdx.x * 512 + tid; it < TOTAL; it += G * 512) {
            const int pr = it / NCH, ch = it - pr * NCH, j0 = ch * 8;
            const bool samp = pr >= M_P / 64;
            const int row0 = samp ? M_P + (pr - M_P / 64) * 16 : pr * 64;
            const bool first = samp || (row0 & 2047) == 0;
            float wg[3][8], wv[3][8], bg[8], bv[8];
#pragma unroll
            for (int j = 0; j < 3; ++j)
#pragma unroll
                for (int e = 0; e < 8; ++e) { wg[j][e] = PRM(conv_w)[j * NUP + j0 + e]; wv[j][e] = PRM(conv_w)[j * NUP + DFF + j0 + e]; }
#pragma unroll
            for (int e = 0; e < 8; ++e) { bg[e] = PRM(conv_b)[j0 + e]; bv[e] = PRM(conv_b)[DFF + j0 + e]; }
            f32x4 g2[2], g1[2], v2[2], v1[2];
            if (first) {
                if (samp) { const float* sc = PRM(state_conv) + (size_t)((row0 - M_P) >> 4) * 2 * NUP;
                    g2[0] = *(const f32x4*)(sc + j0); g2[1] = *(const f32x4*)(sc + j0 + 4); v2[0] = *(const f32x4*)(sc + DFF + j0); v2[1] = *(const f32x4*)(sc + DFF + j0 + 4);
                    g1[0] = *(const f32x4*)(sc + NUP + j0); g1[1] = *(const f32x4*)(sc + NUP + j0 + 4); v1[0] = *(const f32x4*)(sc + NUP + DFF + j0); v1[1] = *(const f32x4*)(sc + NUP + DFF + j0 + 4);
                } else { g2[0] = g2[1] = g1[0] = g1[1] = v2[0] = v2[1] = v1[0] = v1[1] = (f32x4){0.f, 0.f, 0.f, 0.f}; }
            } else {
                att::expand8(*(const u32x4*)(U + (size_t)(row0 - 2) * NUP + j0), g2[0], g2[1]); att::expand8(*(const u32x4*)(U + (size_t)(row0 - 2) * NUP + DFF + j0), v2[0], v2[1]);
                att::expand8(*(const u32x4*)(U + (size_t)(row0 - 1) * NUP + j0), g1[0], g1[1]); att::expand8(*(const u32x4*)(U + (size_t)(row0 - 1) * NUP + DFF + j0), v1[0], v1[1]);
            }
#pragma unroll
            for (int r = 0; r < 2; ++r) {
                f32x4 g0[2], v0[2];
                att::expand8(*(const u32x4*)(U + (size_t)(row0 + r) * NUP + j0), g0[0], g0[1]); att::expand8(*(const u32x4*)(U + (size_t)(row0 + r) * NUP + DFF + j0), v0[0], v0[1]);
                f32x4 hh[2];
#pragma unroll
                for (int q = 0; q < 2; ++q)
#pragma unroll
                    for (int e = 0; e < 4; ++e) {
                        const int i = 4 * q + e;
                        const float cgt = bg[i] + wg[0][i] * g2[q][e] + wg[1][i] * g1[q][e] + wg[2][i] * g0[q][e];
                        const float cvl = bv[i] + wv[0][i] * v2[q][e] + wv[1][i] * v1[q][e] + wv[2][i] * v0[q][e];
                        hh[q][e] = cgt * sigmoidf_(cgt) * cvl;
                    }
                *(u32x4*)(H + (size_t)(row0 + r) * DFF + j0) = pack8(hh[0], hh[1]);
                g2[0] = g1[0]; g2[1] = g1[1]; v2[0] = v1[0]; v2[1] = v1[1]; g1[0] = g0[0]; g1[1] = g0[1]; v1[0] = v0[0]; v1[1] = v0[1];
            }
        }
    }
    xcd_barrier(xbar);
    {
        pg8::Gemm g{H, WdnT, M_TOK, 1024, DFF}; pg8::StaticOrder S; S.init(M_P, 1024, G, (int)blockIdx.x);
        EpiDown E{PRM(out) + O_Y, (float*)(ws + WS_A)};
        pg8::gemm_phase<EpiDown, pg8::StaticOrder, true, true>(lds, g, S, E);
        DownOrder S2; S2.init(G, (int)blockIdx.x);
        pg8::gemm_phase<EpiDown, DownOrder, true, true, 4>(lds, g, S2, E);
    }
    xcd_barrier(xbar);
    for (int row = gw; row < M_TOK; row += NGW) {
        float* yr = PRM(out) + O_Y + (size_t)row * 1024;
        f32x4 v[4]; float s = 0.f;
#pragma unroll
        for (int j = 0; j < 4; ++j) {
            v[j] = *(const f32x4*)(yr + 4 * lane + 256 * j);
            if (row >= M_P) {
#pragma unroll
                for (int ks = 0; ks < 11; ++ks) v[j] += *(const f32x4*)((const float*)(ws + WS_A) + ((size_t)ks * 512 + (row - M_P)) * 1024 + 4 * lane + 256 * j);
            }
            s += (v[j][0] * v[j][0] + v[j][1] * v[j][1]) + (v[j][2] * v[j][2] + v[j][3] * v[j][3]);
        }
        const float rs = rsqrtf(wave_sum(s) * (1.f / 1024.f) + NEPS);
#pragma unroll
        for (int j = 0; j < 4; ++j) { const int c = 4 * lane + 256 * j; const f32x4 g = *(const f32x4*)(PRM(final_g) + c); *(f32x4*)(yr + c) = v[j] * rs * g; }
    }
}
#undef ws

extern "C" void kernel_launch(void* const* d_in, const int* in_sizes, int n_in, void* d_out, int out_size, void* d_ws, size_t ws_size, hipStream_t stream) {
    static int grid = 0;
    if (grid == 0) {
        if (n_in != 23 || (size_t)out_size != O_END || ws_size < WS_END) { fprintf(stderr, "kernel_launch: unexpected sizes n_in %d out %d ws %zu (need %zu)\n", n_in, out_size, ws_size, (size_t)WS_END); grid = -1; return; }
        int dev = 0, cus = 0, per_cu = 0;
        hipGetDevice(&dev); hipDeviceGetAttribute(&cus, hipDeviceAttributeMultiprocessorCount, dev);
        if (hipFuncSetAttribute((const void*)fwd_megakernel, hipFuncAttributeMaxDynamicSharedMemorySize, LDS_BYTES) != hipSuccess) { fprintf(stderr, "kernel_launch: hipFuncSetAttribute failed\n"); grid = -1; return; }
        if (hipOccupancyMaxActiveBlocksPerMultiprocessor(&per_cu, (const void*)fwd_megakernel, 512, LDS_BYTES) != hipSuccess || per_cu < 1) { fprintf(stderr, "kernel_launch: occupancy query says %d\n", per_cu); per_cu = 1; }
        (void)hipGetLastError();
        grid = cus * 1;
    }
    if (grid < 0) return;
    Params p{};
    p.x_prompt = (const float*)d_in[0]; p.x_sample = (const float*)d_in[1]; p.cdk = (const float*)d_in[2]; p.cdv = (const float*)d_in[3]; p.csk = (const float*)d_in[4]; p.csv = (const float*)d_in[5];
    p.state_conv = (const float*)d_in[6]; p.attn_g = (const float*)d_in[7]; p.w_in = (const float*)d_in[8]; p.lq1 = (const float*)d_in[9]; p.lk1 = (const float*)d_in[10]; p.lq2 = (const float*)d_in[11];
    p.lk2 = (const float*)d_in[12]; p.subln_g = (const float*)d_in[13]; p.w_a = (const float*)d_in[14]; p.w_b = (const float*)d_in[15]; p.w_out = (const float*)d_in[16]; p.ffn_g = (const float*)d_in[17];
    p.w_up = (const float*)d_in[18]; p.conv_w = (const float*)d_in[19]; p.conv_b = (const float*)d_in[20]; p.w_down = (const float*)d_in[21]; p.final_g = (const float*)d_in[22];
    p.out = (float*)d_out; p.ws = (unsigned char*)d_ws;
    void* args[] = {&p};
    hipError_t e = hipLaunchCooperativeKernel((const void*)fwd_megakernel, dim3(grid), dim3(512), args, LDS_BYTES, stream);
    if (e != hipSuccess) fprintf(stderr, "cooperative launch failed: %s (grid %d)\n", hipGetErrorString(e), grid);
}
```

```cpp
#include <hip/hip_runtime.h>
#include <hip/hip_cooperative_groups.h>
#include <cstdio>
#include <cstdint>
namespace cg = cooperative_groups;
__device__ __forceinline__ int tid_fresh() { int t = (int)threadIdx.x; asm volatile("" : "+v"(t)); return t; }
namespace pg8 {
#define PG8_LAS __attribute__((address_space(3)))
typedef unsigned short bf16_t;
typedef short bf16x8 __attribute__((ext_vector_type(8)));
typedef float f32x4 __attribute__((ext_vector_type(4)));
typedef unsigned u32x4 __attribute__((ext_vector_type(4)));
constexpr int BM = 256, BK = 64, HALF = 128, HTB = HALF * BK * 2  , STAGE_BYTES = 8 * HTB, NXCD = 8, WGM = 8;

__host__ __device__ __forceinline__ int lds_byte(int r, int c) { const int st = (r >> 4) * 2 + (c >> 5), rr = r & 15, cc = c & 31, ob = rr * 64 + cc * 2; return st * 1024 + (ob ^ (((ob >> 9) & 1) << 5)); }
__host__ __device__ __forceinline__ void stage_rc(int b, int& R, int& C) { const int st = b / 1024, sb = b % 1024, swz = sb ^ (((sb >> 9) & 1) << 5); R = (st >> 1) * 16 + swz / 64; C = (st & 1) * 32 + (swz % 64) / 2; }
__host__ __device__ __forceinline__ int perm32(int rho) { const int n = rho >> 4, i = rho & 15; return 8 * (i >> 2) + 4 * n + (i & 3); }

struct Unit { int pm, pn, kb, nt; };
struct Gemm { const bf16_t* A; const bf16_t* Bt; int M, N, K; };

struct StaticOrder {
    int nM, nN, nwg, G, c;
    __host__ __device__ void init(int M, int N, int G_, int c_) { nM = M / BM; nN = N / BM; nwg = nM * nN; G = G_; c = c_; }
    __host__ __device__ bool next(int i, Unit& u) const {
        const long L = (long)i * G + c; if (L >= nwg) return false;
        int wgid = (int)L; { const int q = nwg / NXCD, r = nwg % NXCD, xcd = wgid % NXCD, off = wgid / NXCD; wgid = (xcd < r ? xcd * (q + 1) : r * (q + 1) + (xcd - r) * q) + off; }
        const int nig = WGM * nN, gid = wgid / nig, fm = gid * WGM, gsz = (nM - fm) < WGM ? (nM - fm) : WGM;
        u.pm = fm + ((wgid % nig) % gsz); u.pn = (wgid % nig) / gsz; u.kb = 0; u.nt = 0; return true;
    }
    __device__ __forceinline__ void a_ready(const Unit&) const {}
    __device__ __forceinline__ void done(const Unit&) const {}
};

__device__ __forceinline__ unsigned cvt_pk_bf16(float lo, float hi) { unsigned r; asm volatile("v_cvt_pk_bf16_f32 %0, %1, %2" : "=v"(r) : "v"(lo), "v"(hi)); return r; }
typedef float f32x2 __attribute__((ext_vector_type(2)));
template <class Epi, class Sched, bool ALIGN_EPI = false, bool SP2 = false, int NTC = 0>
__device__ __forceinline__ void gemm_phase(PG8_LAS unsigned char* lds, const Gemm g, const Sched& S, const Epi& E) {
    const int tid = tid_fresh(), wid = __builtin_amdgcn_readfirstlane(tid >> 6), lane = tid & 63, wr = wid >> 2, wc = wid & 3, fr = lane & 15, fq = lane >> 4;
    const int K = g.K; int nt = NTC ? NTC : K / BK;
    if (NTC) asm volatile("" : "+s"(nt));
    unsigned voffA[2], voffB[2];
#pragma unroll
    for (int i = 0; i < 2; ++i) { int R, C; stage_rc(tid * 16 + i * 8192, R, C); const int Rb = Epi::PERM ? ((R & ~31) + perm32(R & 31)) : R;
        voffA[i] = (unsigned)(R * K + C) * 2u; voffB[i] = (unsigned)(Rb * K + C) * 2u; }
    const size_t kstep = (size_t)(BK * 2);
    const size_t hstep = (size_t)HALF * K * 2;
    const size_t tstep = 2 * hstep;
    const unsigned ldsw = (unsigned)wid * 1024u;
    const int aoff = lds_byte(wr * 64 + fr, fq * 8), boff = lds_byte(wc * 32 + fr, fq * 8);
#define PG8_SA(b, h) (((b) * 2 + (h)) * HTB)
#define PG8_SB(b, h) ((4 + (b) * 2 + (h)) * HTB)
#define PG8_STAGE(bufoff, gbase, voff) do { _Pragma("unroll") for (int _i = 0; _i < 2; ++_i) \
        __builtin_amdgcn_global_load_lds((const unsigned*)((const char*)(gbase) + (voff)[_i]), (PG8_LAS unsigned*)(lds + (bufoff) + ldsw + _i * 8192), 16, 0, 0); } while (0)
#define PG8_LDA(dst, b, h) do { _Pragma("unroll") for (int m = 0; m < 4; ++m) _Pragma("unroll") for (int k = 0; k < 2; ++k) dst[m][k] = *(const PG8_LAS bf16x8*)(lds + PG8_SA(b, h) + aoff + m * 2048 + k * 1024); } while (0)
#define PG8_LDB(dst, b, h) do { _Pragma("unroll") for (int n = 0; n < 2; ++n) _Pragma("unroll") for (int k = 0; k < 2; ++k) dst[n][k] = *(const PG8_LAS bf16x8*)(lds + PG8_SB(b, h) + boff + n * 2048 + k * 1024); } while (0)
#define PG8_MMA(ai, bj, At, Bt) do { __builtin_amdgcn_s_setprio(1); _Pragma("unroll") for (int m = 0; m < 4; ++m) _Pragma("unroll") for (int n = 0; n < 2; ++n) _Pragma("unroll") for (int k = 0; k < 2; ++k) \
        acc[ai][bj][m][n] = __builtin_amdgcn_mfma_f32_16x16x32_bf16(Bt[n][k], At[m][k], acc[ai][bj][m][n], 0, 0, 0); __builtin_amdgcn_s_setprio(0); } while (0)
#define PG8_WAIT_V(n) asm volatile("s_waitcnt vmcnt(" #n ")" ::: "memory")
#define PG8_WAIT_L(n) asm volatile("s_waitcnt lgkmcnt(" #n ")" ::: "memory")
#define PG8_BAR __builtin_amdgcn_s_barrier()
#define PG8_SCHED __builtin_amdgcn_sched_barrier(0)
    Unit cur, nxt; int ui = 0;
    if (!S.next(0, cur)) return;
    f32x4 acc[2][2][4][2];
#pragma unroll
    for (int a = 0; a < 2; ++a)
#pragma unroll
        for (int b = 0; b < 2; ++b)
#pragma unroll
            for (int m = 0; m < 4; ++m)
#pragma unroll
                for (int n = 0; n < 2; ++n) acc[a][b][m][n] = (f32x4){0.f, 0.f, 0.f, 0.f};
    bf16x8 At[4][2], B0[2][2], B1[2][2];
    const char* cA = (const char*)g.A + (size_t)cur.pm * tstep + (size_t)cur.kb * kstep; const char* cB = (const char*)g.Bt + (size_t)cur.pn * tstep + (size_t)cur.kb * kstep;
    S.a_ready(cur);
    if constexpr (SP2) {
        PG8_STAGE(PG8_SB(0, 0), cB, voffB); PG8_STAGE(PG8_SB(0, 1), cB + hstep, voffB); PG8_STAGE(PG8_SA(0, 0), cA, voffA); PG8_STAGE(PG8_SA(0, 1), cA + hstep, voffA);
        if (wr == 1) PG8_BAR;
        PG8_WAIT_V(2); PG8_BAR;
        PG8_STAGE(PG8_SB(1, 0), cB + kstep, voffB); PG8_STAGE(PG8_SA(1, 0), cA + kstep, voffA); PG8_STAGE(PG8_SB(1, 1), cB + hstep + kstep, voffB);
        PG8_WAIT_V(6); PG8_BAR;
    } else {
        PG8_STAGE(PG8_SB(0, 0), cB, voffB); PG8_STAGE(PG8_SA(0, 0), cA, voffA); PG8_STAGE(PG8_SB(0, 1), cB + hstep, voffB); PG8_STAGE(PG8_SA(0, 1), cA + hstep, voffA);
        if (wr == 1) PG8_BAR;
        PG8_WAIT_V(4); PG8_BAR;
        PG8_STAGE(PG8_SB(1, 0), cB + kstep, voffB); PG8_STAGE(PG8_SA(1, 0), cA + kstep, voffA); PG8_STAGE(PG8_SB(1, 1), cB + hstep + kstep, voffB);
        PG8_WAIT_V(6); PG8_BAR;
    }
    for (;;) {
        const bool has_next = S.next(ui + 1, nxt);
        const char* nA = has_next ? (const char*)g.A + (size_t)nxt.pm * tstep + (size_t)nxt.kb * kstep : cA; const char* nB = has_next ? (const char*)g.Bt + (size_t)nxt.pn * tstep + (size_t)nxt.kb * kstep : cB;
        for (int t = 0; t < nt; t += 2) {
            const bool last = (t == nt - 2);
            const char* a1 = cA + (size_t)(t + 1) * kstep;
            const char* a2 = last ? nA : cA + (size_t)(t + 2) * kstep; const char* b2 = last ? nB : cB + (size_t)(t + 2) * kstep;
            const char* a3 = a2 + kstep; const char* b3 = b2 + kstep;
            if (last && has_next) S.a_ready(nxt);
            if constexpr (SP2) {
            PG8_LDB(B0, 0, 0); PG8_LDB(B1, 0, 1); PG8_SCHED; PG8_LDA(At, 0, 0); PG8_STAGE(PG8_SA(1, 1), a1 + hstep, voffA);
            PG8_WAIT_V(8); PG8_WAIT_L(0); PG8_BAR; PG8_MMA(0, 0, At, B0); PG8_MMA(0, 1, At, B1); PG8_BAR; PG8_SCHED;
            PG8_LDA(At, 0, 1); PG8_STAGE(PG8_SB(0, 0), b2, voffB); PG8_STAGE(PG8_SB(0, 1), b2 + hstep, voffB); PG8_STAGE(PG8_SA(0, 0), a2, voffA);
            PG8_WAIT_V(8); PG8_WAIT_L(0); PG8_BAR; PG8_MMA(1, 0, At, B0); PG8_MMA(1, 1, At, B1); PG8_BAR; PG8_SCHED;
            PG8_LDB(B0, 1, 0); PG8_LDB(B1, 1, 1); PG8_SCHED; PG8_LDA(At, 1, 0); PG8_STAGE(PG8_SA(0, 1), a2 + hstep, voffA);
            PG8_WAIT_V(8); PG8_WAIT_L(0); PG8_BAR; PG8_MMA(0, 0, At, B0); PG8_MMA(0, 1, At, B1); PG8_BAR; PG8_SCHED;
            PG8_LDA(At, 1, 1); PG8_STAGE(PG8_SB(1, 0), b3, voffB); PG8_STAGE(PG8_SB(1, 1), b3 + hstep, voffB); PG8_STAGE(PG8_SA(1, 0), a3, voffA);
            PG8_WAIT_V(8); PG8_WAIT_L(0); PG8_BAR; PG8_MMA(1, 0, At, B0); PG8_MMA(1, 1, At, B1); PG8_BAR; PG8_SCHED;
            } else {
            PG8_LDB(B0, 0, 0); PG8_SCHED; PG8_LDA(At, 0, 0); PG8_STAGE(PG8_SA(1, 1), a1 + hstep, voffA);
            PG8_WAIT_L(8); PG8_BAR; PG8_WAIT_L(0); PG8_MMA(0, 0, At, B0); PG8_BAR; PG8_SCHED;
            PG8_LDB(B1, 0, 1); PG8_STAGE(PG8_SB(0, 0), b2, voffB);
            PG8_BAR; PG8_WAIT_L(0); PG8_MMA(0, 1, At, B1); PG8_BAR;
            PG8_LDA(At, 0, 1); PG8_STAGE(PG8_SA(0, 0), a2, voffA);
            PG8_BAR; PG8_WAIT_L(0); PG8_MMA(1, 0, At, B0); PG8_BAR; PG8_SCHED;
            PG8_STAGE(PG8_SB(0, 1), b2 + hstep, voffB);
            PG8_WAIT_V(6); PG8_BAR; PG8_MMA(1, 1, At, B1); PG8_BAR;
            PG8_LDB(B0, 1, 0); PG8_SCHED; PG8_LDA(At, 1, 0); PG8_STAGE(PG8_SA(0, 1), a2 + hstep, voffA);
            PG8_WAIT_L(8); PG8_BAR; PG8_WAIT_L(0); PG8_MMA(0, 0, At, B0); PG8_BAR; PG8_SCHED;
            PG8_LDB(B1, 1, 1); PG8_STAGE(PG8_SB(1, 0), b3, voffB);
            PG8_BAR; PG8_WAIT_L(0); PG8_MMA(0, 1, At, B1); PG8_BAR;
            PG8_LDA(At, 1, 1); PG8_STAGE(PG8_SA(1, 0), a3, voffA);
            PG8_BAR; PG8_WAIT_L(0); PG8_MMA(1, 0, At, B0); PG8_BAR; PG8_SCHED;
            PG8_STAGE(PG8_SB(1, 1), b3 + hstep, voffB);
            PG8_WAIT_V(6); PG8_BAR; PG8_MMA(1, 1, At, B1); PG8_BAR;
            }
        }
        if constexpr (ALIGN_EPI) { if (wr == 0) PG8_BAR; }
        if constexpr (!Epi::AFTER_DRAIN) { E(acc, cur, wr, wc, fr, fq); S.done(cur); }
        if (!has_next) break;
#pragma unroll
        for (int a = 0; a < 2; ++a)
#pragma unroll
            for (int b = 0; b < 2; ++b)
#pragma unroll
                for (int m = 0; m < 4; ++m)
#pragma unroll
                    for (int n = 0; n < 2; ++n) acc[a][b][m][n] = (f32x4){0.f, 0.f, 0.f, 0.f};
        cur = nxt; cA = nA; cB = nB; ++ui;
        if constexpr (ALIGN_EPI) { if (wr == 1) PG8_BAR; }
    }
    PG8_WAIT_V(0);
    if constexpr (!ALIGN_EPI) { if (wr == 0) PG8_BAR; }
    PG8_BAR;
    if constexpr (Epi::AFTER_DRAIN) { E.fused(acc, cur, wr, wc, fr, fq, lds, wid, lane); S.done(cur); }
#undef PG8_SA
#undef PG8_SB
#undef PG8_STAGE
#undef PG8_LDA
#undef PG8_LDB
#undef PG8_MMA
#undef PG8_WAIT_V
#undef PG8_WAIT_L
#undef PG8_BAR
#undef PG8_SCHED
}
}

#define LAS __attribute__((address_space(3)))
typedef LAS unsigned char* lptr;
typedef unsigned short bf16_t;
typedef float f32x4 __attribute__((ext_vector_type(4)));
typedef float f32x2 __attribute__((ext_vector_type(2)));
typedef float f32x16 __attribute__((ext_vector_type(16)));
typedef unsigned u32x4 __attribute__((ext_vector_type(4)));
typedef unsigned u32x2 __attribute__((ext_vector_type(2)));
typedef short bf16x8 __attribute__((ext_vector_type(8)));
typedef short s16x4 __attribute__((ext_vector_type(4)));
typedef short v4i16_t __attribute__((ext_vector_type(4)));

constexpr int M_TOK = 33280, M_P = 32768, DM = 1024, NIN = 5120, DFF = 2816, NUP = 5632;
constexpr float L2E = 1.4426950408889634f, LN2 = 0.6931471805599453f, NEPS = 1e-6f;
constexpr size_t O_Y = 0, O_PDK = 34078720, O_PDV = O_PDK + 16777216, O_PSK = O_PDV + 16777216, O_PSV = O_PSK + 16777216,
                 O_PCONV = O_PSV + 16777216, O_SDK = O_PCONV + 180224, O_SDV = O_SDK + 262144, O_SSK = O_SDV + 262144, O_SSV = O_SSK + 262144,
                 O_SCONV = O_SSV + 262144, O_END = O_SCONV + 360448;
constexpr size_t WS_CTL = 0, WS_RSTD = 16384, WS_SSQ1 = WS_RSTD + 133120, WS_SSQ2 = WS_SSQ1 + 2129920, WS_WIN = WS_SSQ2 + 2129920,
                 WS_WA = WS_WIN + 10485760, WS_WB = WS_WA + 1048576, WS_WOUT = WS_WB + 1048576, WS_WUP = WS_WOUT + 2097152,
                 WS_WDN = WS_WUP + 11534336, WS_A = WS_WDN + 5767168, WS_B = WS_A + 408944640, WS_X1B = WS_B + 187432960, WS_END = WS_X1B + 68157440;
constexpr size_t ZSEC = (size_t)M_TOK * 512;

struct Params {
    const float* x_prompt; const float* x_sample; const float* cdk; const float* cdv; const float* csk; const float* csv; const float* state_conv;
    const float* attn_g; const float* w_in; const float* lq1; const float* lk1; const float* lq2; const float* lk2; const float* subln_g;
    const float* w_a; const float* w_b; const float* w_out; const float* ffn_g; const float* w_up; const float* conv_w; const float* conv_b;
    const float* w_down; const float* final_g; float* out; unsigned char* ws;
};

constexpr int PRM_OFF = 131072 + 1024;
template <class T> __device__ __forceinline__ T prm_ld(lptr lds, int off) {
    const LAS unsigned* q = (const LAS unsigned*)(lds + PRM_OFF + off); unsigned lo = q[0], hi = q[1];
    lo = __builtin_amdgcn_readfirstlane(lo); hi = __builtin_amdgcn_readfirstlane(hi);
    return (T)(__attribute__((address_space(1))) void*)(((unsigned long long)hi << 32) | lo);
}
template <class T> __device__ __forceinline__ void prm_st(lptr lds, int off, T v) { *(LAS unsigned long long*)(lds + PRM_OFF + off) = (unsigned long long)v; }
#define PRM(f) prm_ld<decltype(Params::f)>(lds, (int)offsetof(Params, f))
__device__ __forceinline__ float bflo(unsigned w) { return __uint_as_float(w << 16); }
__device__ __forceinline__ float bfhi(unsigned w) { return __uint_as_float(w & 0xffff0000u); }
__device__ __forceinline__ unsigned cvtpk(float lo, float hi) { unsigned r; asm volatile("v_cvt_pk_bf16_f32 %0, %1, %2" : "=v"(r) : "v"(lo), "v"(hi)); return r; }
__device__ __forceinline__ u32x4 pack8(f32x4 a, f32x4 b) { u32x4 w; w.x = cvtpk(a[0], a[1]); w.y = cvtpk(a[2], a[3]); w.z = cvtpk(b[0], b[1]); w.w = cvtpk(b[2], b[3]); return w; }
__device__ __forceinline__ float wave_sum(float v) {
#pragma unroll
    for (int o = 1; o < 64; o <<= 1) v += __shfl_xor(v, o);
    return v;
}
__device__ __forceinline__ float fexp2(float x) { return __builtin_amdgcn_exp2f(x); }
__device__ __forceinline__ float flog2(float x) { return __builtin_amdgcn_logf(x); }
__device__ __forceinline__ float frcp(float x) { return __builtin_amdgcn_rcpf(x); }
__device__ __forceinline__ float sigmoidf_(float x) { return frcp(1.f + fexp2(-x * L2E)); }

struct EpiIn {
    static constexpr bool PERM = true, AFTER_DRAIN = false;
    const float* rstd; bf16_t* z; float* out;
    __device__ __forceinline__ void operator()(const pg8::f32x4 (&acc)[2][2][4][2], const pg8::Unit& u, int wr, int wc, int fr, int fq) const {
        const int pn = u.pn; const bool samp = u.pm >= 128;
        bf16_t* zb; int ld, tcol; float* fo = nullptr; float sc = 1.f; int mode = 0;
        if (pn < 12) {
            const int sec = pn >> 1; zb = z + (size_t)sec * ZSEC; ld = 512; tcol = (pn & 1) * 256;
            if (sec < 2) mode = 1;
            if (sec == 0) sc = 0.125f * L2E; else if (sec == 3) sc = 0.125f;
            if (sec == 1) fo = out + (samp ? O_SDK : O_PDK); else if (sec == 2) fo = out + (samp ? O_SDV : O_PDV);
            else if (sec == 4) fo = out + (samp ? O_SSK : O_PSK); else if (sec == 5) fo = out + (samp ? O_SSV : O_PSV);
        } else { const int gs = (pn - 12) >> 2; zb = z + (size_t)(6 + 2 * gs) * ZSEC; ld = 1024; tcol = ((pn - 12) & 3) * 256; mode = 2; }
        const int cb = tcol + wc * 64 + fq * 8;
        float ir[2][4];
#pragma unroll
        for (int n = 0; n < 2; ++n)
#pragma unroll
            for (int e = 0; e < 4; ++e) ir[n][e] = exp2f(-(float)(8 * fq + 4 * n + e) * (13.287712379549449f / 32.f)) * 0.15915494309189535f;
#pragma unroll
        for (int ai = 0; ai < 2; ++ai)
#pragma unroll
            for (int m = 0; m < 4; ++m) {
                const int row = u.pm * 256 + ai * 128 + wr * 64 + m * 16 + fr;
                const float rs = rstd[row] * sc;
                f32x4 v[2][2];
#pragma unroll
                for (int bj = 0; bj < 2; ++bj)
#pragma unroll
                    for (int n = 0; n < 2; ++n) v[bj][n] = acc[ai][bj][m][n] * rs;
                if (mode == 1) {
                    const float pos = samp ? (float)(2048 + (row & 15)) : (float)(row & 2047);
#pragma unroll
                    for (int n = 0; n < 2; ++n)
#pragma unroll
                        for (int e = 0; e < 4; ++e) {
                            float rev = pos * ir[n][e]; rev -= rintf(rev);
                            const float sn = __builtin_amdgcn_sinf(rev), cs = __builtin_amdgcn_cosf(rev);
                            const float x1 = v[0][n][e], x2 = v[1][n][e];
                            v[0][n][e] = x1 * cs - x2 * sn; v[1][n][e] = x2 * cs + x1 * sn;
                        }
                } else if (mode == 2) {
#pragma unroll
                    for (int bj = 0; bj < 2; ++bj)
#pragma unroll
                        for (int n = 0; n < 2; ++n)
#pragma unroll
                            for (int e = 0; e < 4; ++e) v[bj][n][e] = sigmoidf_(v[bj][n][e]);
                }
                const size_t rl = samp ? (size_t)(row - M_P) : (size_t)row;
#pragma unroll
                for (int bj = 0; bj < 2; ++bj) {
                    *(u32x4*)(zb + (size_t)row * ld + cb + 32 * bj) = pack8(v[bj][0], v[bj][1]);
                    if (fo) { float* d = fo + rl * 512 + cb + 32 * bj; *(f32x4*)d = v[bj][0]; *(f32x4*)(d + 4) = v[bj][1]; }
                }
            }
    }
};
template <bool FIRST> struct EpiMerge {
    static constexpr bool PERM = true, AFTER_DRAIN = false;
    const bf16_t* gate; bf16_t* mg;
    __device__ __forceinline__ void operator()(const pg8::f32x4 (&acc)[2][2][4][2], const pg8::Unit& u, int wr, int wc, int fr, int fq) const {
#pragma unroll
        for (int ai = 0; ai < 2; ++ai)
#pragma unroll
            for (int m = 0; m < 4; ++m) {
                const int row = u.pm * 256 + ai * 128 + wr * 64 + m * 16 + fr;
#pragma unroll
                for (int bj = 0; bj < 2; ++bj) {
                    const size_t off = (size_t)row * 1024 + u.pn * 256 + bj * 128 + wc * 32 + fq * 8;
                    const u32x4 g = *(const u32x4*)(gate + off);
                    f32x4 a = acc[ai][bj][m][0], b = acc[ai][bj][m][1];
                    a[0] *= bflo(g.x); a[1] *= bfhi(g.x); a[2] *= bflo(g.y); a[3] *= bfhi(g.y);
                    b[0] *= bflo(g.z); b[1] *= bfhi(g.z); b[2] *= bflo(g.w); b[3] *= bfhi(g.w);
                    if (!FIRST) { const u32x4 o = *(const u32x4*)(mg + off);
                        a[0] += bflo(o.x); a[1] += bfhi(o.x); a[2] += bflo(o.y); a[3] += bfhi(o.y);
                        b[0] += bflo(o.z); b[1] += bfhi(o.z); b[2] += bflo(o.w); b[3] += bfhi(o.w); }
                    *(u32x4*)(mg + off) = pack8(a, b);
                }
            }
    }
};
template <bool WRITE_BF> struct EpiRes {
    static constexpr bool PERM = true, AFTER_DRAIN = false;
    const float* base_p; const float* base_s; float* y; bf16_t* yb; float* ssq;
    __device__ __forceinline__ void operator()(const pg8::f32x4 (&acc)[2][2][4][2], const pg8::Unit& u, int wr, int wc, int fr, int fq) const {
        const bool samp = u.pm >= 128;
#pragma unroll
        for (int ai = 0; ai < 2; ++ai)
#pragma unroll
            for (int m = 0; m < 4; ++m) {
                const int row = u.pm * 256 + ai * 128 + wr * 64 + m * 16 + fr;
                const float* brow = samp ? base_s + (size_t)(row - M_P) * 1024 : base_p + (size_t)row * 1024;
                float s = 0.f;
#pragma unroll
                for (int bj = 0; bj < 2; ++bj) {
                    const int col = u.pn * 256 + bj * 128 + wc * 32 + fq * 8;
                    f32x4 a = acc[ai][bj][m][0] + *(const f32x4*)(brow + col), b = acc[ai][bj][m][1] + *(const f32x4*)(brow + col + 4);
                    s += (a[0] * a[0] + a[1] * a[1]) + (a[2] * a[2] + a[3] * a[3]) + (b[0] * b[0] + b[1] * b[1]) + (b[2] * b[2] + b[3] * b[3]);
                    float* d = y + (size_t)row * 1024 + col; *(f32x4*)d = a; *(f32x4*)(d + 4) = b;
                    if (WRITE_BF) *(u32x4*)(yb + (size_t)row * 1024 + col) = pack8(a, b);
                }
                s += __shfl_xor(s, 16); s += __shfl_xor(s, 32);
                if (fq == 0) ssq[(size_t)row * 16 + u.pn * 4 + wc] = s;
            }
    }
};
struct EpiUp {
    static constexpr bool PERM = true, AFTER_DRAIN = false;
    const float* ssq; bf16_t* U; float* out;
    __device__ __forceinline__ void operator()(const pg8::f32x4 (&acc)[2][2][4][2], const pg8::Unit& u, int wr, int wc, int fr, int fq) const {
        const bool samp = u.pm >= 128;
#pragma unroll
        for (int ai = 0; ai < 2; ++ai)
#pragma unroll
            for (int m = 0; m < 4; ++m) {
                const int row = u.pm * 256 + ai * 128 + wr * 64 + m * 16 + fr;
                const f32x4* sp = (const f32x4*)(ssq + (size_t)row * 16);
                const f32x4 s0 = sp[0], s1 = sp[1], s2 = sp[2], s3 = sp[3];
                const float tot = ((s0[0] + s0[1]) + (s0[2] + s0[3])) + ((s1[0] + s1[1]) + (s1[2] + s1[3])) + ((s2[0] + s2[1]) + (s2[2] + s2[3])) + ((s3[0] + s3[1]) + (s3[2] + s3[3]));
                const float rs = rsqrtf(tot * (1.f / 1024.f) + NEPS);
                float* cs = nullptr;
                if (!samp) { const int t = row & 2047; if (t >= 2046) cs = out + O_PCONV + (size_t)((row >> 11) * 2 + (t - 2046)) * NUP; }
                else { const int t = row & 15; if (t >= 14) cs = out + O_SCONV + (size_t)(((row - M_P) >> 4) * 2 + (t - 14)) * NUP; }
#pragma unroll
                for (int bj = 0; bj < 2; ++bj) {
                    const int col = u.pn * 256 + bj * 128 + wc * 32 + fq * 8;
                    const f32x4 a = acc[ai][bj][m][0] * rs, b = acc[ai][bj][m][1] * rs;
                    *(u32x4*)(U + (size_t)row * NUP + col) = pack8(a, b);
                    if (cs) { *(f32x4*)(cs + col) = a; *(f32x4*)(cs + col + 4) = b; }
                }
            }
    }
};


__device__ __forceinline__ float dpp_ror1(float v) { return __int_as_float(__builtin_amdgcn_update_dpp(0, __float_as_int(v), 0x121, 0xf, 0xf, false)); }
__device__ __forceinline__ float dpp_ror2(float v) { return __int_as_float(__builtin_amdgcn_update_dpp(0, __float_as_int(v), 0x122, 0xf, 0xf, false)); }
struct EpiUpConv {
    static constexpr bool PERM = true, AFTER_DRAIN = false;
    const float* ssq; bf16_t* U; bf16_t* H; float* out; const float* cw; const float* cb; lptr wl;
    __device__ __forceinline__ void operator()(const pg8::f32x4 (&acc)[2][2][4][2], const pg8::Unit& u, int wr, int wc, int fr, int fq) const {
        const bool samp = u.pm >= 128;
        const int j0 = u.pn * 128 + wc * 32 + fq * 8;
        {
            const int t_ = (wr * 4 + wc) * 64 + fq * 16 + fr;
#pragma unroll
            for (int i = 0; i < 2; ++i) { const int idx = t_ + 512 * i, k = idx >> 8, p = idx & 255, col = (p >> 7) * DFF + u.pn * 128 + (p & 127);
                ((LAS float*)wl)[idx] = k < 3 ? cw[k * NUP + col] : cb[col]; }
            asm volatile("s_waitcnt lgkmcnt(0)\n\ts_barrier" ::: "memory");
        }
        const LAS float* wq = (const LAS float*)wl + wc * 32 + fq * 8;
        float rs[2][4];
#pragma unroll
        for (int ai = 0; ai < 2; ++ai)
#pragma unroll
            for (int m = 0; m < 4; ++m) {
                const int row = u.pm * 256 + ai * 128 + wr * 64 + m * 16 + fr;
                const f32x4 s0 = *((const f32x4*)(ssq + (size_t)row * 16) + fq);
                float tot = (s0[0] + s0[1]) + (s0[2] + s0[3]);
                tot += __shfl_xor(tot, 16); tot += __shfl_xor(tot, 32);
                rs[ai][m] = rsqrtf(tot * (1.f / 1024.f) + NEPS);
            }
        __builtin_amdgcn_sched_barrier(0);
#pragma unroll
        for (int n = 0; n < 2; ++n) {
            const int jc = j0 + 4 * n;
#pragma unroll
            for (int ai = 0; ai < 2; ++ai) {
                f32x4 k1g = (f32x4){0.f, 0.f, 0.f, 0.f}, k2g = k1g, k1v = k1g, k2v = k1g;
#pragma unroll
                for (int m = 0; m < 4; ++m) {
                    const int row = u.pm * 256 + ai * 128 + wr * 64 + m * 16 + fr;
                    const f32x4 ug = acc[ai][0][m][n] * rs[ai][m], uv = acc[ai][1][m][n] * rs[ai][m];
                    float* cs = nullptr;
                    if (!samp) { const int t = row & 2047; if (t >= 2046) cs = out + O_PCONV + (size_t)((row >> 11) * 2 + (t - 2046)) * NUP; }
                    else { const int t = row & 15; if (t >= 14) cs = out + O_SCONV + (size_t)(((row - M_P) >> 4) * 2 + (t - 14)) * NUP; }
                    if (cs) { *(f32x4*)(cs + jc) = ug; *(f32x4*)(cs + DFF + jc) = uv; }
                    const int lr = samp ? (row & 15) : (row & 63);
                    const bool keep = samp ? (lr < 2) : (lr < 2 || lr >= 62);
                    if (keep) { u32x2 wg, wv; wg.x = cvtpk(ug[0], ug[1]); wg.y = cvtpk(ug[2], ug[3]); wv.x = cvtpk(uv[0], uv[1]); wv.y = cvtpk(uv[2], uv[3]);
                        *(u32x2*)(U + (size_t)row * NUP + jc) = wg; *(u32x2*)(U + (size_t)row * NUP + DFF + jc) = wv; }
                    f32x4 c1g, c2g, c1v, c2v;
#pragma unroll
                    for (int e = 0; e < 4; ++e) { c1g[e] = dpp_ror1(ug[e]); c2g[e] = dpp_ror2(ug[e]); c1v[e] = dpp_ror1(uv[e]); c2v[e] = dpp_ror2(uv[e]); }
                    f32x4 p1g, p2g, p1v, p2v;
#pragma unroll
                    for (int e = 0; e < 4; ++e) { p1g[e] = fr >= 1 ? c1g[e] : k1g[e]; p2g[e] = fr >= 2 ? c2g[e] : k2g[e]; p1v[e] = fr >= 1 ? c1v[e] : k1v[e]; p2v[e] = fr >= 2 ? c2v[e] : k2v[e]; }
                    k1g = c1g; k2g = c2g; k1v = c1v; k2v = c2v;
                    f32x4 hh;
                    { const f32x4 w0g = *(const LAS f32x4*)(wq + 4 * n), w1g = *(const LAS f32x4*)(wq + 256 + 4 * n), w2g = *(const LAS f32x4*)(wq + 512 + 4 * n), bg = *(const LAS f32x4*)(wq + 768 + 4 * n);
                      const f32x4 cg = bg + w0g * p2g + w1g * p1g + w2g * ug;
#pragma unroll
                      for (int e = 0; e < 4; ++e) hh[e] = cg[e] * sigmoidf_(cg[e]); }
                    { const f32x4 w0v = *(const LAS f32x4*)(wq + 128 + 4 * n), w1v = *(const LAS f32x4*)(wq + 384 + 4 * n), w2v = *(const LAS f32x4*)(wq + 640 + 4 * n), bv = *(const LAS f32x4*)(wq + 896 + 4 * n);
                      const f32x4 cv = bv + w0v * p2v + w1v * p1v + w2v * uv;
                      hh = hh * cv; }
                    const bool deferred = samp ? (fr < 2) : (m == 0 && fr < 2);
                    if (!deferred) { u32x2 w; w.x = cvtpk(hh[0], hh[1]); w.y = cvtpk(hh[2], hh[3]); *(u32x2*)(H + (size_t)row * DFF + jc) = w; }
                }
            }
        }
    }
};

struct EpiDown {
    static constexpr bool PERM = true, AFTER_DRAIN = false;
    float* y; float* part;
    __device__ __forceinline__ void operator()(const pg8::f32x4 (&acc)[2][2][4][2], const pg8::Unit& u, int wr, int wc, int fr, int fq) const {
        const bool split = u.pm >= 128;
#pragma unroll
        for (int ai = 0; ai < 2; ++ai)
#pragma unroll
            for (int m = 0; m < 4; ++m) {
                const int row = u.pm * 256 + ai * 128 + wr * 64 + m * 16 + fr;
#pragma unroll
                for (int bj = 0; bj < 2; ++bj) {
                    float* d = y + (size_t)row * 1024 + u.pn * 256 + bj * 128 + wc * 32 + fq * 8;
                    if (!split) { const f32x4 a = acc[ai][bj][m][0] + *(const f32x4*)d, b = acc[ai][bj][m][1] + *(const f32x4*)(d + 4); *(f32x4*)d = a; *(f32x4*)(d + 4) = b; }
                    else { float* q = part + ((size_t)(u.kb >> 2) * 512 + (row - M_P)) * 1024 + u.pn * 256 + bj * 128 + wc * 32 + fq * 8; *(f32x4*)q = acc[ai][bj][m][0]; *(f32x4*)(q + 4) = acc[ai][bj][m][1]; }
                }
            }
    }
};
struct DownOrder {
    int G, c;
    __device__ void init(int G_, int c_) { G = G_; c = c_; }
    __device__ bool next(int i, pg8::Unit& u) const {
        const int s = i * G + c; if (s >= 88) return false;
        u.pm = 128 + (s & 1); u.pn = (s >> 1) & 3; u.kb = 4 * (s >> 3); u.nt = 4; return true;
    }
    __device__ __forceinline__ void a_ready(const pg8::Unit&) const {}
    __device__ __forceinline__ void done(const pg8::Unit&) const {}
};

template <int PERMROWS>
__device__ __forceinline__ void transpose_item(const float* W, int K, int N, bf16_t* WT, const float* g, LAS float* scr, int item, int lane) {
    const int nblk = N / 32, kb = item / nblk, nb = item % nblk, k0 = 64 * kb, n0 = 32 * nb;
#pragma unroll 8
    for (int i = 0; i < 32; ++i) { const int kk = 2 * i + (lane >> 5); float v = W[(size_t)(k0 + kk) * N + n0 + (lane & 31)]; if (g) v *= g[k0 + kk]; scr[kk * 33 + (lane & 31)] = v; }
    asm volatile("s_waitcnt lgkmcnt(0)" ::: "memory");
    const int c = lane & 7;
#pragma unroll
    for (int j = 0; j < 4; ++j) {
        const int n = (lane >> 3) + 8 * j; const LAS float* s = scr + (8 * c) * 33 + n;
        u32x4 o; o.x = cvtpk(s[0 * 33], s[1 * 33]); o.y = cvtpk(s[2 * 33], s[3 * 33]); o.z = cvtpk(s[4 * 33], s[5 * 33]); o.w = cvtpk(s[6 * 33], s[7 * 33]);
        int nn = n0 + n;
        if (PERMROWS == 1) { const int p = nn & 255; nn = (nn & ~255) + ((p >> 5) & 1) * 128 + (p >> 6) * 32 + (p & 31); }
        if (PERMROWS == 2) { const int bj = nn >= DFF ? 1 : 0, j = nn - DFF * bj; nn = (j >> 7) * 256 + bj * 128 + (j & 127); }
        *(u32x4*)(WT + (size_t)nn * K + k0 + 8 * c) = o;
    }
    asm volatile("s_waitcnt lgkmcnt(0)" ::: "memory");
}

namespace att {
constexpr int KCH = 1040, KMAP = 8 * KCH;
constexpr int DA_K = 0, DA_V = 2 * KMAP, DA_VS = 320;
constexpr int SB_K = 0, SB_V = KMAP, SB_VS = 192;
constexpr int BUFB = 37376, WSF = 2 * BUFB, CTL = WSF + 2048, EXCH = 0, EXS = 132;
constexpr int NU_DAS = 128, NU_SBS = 256, NU_DAP = 1024, NU_SBP = 1024, NUNITS = NU_DAS + NU_SBS + NU_DAP + NU_SBP;
constexpr float SB_THR = -88.0f;

__device__ __forceinline__ s16x4 vtr(lptr p) { return __builtin_bit_cast(s16x4, __builtin_amdgcn_ds_read_tr16_b64_v4i16((LAS v4i16_t*)p)); }
__device__ __forceinline__ int crow(int r, int hi) { return (r & 3) + 8 * (r >> 2) + 4 * hi; }
__device__ __forceinline__ void expand8(u32x4 w, f32x4& a, f32x4& b) { a[0] = bflo(w.x); a[1] = bfhi(w.x); a[2] = bflo(w.y); a[3] = bfhi(w.y); b[0] = bflo(w.z); b[1] = bfhi(w.z); b[2] = bflo(w.w); b[3] = bfhi(w.w); }

template <bool SAMPLE> struct DAStage;
template <> struct DAStage<false> {
    u32x4 k[2], v[2];
    __device__ __forceinline__ void load(const float* ck, const float* cv, const bf16_t* KA, const bf16_t* VA, int b, int h, int t, int tid) {
#pragma unroll
        for (int i = 0; i < 2; ++i) { const int id = tid + 512 * i, row = id >> 4, ch = id & 15; const size_t off = (size_t)(b * 2048 + 64 * t + row) * 512 + h * 128 + ch * 8;
            k[i] = *(const u32x4*)(KA + off); v[i] = *(const u32x4*)(VA + off); }
    }
    __device__ __forceinline__ void store(lptr lds, int tid) {
#pragma unroll
        for (int i = 0; i < 2; ++i) { const int id = tid + 512 * i, row = id >> 4, ch = id & 15;
            *(LAS u32x4*)(lds + DA_K + (ch >> 3) * KMAP + (ch & 7) * KCH + row * 16) = k[i]; *(LAS u32x4*)(lds + DA_V + row * DA_VS + ch * 16) = v[i]; }
    }
};
template <> struct DAStage<true> {
    f32x4 k[2][2], v[2][2];
    __device__ __forceinline__ void load(const float* ck, const float* cv, const bf16_t* KA, const bf16_t* VA, int b, int h, int t, int tid) {
#pragma unroll
        for (int i = 0; i < 2; ++i) { const int id = tid + 512 * i, row = id >> 4, ch = id & 15;
            if (t < 32) { const size_t off = ((size_t)(b * 2048 + 64 * t + row) * 4 + h) * 128 + ch * 8;
                k[i][0] = *(const f32x4*)(ck + off); k[i][1] = *(const f32x4*)(ck + off + 4); v[i][0] = *(const f32x4*)(cv + off); v[i][1] = *(const f32x4*)(cv + off + 4); }
            else if (row < 16) { const size_t off = (size_t)(M_P + b * 16 + row) * 512 + h * 128 + ch * 8; expand8(*(const u32x4*)(KA + off), k[i][0], k[i][1]); expand8(*(const u32x4*)(VA + off), v[i][0], v[i][1]); }
            else { k[i][0] = k[i][1] = v[i][0] = v[i][1] = (f32x4){0.f, 0.f, 0.f, 0.f}; } }
    }
    __device__ __forceinline__ void store(lptr lds, int tid) {
#pragma unroll
        for (int i = 0; i < 2; ++i) { const int id = tid + 512 * i, row = id >> 4, ch = id & 15;
            *(LAS u32x4*)(lds + DA_K + (ch >> 3) * KMAP + (ch & 7) * KCH + row * 16) = pack8(k[i][0], k[i][1]); *(LAS u32x4*)(lds + DA_V + row * DA_VS + ch * 16) = pack8(v[i][0], v[i][1]); }
    }
};
template <bool SAMPLE> struct SBStage;
template <> struct SBStage<false> {
    u32x4 k, v;
    __device__ __forceinline__ void load(const float* ck, const float* cv, const bf16_t* KB, const bf16_t* VB, int b, int h, int t, int tid) {
        const int row = tid >> 3, ch = tid & 7; const size_t off = (size_t)(b * 2048 + 64 * t + row) * 512 + h * 64 + ch * 8;
        k = *(const u32x4*)(KB + off); v = *(const u32x4*)(VB + off);
    }
    __device__ __forceinline__ void store(lptr lds, int tid) {
        const int row = tid >> 3, ch = tid & 7;
        *(LAS u32x4*)(lds + SB_K + ch * KCH + row * 16) = k; *(LAS u32x4*)(lds + SB_V + row * SB_VS + ch * 16) = v;
    }
};
template <> struct SBStage<true> {
    f32x4 k[2], v[2];
    __device__ __forceinline__ void load(const float* ck, const float* cv, const bf16_t* KB, const bf16_t* VB, int b, int h, int t, int tid) {
        const int row = tid >> 3, ch = tid & 7;
        if (t < 32) { const size_t off = ((size_t)(b * 2048 + 64 * t + row) * 8 + h) * 64 + ch * 8;
            k[0] = *(const f32x4*)(ck + off); k[1] = *(const f32x4*)(ck + off + 4); v[0] = *(const f32x4*)(cv + off); v[1] = *(const f32x4*)(cv + off + 4); }
        else if (row < 16) { const size_t off = (size_t)(M_P + b * 16 + row) * 512 + h * 64 + ch * 8; expand8(*(const u32x4*)(KB + off), k[0], k[1]); expand8(*(const u32x4*)(VB + off), v[0], v[1]); }
        else { k[0] = k[1] = v[0] = v[1] = (f32x4){0.f, 0.f, 0.f, 0.f}; }
    }
    __device__ __forceinline__ void store(lptr lds, int tid) {
        const int row = tid >> 3, ch = tid & 7;
        *(LAS u32x4*)(lds + SB_K + ch * KCH + row * 16) = pack8(k[0], k[1]); *(LAS u32x4*)(lds + SB_V + row * SB_VS + ch * 16) = pack8(v[0], v[1]);
    }
};

#define MFMA32(a, b, c) __builtin_amdgcn_mfma_f32_32x32x16_bf16((a), (b), (c), 0, 0, 0)

template <bool SAMPLE>
__device__ __forceinline__ void da_unit(lptr lds, const bf16_t* zA, bf16_t* OA, int b, int h, int qblk, float lam) {
    const int tid = tid_fresh(), lane = tid & 63, r32 = lane & 31, hi = lane >> 5, wid = __builtin_amdgcn_readfirstlane(tid >> 6), c = wid & 1, sub = wid >> 1;
    const bf16_t* QA = zA; const bf16_t* KA = zA + ZSEC; const bf16_t* VA = zA + 2 * ZSEC;
    const size_t qrow = SAMPLE ? (size_t)(M_P + b * 16 + (r32 & 15)) : (size_t)(b * 2048 + qblk * 128 + sub * 32 + r32);
    bf16x8 qr[4];
#pragma unroll
    for (int d0 = 0; d0 < 4; ++d0) qr[d0] = *(const bf16x8*)(QA + qrow * 512 + h * 128 + c * 64 + d0 * 16 + hi * 8);
    const int nt = SAMPLE ? 33 : 2 * qblk + 2;
    const int ntw = SAMPLE ? (sub == 0 ? 33 : 0) : 2 * qblk + 1 + (sub >> 1);
    f32x16 o[4];
#pragma unroll
    for (int i = 0; i < 4; ++i) o[i] = f32x16{};
    float m = 0.f, l = 0.f;
    f32x16 negm = f32x16{};
    LAS float* wsf = (LAS float*)(lds + WSF) + wid * 64;
    const int vlane = ((lane >> 4) & 1) * 32 + (lane & 3) * 8 + (4 * hi + ((lane & 15) >> 2)) * DA_VS;
    const float* ck = SAMPLE ? PRM(cdk) : nullptr; const float* cv = SAMPLE ? PRM(cdv) : nullptr;
    DAStage<SAMPLE> st;
    st.load(ck, cv, KA, VA, b, h, 0, tid);
    for (int t = 0; t < nt; ++t) {
        __syncthreads();
        lptr tb = lds;
        st.store(lds, tid);
        __syncthreads();
        if (t + 1 < nt) st.load(ck, cv, KA, VA, b, h, t + 1, tid);
        if (t < ntw) {
            f32x16 p0, p1;
            bf16x8 kf[8];
#pragma unroll
            for (int d0 = 0; d0 < 4; ++d0) { lptr ka = tb + DA_K + c * KMAP + (2 * d0 + hi) * KCH + r32 * 16; kf[2 * d0] = *(const LAS bf16x8*)ka; kf[2 * d0 + 1] = *(const LAS bf16x8*)(ka + 512); }
            __builtin_amdgcn_sched_barrier(0);
#pragma unroll
            for (int d0 = 0; d0 < 4; ++d0) { p0 = MFMA32(kf[2 * d0], qr[d0], d0 == 0 ? negm : p0); p1 = MFMA32(kf[2 * d0 + 1], qr[d0], d0 == 0 ? negm : p1); }
            constexpr int NPRE = SAMPLE ? 1 : 3;
            s16x4 vlo[NPRE * 4], vhi[NPRE * 4];
#pragma unroll
            for (int ks = 0; ks < NPRE; ++ks)
#pragma unroll
                for (int d0 = 0; d0 < 4; ++d0) { lptr va = tb + DA_V + vlane + ks * 16 * DA_VS + d0 * 64; vlo[ks * 4 + d0] = vtr(va); vhi[ks * 4 + d0] = vtr(va + 8 * DA_VS); }
            __builtin_amdgcn_sched_barrier(0);
            if (SAMPLE && t == 32) {
#pragma unroll
                for (int r = 8; r < 16; ++r) p0[r] = -1e30f;
#pragma unroll
                for (int r = 0; r < 16; ++r) p1[r] = -1e30f;
            }
            float ra = __builtin_fmaxf(__builtin_fmaxf(p0[0], p0[1]), p1[0]), rb = __builtin_fmaxf(__builtin_fmaxf(p0[2], p0[3]), p1[1]);
            ra = __builtin_fmaxf(__builtin_fmaxf(ra, p1[2]), p1[3]);
#pragma unroll
            for (int r = 4; r < 16; r += 4) { ra = __builtin_fmaxf(__builtin_fmaxf(ra, p0[r]), p0[r + 1]); rb = __builtin_fmaxf(__builtin_fmaxf(rb, p0[r + 2]), p0[r + 3]);
                                              ra = __builtin_fmaxf(__builtin_fmaxf(ra, p1[r]), p1[r + 1]); rb = __builtin_fmaxf(__builtin_fmaxf(rb, p1[r + 2]), p1[r + 3]); }
            float rm = fmaxf(ra, rb);
            rm = fmaxf(rm, __shfl_xor(rm, 32));
            if (__any(rm > 8.f)) {
                const float dl = rm > 8.f ? rm : 0.f;
                m += dl;
                const float alpha = fexp2(-dl); l *= alpha;
#pragma unroll
                for (int r = 0; r < 16; ++r) { p0[r] -= dl; p1[r] -= dl; negm[r] = -m; }
                if (hi == 0) wsf[r32] = alpha;
                asm volatile("s_waitcnt lgkmcnt(0)" ::: "memory");
                float f[16];
#pragma unroll
                for (int r = 0; r < 16; ++r) f[r] = wsf[crow(r, hi)];
#pragma unroll
                for (int d0 = 0; d0 < 4; ++d0)
#pragma unroll
                    for (int r = 0; r < 16; ++r) o[d0][r] *= f[r];
                asm volatile("s_waitcnt lgkmcnt(0)" ::: "memory");
            }
            float ls = 0.f;
#pragma unroll
            for (int r = 0; r < 16; ++r) { p0[r] = fexp2(p0[r]); p1[r] = fexp2(p1[r]); ls += p0[r] + p1[r]; }
            l += ls;
            bf16x8 pw[4];
            { u32x4 w;
              w.x = cvtpk(p0[0], p0[1]); w.y = cvtpk(p0[2], p0[3]); w.z = cvtpk(p0[4], p0[5]); w.w = cvtpk(p0[6], p0[7]); pw[0] = __builtin_bit_cast(bf16x8, w);
              w.x = cvtpk(p0[8], p0[9]); w.y = cvtpk(p0[10], p0[11]); w.z = cvtpk(p0[12], p0[13]); w.w = cvtpk(p0[14], p0[15]); pw[1] = __builtin_bit_cast(bf16x8, w);
              w.x = cvtpk(p1[0], p1[1]); w.y = cvtpk(p1[2], p1[3]); w.z = cvtpk(p1[4], p1[5]); w.w = cvtpk(p1[6], p1[7]); pw[2] = __builtin_bit_cast(bf16x8, w);
              w.x = cvtpk(p1[8], p1[9]); w.y = cvtpk(p1[10], p1[11]); w.z = cvtpk(p1[12], p1[13]); w.w = cvtpk(p1[14], p1[15]); pw[3] = __builtin_bit_cast(bf16x8, w); }
            __builtin_amdgcn_sched_barrier(0);
#pragma unroll
            for (int ks = 0; ks < 4; ++ks)
#pragma unroll
                for (int d0 = 0; d0 < 4; ++d0) {
                    s16x4 lo, hh;
                    if (ks < NPRE) { lo = vlo[ks * 4 + d0]; hh = vhi[ks * 4 + d0]; }
                    else { lptr va = tb + DA_V + vlane + ks * 16 * DA_VS + d0 * 64; lo = vtr(va); hh = vtr(va + 8 * DA_VS); }
                    const bf16x8 vf = (bf16x8){lo[0], lo[1], lo[2], lo[3], hh[0], hh[1], hh[2], hh[3]};
                    o[d0] = MFMA32(pw[ks], vf, o[d0]);
                }
        }
    }
    __syncthreads();
    l += __shfl_xor(l, 32);
    const bool live = !SAMPLE || sub == 0;
    if (live) {
        const float fac = (c == 0) ? frcp(l) : lam * frcp(l);
        if (hi == 0) wsf[r32] = fac;
        asm volatile("s_waitcnt lgkmcnt(0)" ::: "memory");
        float f[16];
#pragma unroll
        for (int r = 0; r < 16; ++r) f[r] = wsf[crow(r, hi)];
#pragma unroll
        for (int d0 = 0; d0 < 4; ++d0)
#pragma unroll
            for (int r = 0; r < 16; ++r) o[d0][r] *= f[r];
    }
    LAS float* ex = (LAS float*)(lds + EXCH) + sub * 32 * EXS;
    if (live && c == 1) {
#pragma unroll
        for (int d0 = 0; d0 < 4; ++d0)
#pragma unroll
            for (int r = 0; r < 16; ++r) ex[crow(r, hi) * EXS + d0 * 32 + r32] = o[d0][r];
    }
    __syncthreads();
    if (live && c == 0) {
#pragma unroll
        for (int d0 = 0; d0 < 4; ++d0)
#pragma unroll
            for (int r = 0; r < 16; ++r) { LAS float* e = ex + crow(r, hi) * EXS + d0 * 32 + r32; *e = o[d0][r] - *e; }
    }
    __syncthreads();
    if (live) {
        const f32x2 g = *(const f32x2*)(PRM(subln_g) + 2 * lane);
#pragma unroll 4
        for (int rr = 0; rr < 16; ++rr) {
            const int row = c * 16 + rr;
            const f32x2 v = *(const LAS f32x2*)(ex + row * EXS + 2 * lane);
            const float ss = wave_sum(v.x * v.x + v.y * v.y);
            const float rs = rsqrtf(ss * (1.f / 128.f) + NEPS) * 0.8f;
            const bool ok = !SAMPLE || row < 16;
            const size_t grow = SAMPLE ? (size_t)(M_P + b * 16 + row) : (size_t)(b * 2048 + qblk * 128 + sub * 32 + row);
            if (ok) *(unsigned*)(OA + grow * 512 + h * 128 + 2 * lane) = cvtpk(v.x * rs * g.x, v.y * rs * g.y);
        }
    }
    __syncthreads();
}

template <bool SAMPLE>
__device__ __forceinline__ void sb_unit(lptr lds, const bf16_t* zA, bf16_t* OB, int b, int h, int qblk) {
    const int tid = tid_fresh(), lane = tid & 63, r32 = lane & 31, hi = lane >> 5, wid = __builtin_amdgcn_readfirstlane(tid >> 6);
    const bf16_t* QB = zA + 3 * ZSEC; const bf16_t* KB = zA + 4 * ZSEC; const bf16_t* VB = zA + 5 * ZSEC;
    const int qw = SAMPLE ? 2048 : qblk * 256 + wid * 32;
    const int qpos = SAMPLE ? 2048 + (r32 & 15) : qw + r32;
    const size_t qrow = SAMPLE ? (size_t)(M_P + b * 16 + (r32 & 15)) : (size_t)(b * 2048 + qpos);
    bf16x8 qr[4];
#pragma unroll
    for (int d0 = 0; d0 < 4; ++d0) qr[d0] = *(const bf16x8*)(QB + qrow * 512 + h * 64 + d0 * 16 + hi * 8);
    const int t_hi = SAMPLE ? 32 : 4 * qblk + 3;
    const int tw = qw >> 6;
    const bool active = !SAMPLE || wid == 0;
    f32x16 o[2]; o[0] = f32x16{}; o[1] = f32x16{};
    float R = 0.f;
    bool mydone = !active;
    LAS int* flags = (LAS int*)(lds + CTL);
    if (lane == 0) { flags[wid] = mydone ? 1 : 0; flags[8 + wid] = mydone ? 1 : 0; }
    const int vlane = ((lane >> 4) & 1) * 32 + (lane & 3) * 8 + (4 * hi + ((lane & 15) >> 2)) * SB_VS;
    const float* ck = SAMPLE ? PRM(csk) : nullptr; const float* cv = SAMPLE ? PRM(csv) : nullptr;
    SBStage<SAMPLE> st;
    st.load(ck, cv, KB, VB, b, h, t_hi, tid);
    st.store(lds + (t_hi & 1) * BUFB, tid);
    if (t_hi > 0) st.load(ck, cv, KB, VB, b, h, t_hi - 1, tid);
    for (int t = t_hi; t >= 0; --t) {
        __syncthreads();
        { int nd = 0;
#pragma unroll
          for (int w = 0; w < 8; ++w) nd += flags[((t + 1) & 1) * 8 + w];
          if (nd == 8) break; }
        lptr tb = lds + (t & 1) * BUFB;
        if (t > 0) { st.store(lds + ((t - 1) & 1) * BUFB, tid); if (t > 1) st.load(ck, cv, KB, VB, b, h, t - 2, tid); }
        if (!mydone && t <= tw) {
            f32x16 p0 = f32x16{}, p1 = f32x16{};
#pragma unroll
            for (int d0 = 0; d0 < 4; ++d0) {
                lptr ka = tb + SB_K + (2 * d0 + hi) * KCH + r32 * 16;
                const bf16x8 b0 = *(const LAS bf16x8*)ka, b1 = *(const LAS bf16x8*)(ka + 512);
                p0 = MFMA32(b0, qr[d0], p0); p1 = MFMA32(b1, qr[d0], p1);
            }
            float x[32], lk[32];
#pragma unroll
            for (int r = 0; r < 16; ++r) { x[r] = p0[r]; x[16 + r] = p1[r]; }
            const int kb = 64 * t + 4 * hi;
#pragma unroll
            for (int i = 0; i < 32; ++i) {
                const float z = x[i];
                const float e = fexp2(-fabsf(z) * L2E);
                const float sp = fmaxf(z, 0.f) + LN2 * flog2(1.f + e);
                const bool msk = (kb + 8 * (i >> 2) + (i & 3)) < qpos;
                lk[i] = msk ? -sp : 0.f;
                x[i] = msk ? (z - sp) : -1e30f;
            }
            float gs[8], gp[8];
#pragma unroll
            for (int k = 0; k < 8; ++k) { gs[k] = (lk[4 * k] + lk[4 * k + 1]) + (lk[4 * k + 2] + lk[4 * k + 3]); gp[k] = __shfl_xor(gs[k], 32); }
            float run = R;
#pragma unroll
            for (int k = 7; k >= 0; --k) {
                const float c3 = run + (hi == 0 ? gp[k] : 0.f), c2 = c3 + lk[4 * k + 3], c1 = c2 + lk[4 * k + 2], c0 = c1 + lk[4 * k + 1];
                x[4 * k + 3] += c3; x[4 * k + 2] += c2; x[4 * k + 1] += c1; x[4 * k] += c0;
                run += gs[k] + gp[k];
            }
            R = run;
#pragma unroll
            for (int i = 0; i < 32; ++i) x[i] = fexp2(x[i] * L2E);
            bf16x8 pw[4];
#pragma unroll
            for (int ks = 0; ks < 4; ++ks) { u32x4 w; w.x = cvtpk(x[8 * ks], x[8 * ks + 1]); w.y = cvtpk(x[8 * ks + 2], x[8 * ks + 3]); w.z = cvtpk(x[8 * ks + 4], x[8 * ks + 5]); w.w = cvtpk(x[8 * ks + 6], x[8 * ks + 7]); pw[ks] = __builtin_bit_cast(bf16x8, w); }
#pragma unroll
            for (int d0 = 0; d0 < 2; ++d0)
#pragma unroll
                for (int ks = 0; ks < 4; ++ks) {
                    lptr va = tb + SB_V + vlane + ks * 16 * SB_VS + d0 * 64;
                    const s16x4 lo = vtr(va), hh = vtr(va + 8 * SB_VS);
                    const bf16x8 vf = (bf16x8){lo[0], lo[1], lo[2], lo[3], hh[0], hh[1], hh[2], hh[3]};
                    o[d0] = MFMA32(pw[ks], vf, o[d0]);
                }
            if (__all(R < SB_THR)) mydone = true;
        }
        if (lane == 0) flags[(t & 1) * 8 + wid] = mydone ? 1 : 0;
    }
    __syncthreads();
    if (active) {
#pragma unroll
        for (int d0 = 0; d0 < 2; ++d0)
#pragma unroll
            for (int r = 0; r < 16; ++r) {
                const int q = crow(r, hi);
                const bool ok = !SAMPLE || q < 16;
                const size_t grow = SAMPLE ? (size_t)(M_P + b * 16 + q) : (size_t)(b * 2048 + qw + q);
                if (ok) OB[grow * 512 + h * 64 + d0 * 32 + r32] = (bf16_t)(cvtpk(o[d0][r], 0.f) & 0xffffu);
            }
    }
}

__device__ __forceinline__ void attention_phase(lptr lds, unsigned* counter) {
    const int tid = tid_fresh(), lane = tid & 63;
    bf16_t* zA = (bf16_t*)(PRM(ws) + WS_A);
    bf16_t* OA = zA + 10 * ZSEC; bf16_t* OB = zA + 11 * ZSEC;
    const float d1 = wave_sum(PRM(lq1)[lane] * PRM(lk1)[lane]), d2 = wave_sum(PRM(lq2)[lane] * PRM(lk2)[lane]);
    const float lam = expf(d1) - expf(d2) + 0.2f;
    LAS int* ctl = (LAS int*)(lds + CTL);
    for (;;) {
        __syncthreads();
        if (tid == 0) ctl[16] = (int)atomicAdd(counter, 1u);
        __syncthreads();
        int u = __builtin_amdgcn_readfirstlane(ctl[16]);
        if (u >= NUNITS) break;
        if (u < NU_DAS) { da_unit<true>(lds, zA, OA, u >> 2, u & 3, 0, lam); continue; }
        u -= NU_DAS;
        if (u < NU_SBS) { sb_unit<true>(lds, zA, OB, u >> 3, u & 7, 0); continue; }
        u -= NU_SBS;
        if (u < NU_DAP) { const int bh = u & 63; da_unit<false>(lds, zA, OA, bh >> 2, bh & 3, 15 - (u >> 6), lam); continue; }
        u -= NU_DAP;
        { const int bh = u & 127; sb_unit<false>(lds, zA, OB, bh >> 3, bh & 7, 7 - (u >> 7)); }
    }
}
#undef MFMA32
}

#define XB_TMO      128
#define XB_XCNT(j)  (256  + 64 * (j))
#define XB_XSUB(j)  (1280 + 64 * (j))
#define XB_XGEN(j)  (2304 + 64 * (j))
#define XB_TOP      3328
#define XB_TOPGEN   3392
#define XCD_BAR_WORDS 3456
#define XB_SPIN_CAP (1u << 18)

__device__ __forceinline__ unsigned xb_ld(unsigned* p)              { return __hip_atomic_load(p, __ATOMIC_RELAXED, __HIP_MEMORY_SCOPE_AGENT); }
__device__ __forceinline__ unsigned xb_add(unsigned* p, unsigned v) { return __hip_atomic_fetch_add(p, v, __ATOMIC_RELAXED, __HIP_MEMORY_SCOPE_AGENT); }
__device__ __forceinline__ unsigned xb_xcc_id() { return (unsigned)__builtin_amdgcn_s_getreg((3 << 11) | 20) & 0xFu; }
#define XB_SPIN(cond, bar) do { unsigned _sp = 0; while (cond) { __builtin_amdgcn_s_sleep(1); \
    if ((++_sp & 255u) == 0u) { if (xb_ld(&(bar)[XB_TMO])) break; if (_sp > XB_SPIN_CAP) { atomicAdd(&(bar)[XB_TMO], 1u); break; } } } } while (0)

struct XcdBarrier {
    unsigned* bar; unsigned x;
    volatile LAS unsigned* st;
};

__device__ __forceinline__ XcdBarrier xcd_barrier_post(unsigned* bar, volatile LAS unsigned* st) {
    XcdBarrier b; b.bar = bar; b.x = xb_xcc_id(); b.st = st;
    if (threadIdx.x == 0) (void)xb_add(&bar[XB_XCNT(b.x)], 1u);
    return b;
}
__device__ __forceinline__ void xcd_barrier_complete(unsigned* bar, unsigned x, unsigned& nloc, unsigned& nx) {
    const unsigned G = gridDim.x * gridDim.y * gridDim.z;
    unsigned sum, cnt, mine, sp = 0u;
    for (;;) {
        sum = 0u; cnt = 0u; mine = 0u;
#pragma unroll
        for (unsigned j = 0; j < 16; ++j) { const unsigned c = xb_ld(&bar[XB_XCNT(j)]); sum += c; cnt += (c > 0u) ? 1u : 0u; mine = (j == x) ? c : mine; }
        if (sum == G) break;
        __builtin_amdgcn_s_sleep(1);
        if ((++sp & 255u) == 0u) { if (xb_ld(&bar[XB_TMO])) break; if (sp > XB_SPIN_CAP) { atomicAdd(&bar[XB_TMO], 1u); break; } }
    }
    nloc = mine > 0u ? mine : 1u; nx = cnt > 0u ? cnt : 1u;
}

__device__ __forceinline__ void xcd_barrier(const XcdBarrier& b) {
    asm volatile("s_waitcnt vmcnt(0)" ::: "memory");
    __syncthreads();
    if (threadIdx.x == 0) {
        unsigned* bar = b.bar;
        __builtin_amdgcn_s_waitcnt(0);
        unsigned nloc = b.st[0], nx = b.st[1];
        if (nloc == 0u) { xcd_barrier_complete(bar, b.x, nloc, nx); b.st[0] = nloc; b.st[1] = nx; }
        const unsigned old = xb_add(&bar[XB_XSUB(b.x)], 1u);
        const unsigned gen = old / nloc;
        if (old + 1u == (gen + 1u) * nloc) {
            __builtin_amdgcn_fence(__ATOMIC_RELEASE, "agent");
            asm volatile("s_waitcnt vmcnt(0)" ::: "memory");
            const unsigned og = xb_add(&bar[XB_TOP], 1u);
            const unsigned tg = og / nx;
            if (og + 1u == (tg + 1u) * nx) xb_add(&bar[XB_TOPGEN], 1u);
            else XB_SPIN(xb_ld(&bar[XB_TOPGEN]) == tg, bar);
            __builtin_amdgcn_fence(__ATOMIC_ACQUIRE, "agent");
            xb_add(&bar[XB_XGEN(b.x)], 1u);
            asm volatile("s_waitcnt vmcnt(0)" ::: "memory");
        } else {
            XB_SPIN(xb_ld(&bar[XB_XGEN(b.x)]) == gen, bar);
            __builtin_amdgcn_fence(__ATOMIC_ACQUIRE, "agent");
            asm volatile("s_waitcnt vmcnt(0)" ::: "memory");
        }
    }
    __syncthreads();
}

constexpr int LDS_BYTES = 147456;
__global__ void __launch_bounds__(512, 2) fwd_megakernel(Params p) {
    extern __shared__ __attribute__((aligned(16))) unsigned char lds_raw[];
    lptr lds = (lptr)lds_raw;
    cg::grid_group grid = cg::this_grid();
    const int tid = threadIdx.x, lane = tid & 63, wave = __builtin_amdgcn_readfirstlane(tid >> 6);
    const int G = gridDim.x, gw = blockIdx.x * 8 + wave, NGW = G * 8;
    if (tid == 0) {
        prm_st(lds, offsetof(Params, x_prompt), p.x_prompt); prm_st(lds, offsetof(Params, x_sample), p.x_sample); prm_st(lds, offsetof(Params, cdk), p.cdk); prm_st(lds, offsetof(Params, cdv), p.cdv);
        prm_st(lds, offsetof(Params, csk), p.csk); prm_st(lds, offsetof(Params, csv), p.csv); prm_st(lds, offsetof(Params, state_conv), p.state_conv); prm_st(lds, offsetof(Params, attn_g), p.attn_g);
        prm_st(lds, offsetof(Params, w_in), p.w_in); prm_st(lds, offsetof(Params, lq1), p.lq1); prm_st(lds, offsetof(Params, lk1), p.lk1); prm_st(lds, offsetof(Params, lq2), p.lq2); prm_st(lds, offsetof(Params, lk2), p.lk2);
        prm_st(lds, offsetof(Params, subln_g), p.subln_g); prm_st(lds, offsetof(Params, w_a), p.w_a); prm_st(lds, offsetof(Params, w_b), p.w_b); prm_st(lds, offsetof(Params, w_out), p.w_out); prm_st(lds, offsetof(Params, ffn_g), p.ffn_g);
        prm_st(lds, offsetof(Params, w_up), p.w_up); prm_st(lds, offsetof(Params, conv_w), p.conv_w); prm_st(lds, offsetof(Params, conv_b), p.conv_b); prm_st(lds, offsetof(Params, w_down), p.w_down); prm_st(lds, offsetof(Params, final_g), p.final_g);
        prm_st(lds, offsetof(Params, out), p.out); prm_st(lds, offsetof(Params, ws), p.ws);
    }
    __syncthreads();
#define ws PRM(ws)
    float* rstd1 = (float*)(ws + WS_RSTD); float* ssq1 = (float*)(ws + WS_SSQ1);
    bf16_t* WinT = (bf16_t*)(ws + WS_WIN); bf16_t* WaT = (bf16_t*)(ws + WS_WA); bf16_t* WbT = (bf16_t*)(ws + WS_WB); bf16_t* WoutT = (bf16_t*)(ws + WS_WOUT);
    bf16_t* WupT = (bf16_t*)(ws + WS_WUP); bf16_t* WdnT = (bf16_t*)(ws + WS_WDN);
    bf16_t* zA = (bf16_t*)(ws + WS_A); bf16_t* U = zA;
    bf16_t* XB = (bf16_t*)(ws + WS_B); bf16_t* MG = XB + (size_t)M_TOK * 1024; bf16_t* H = XB;
    bf16_t* X1B = (bf16_t*)(ws + WS_X1B);
    unsigned* counter = (unsigned*)(ws + WS_CTL);
    volatile LAS unsigned* bst = (volatile LAS unsigned*)(lds + 131072 + 512);
    if (tid == 0) { bst[0] = 0u; bst[1] = 0u; }
    __syncthreads();

    {
        if (blockIdx.x == 0) for (int i = tid; i < 4096; i += 512) counter[i] = 0u;
        LAS float* scr = (LAS float*)(lds + wave * 16384);
        constexpr int I_IN = 16 * 160, I_A = 8 * 32, I_O = 16 * 32, I_UP = 16 * 176, I_DN = 44 * 32, NITEMS = I_IN + 2 * I_A + I_O + I_UP + I_DN;
        for (int it = gw; it < NITEMS; it += NGW) {
            int r = it;
            if (r < I_IN) { transpose_item<1>(PRM(w_in), 1024, NIN, WinT, PRM(attn_g), scr, r, lane); continue; } r -= I_IN;
            if (r < I_A) { transpose_item<0>(PRM(w_a), 512, 1024, WaT, nullptr, scr, r, lane); continue; } r -= I_A;
            if (r < I_A) { transpose_item<0>(PRM(w_b), 512, 1024, WbT, nullptr, scr, r, lane); continue; } r -= I_A;
            if (r < I_O) { transpose_item<0>(PRM(w_out), 1024, 1024, WoutT, nullptr, scr, r, lane); continue; } r -= I_O;
            if (r < I_UP) { transpose_item<2>(PRM(w_up), 1024, NUP, WupT, PRM(ffn_g), scr, r, lane); continue; } r -= I_UP;
            transpose_item<0>(PRM(w_down), DFF, 1024, WdnT, nullptr, scr, r, lane);
        }
        for (int row0 = gw; row0 < M_TOK; row0 += 4 * NGW) {
            f32x4 v[4][4];
#pragma unroll
            for (int q = 0; q < 4; ++q) { const int row = row0 + q * NGW;
                if (row < M_TOK) { const float* xr = row < M_P ? PRM(x_prompt) + (size_t)row * 1024 : PRM(x_sample) + (size_t)(row - M_P) * 1024;
#pragma unroll
                    for (int j = 0; j < 4; ++j) v[q][j] = *(const f32x4*)(xr + 4 * lane + 256 * j); } }
#pragma unroll
            for (int q = 0; q < 4; ++q) { const int row = row0 + q * NGW;
                if (row < M_TOK) { float s = 0.f;
#pragma unroll
                    for (int j = 0; j < 4; ++j) s += (v[q][j][0] * v[q][j][0] + v[q][j][1] * v[q][j][1]) + (v[q][j][2] * v[q][j][2] + v[q][j][3] * v[q][j][3]);
                    s = wave_sum(s);
                    if (lane == 0) rstd1[row] = rsqrtf(s * (1.f / 1024.f) + NEPS);
#pragma unroll
                    for (int j = 0; j < 4; ++j) { u32x2 w; w.x = cvtpk(v[q][j][0], v[q][j][1]); w.y = cvtpk(v[q][j][2], v[q][j][3]); *(u32x2*)(XB + (size_t)row * 1024 + 4 * lane + 256 * j) = w; } } }
        }
    }
    grid.sync();
    const XcdBarrier xbar = xcd_barrier_post(counter + 256, bst);
    {
        pg8::Gemm g{XB, WinT, M_TOK, NIN, 1024}; pg8::StaticOrder S; S.init(M_TOK, NIN, G, (int)blockIdx.x);
        EpiIn E{rstd1, zA, PRM(out)};
        pg8::gemm_phase<EpiIn, pg8::StaticOrder, true, true>(lds, g, S, E);
    }
    xcd_barrier(xbar);
    att::attention_phase(lds, counter);
    xcd_barrier(xbar);
    {
        pg8::Gemm g{zA + 10 * ZSEC, WaT, M_TOK, 1024, 512}; pg8::StaticOrder S; S.init(M_TOK, 1024, G, (int)blockIdx.x);
        EpiMerge<true> E{zA + 6 * ZSEC, MG};
        pg8::gemm_phase<EpiMerge<true>, pg8::StaticOrder, true, true>(lds, g, S, E);
    }
    {
        pg8::Gemm g{zA + 11 * ZSEC, WbT, M_TOK, 1024, 512}; pg8::StaticOrder S; S.init(M_TOK, 1024, G, (int)blockIdx.x);
        EpiMerge<false> E{zA + 8 * ZSEC, MG};
        pg8::gemm_phase<EpiMerge<false>, pg8::StaticOrder, true, true>(lds, g, S, E);
    }
    xcd_barrier(xbar);
    {
        pg8::Gemm g{MG, WoutT, M_TOK, 1024, 1024}; pg8::StaticOrder S; S.init(M_TOK, 1024, G, (int)blockIdx.x);
        EpiRes<true> E{PRM(x_prompt), PRM(x_sample), PRM(out) + O_Y, X1B, ssq1};
        pg8::gemm_phase<EpiRes<true>, pg8::StaticOrder, true, true>(lds, g, S, E);
    }
    xcd_barrier(xbar);
    {
        pg8::Gemm g{X1B, WupT, M_TOK, NUP, 1024}; pg8::StaticOrder S; S.init(M_TOK, NUP, G, (int)blockIdx.x);
        EpiUpConv E{ssq1, U, H, PRM(out), PRM(conv_w), PRM(conv_b), lds + 131072 + 4096};
        pg8::gemm_phase<EpiUpConv, pg8::StaticOrder, true, true>(lds, g, S, E);
    }
    xcd_barrier(xbar);
    {
        constexpr int NCH = DFF / 8, NPAIR = M_P / 64 + 512 / 16, TOTAL = NPAIR * NCH;
        for (int it = blockIdx.x * 512 + tid; it < TOTAL; it += G * 512) {
            const int pr = it / NCH, ch = it - pr * NCH, j0 = ch * 8;
            const bool samp = pr >= M_P / 64;
            const int row0 = samp ? M_P + (pr - M_P / 64) * 16 : pr * 64;
            const bool first = samp || (row0 & 2047) == 0;
            float wg[3][8], wv[3][8], bg[8], bv[8];
#pragma unroll
            for (int j = 0; j < 3; ++j)
#pragma unroll
                for (int e = 0; e < 8; ++e) { wg[j][e] = PRM(conv_w)[j * NUP + j0 + e]; wv[j][e] = PRM(conv_w)[j * NUP + DFF + j0 + e]; }
#pragma unroll
            for (int e = 0; e < 8; ++e) { bg[e] = PRM(conv_b)[j0 + e]; bv[e] = PRM(conv_b)[DFF + j0 + e]; }
            f32x4 g2[2], g1[2], v2[2], v1[2];
            if (first) {
                if (samp) { const float* sc = PRM(state_conv) + (size_t)((row0 - M_P) >> 4) * 2 * NUP;
                    g2[0] = *(const f32x4*)(sc + j0); g2[1] = *(const f32x4*)(sc + j0 + 4); v2[0] = *(const f32x4*)(sc + DFF + j0); v2[1] = *(const f32x4*)(sc + DFF + j0 + 4);
                    g1[0] = *(const f32x4*)(sc + NUP + j0); g1[1] = *(const f32x4*)(sc + NUP + j0 + 4); v1[0] = *(const f32x4*)(sc + NUP + DFF + j0); v1[1] = *(const f32x4*)(sc + NUP + DFF + j0 + 4);
                } else { g2[0] = g2[1] = g1[0] = g1[1] = v2[0] = v2[1] = v1[0] = v1[1] = (f32x4){0.f, 0.f, 0.f, 0.f}; }
            } else {
                att::expand8(*(const u32x4*)(U + (size_t)(row0 - 2) * NUP + j0), g2[0], g2[1]); att::expand8(*(const u32x4*)(U + (size_t)(row0 - 2) * NUP + DFF + j0), v2[0], v2[1]);
                att::expand8(*(const u32x4*)(U + (size_t)(row0 - 1) * NUP + j0), g1[0], g1[1]); att::expand8(*(const u32x4*)(U + (size_t)(row0 - 1) * NUP + DFF + j0), v1[0], v1[1]);
            }
#pragma unroll
            for (int r = 0; r < 2; ++r) {
                f32x4 g0[2], v0[2];
                att::expand8(*(const u32x4*)(U + (size_t)(row0 + r) * NUP + j0), g0[0], g0[1]); att::expand8(*(const u32x4*)(U + (size_t)(row0 + r) * NUP + DFF + j0), v0[0], v0[1]);
                f32x4 hh[2];
#pragma unroll
                for (int q = 0; q < 2; ++q)
#pragma unroll
                    for (int e = 0; e < 4; ++e) {
                        const int i = 4 * q + e;
                        const float cgt = bg[i] + wg[0][i] * g2[q][e] + wg[1][i] * g1[q][e] + wg[2][i] * g0[q][e];
                        const float cvl = bv[i] + wv[0][i] * v2[q][e] + wv[1][i] * v1[q][e] + wv[2][i] * v0[q][e];
                        hh[q][e] = cgt * sigmoidf_(cgt) * cvl;
                    }
                *(u32x4*)(H + (size_t)(row0 + r) * DFF + j0) = pack8(hh[0], hh[1]);
                g2[0] = g1[0]; g2[1] = g1[1]; v2[0] = v1[0]; v2[1] = v1[1]; g1[0] = g0[0]; g1[1] = g0[1]; v1[0] = v0[0]; v1[1] = v0[1];
            }
        }
    }
    xcd_barrier(xbar);
    {
        pg8::Gemm g{H, WdnT, M_TOK, 1024, DFF}; pg8::StaticOrder S; S.init(M_P, 1024, G, (int)blockIdx.x);
        EpiDown E{PRM(out) + O_Y, (float*)(ws + WS_A)};
        pg8::gemm_phase<EpiDown, pg8::StaticOrder, true, true>(lds, g, S, E);
        DownOrder S2; S2.init(G, (int)blockIdx.x);
        pg8::gemm_phase<EpiDown, DownOrder, true, true, 4>(lds, g, S2, E);
    }
    xcd_barrier(xbar);
    for (int row0 = gw; row0 < M_P; row0 += 4 * NGW) {
        f32x4 v[4][4];
#pragma unroll
        for (int q = 0; q < 4; ++q) { const int row = row0 + q * NGW;
            if (row < M_P) { const float* yr = PRM(out) + O_Y + (size_t)row * 1024;
#pragma unroll
                for (int j = 0; j < 4; ++j) v[q][j] = *(const f32x4*)(yr + 4 * lane + 256 * j); } }
#pragma unroll
        for (int q = 0; q < 4; ++q) { const int row = row0 + q * NGW;
            if (row < M_P) { float* yr = PRM(out) + O_Y + (size_t)row * 1024; float s = 0.f;
#pragma unroll
                for (int j = 0; j < 4; ++j) s += (v[q][j][0] * v[q][j][0] + v[q][j][1] * v[q][j][1]) + (v[q][j][2] * v[q][j][2] + v[q][j][3] * v[q][j][3]);
                const float rs = rsqrtf(wave_sum(s) * (1.f / 1024.f) + NEPS);
#pragma unroll
                for (int j = 0; j < 4; ++j) { const int c = 4 * lane + 256 * j; const f32x4 g = *(const f32x4*)(PRM(final_g) + c); *(f32x4*)(yr + c) = v[q][j] * rs * g; } } }
    }
    for (int row = M_P + gw; row < M_TOK; row += NGW) {
        float* yr = PRM(out) + O_Y + (size_t)row * 1024;
        f32x4 v[4]; float s = 0.f;
#pragma unroll
        for (int j = 0; j < 4; ++j) {
            v[j] = *(const f32x4*)(yr + 4 * lane + 256 * j);
#pragma unroll
            for (int ks = 0; ks < 11; ++ks) v[j] += *(const f32x4*)((const float*)(ws + WS_A) + ((size_t)ks * 512 + (row - M_P)) * 1024 + 4 * lane + 256 * j);
            s += (v[j][0] * v[j][0] + v[j][1] * v[j][1]) + (v[j][2] * v[j][2] + v[j][3] * v[j][3]);
        }
        const float rs = rsqrtf(wave_sum(s) * (1.f / 1024.f) + NEPS);
#pragma unroll
        for (int j = 0; j < 4; ++j) { const int c = 4 * lane + 256 * j; const f32x4 g = *(const f32x4*)(PRM(final_g) + c); *(f32x4*)(yr + c) = v[j] * rs * g; }
    }
}
#undef ws

extern "C" void kernel_launch(void* const* d_in, const int* in_sizes, int n_in, void* d_out, int out_size, void* d_ws, size_t ws_size, hipStream_t stream) {
    static int grid = 0;
    if (grid == 0) {
        if (n_in != 23 || (size_t)out_size != O_END || ws_size < WS_END) { fprintf(stderr, "kernel_launch: unexpected sizes n_in %d out %d ws %zu (need %zu)\n", n_in, out_size, ws_size, (size_t)WS_END); grid = -1; return; }
        int dev = 0, cus = 0, per_cu = 0;
        hipGetDevice(&dev); hipDeviceGetAttribute(&cus, hipDeviceAttributeMultiprocessorCount, dev);
        if (hipFuncSetAttribute((const void*)fwd_megakernel, hipFuncAttributeMaxDynamicSharedMemorySize, LDS_BYTES) != hipSuccess) { fprintf(stderr, "kernel_launch: hipFuncSetAttribute failed\n"); grid = -1; return; }
        if (hipOccupancyMaxActiveBlocksPerMultiprocessor(&per_cu, (const void*)fwd_megakernel, 512, LDS_BYTES) != hipSuccess || per_cu < 1) { fprintf(stderr, "kernel_launch: occupancy query says %d\n", per_cu); per_cu = 1; }
        (void)hipGetLastError();
        grid = cus * 1;
    }
    if (grid < 0) return;
    Params p{};
    p.x_prompt = (const float*)d_in[0]; p.x_sample = (const float*)d_in[1]; p.cdk = (const float*)d_in[2]; p.cdv = (const float*)d_in[3]; p.csk = (const float*)d_in[4]; p.csv = (const float*)d_in[5];
    p.state_conv = (const float*)d_in[6]; p.attn_g = (const float*)d_in[7]; p.w_in = (const float*)d_in[8]; p.lq1 = (const float*)d_in[9]; p.lk1 = (const float*)d_in[10]; p.lq2 = (const float*)d_in[11];
    p.lk2 = (const float*)d_in[12]; p.subln_g = (const float*)d_in[13]; p.w_a = (const float*)d_in[14]; p.w_b = (const float*)d_in[15]; p.w_out = (const float*)d_in[16]; p.ffn_g = (const float*)d_in[17];
    p.w_up = (const float*)d_in[18]; p.conv_w = (const float*)d_in[19]; p.conv_b = (const float*)d_in[20]; p.w_down = (const float*)d_in[21]; p.final_g = (const float*)d_in[22];
    p.out = (float*)d_out; p.ws = (unsigned char*)d_ws;
    void* args[] = {&p};
    hipError_t e = hipLaunchCooperativeKernel((const void*)fwd_megakernel, dim3(grid), dim3(512), args, LDS_BYTES, stream);
    if (e != hipSuccess) fprintf(stderr, "cooperative launch failed: %s (grid %d)\n", hipGetErrorString(e), grid);
}
```

```cpp
#include <hip/hip_runtime.h>
#include <hip/hip_cooperative_groups.h>
#include <cstdio>
#include <cstdint>
namespace cg = cooperative_groups;
__device__ __forceinline__ int tid_fresh() { int t = (int)threadIdx.x; asm volatile("" : "+v"(t)); return t; }
namespace pg8 {
#define PG8_LAS __attribute__((address_space(3)))
typedef unsigned short bf16_t;
typedef short bf16x8 __attribute__((ext_vector_type(8)));
typedef float f32x4 __attribute__((ext_vector_type(4)));
typedef unsigned u32x4 __attribute__((ext_vector_type(4)));
constexpr int BM = 256, BK = 64, HALF = 128, HTB = HALF * BK * 2  , STAGE_BYTES = 8 * HTB, NXCD = 8, WGM = 8;

__host__ __device__ __forceinline__ int lds_byte(int r, int c) { const int st = (r >> 4) * 2 + (c >> 5), rr = r & 15, cc = c & 31, ob = rr * 64 + cc * 2; return st * 1024 + (ob ^ (((ob >> 9) & 1) << 5)); }
__host__ __device__ __forceinline__ void stage_rc(int b, int& R, int& C) { const int st = b / 1024, sb = b % 1024, swz = sb ^ (((sb >> 9) & 1) << 5); R = (st >> 1) * 16 + swz / 64; C = (st & 1) * 32 + (swz % 64) / 2; }
__host__ __device__ __forceinline__ int perm32(int rho) { const int n = rho >> 4, i = rho & 15; return 8 * (i >> 2) + 4 * n + (i & 3); }

struct Unit { int pm, pn, kb, nt; };
struct Gemm { const bf16_t* A; const bf16_t* Bt; int M, N, K; };

struct StaticOrder {
    int nM, nN, nwg, G, c;
    __host__ __device__ void init(int M, int N, int G_, int c_) { nM = M / BM; nN = N / BM; nwg = nM * nN; G = G_; c = c_; }
    __host__ __device__ bool next(int i, Unit& u) const {
        const long L = (long)i * G + c; if (L >= nwg) return false;
        int wgid = (int)L; { const int q = nwg / NXCD, r = nwg % NXCD, xcd = wgid % NXCD, off = wgid / NXCD; wgid = (xcd < r ? xcd * (q + 1) : r * (q + 1) + (xcd - r) * q) + off; }
        const int nig = WGM * nN, gid = wgid / nig, fm = gid * WGM, gsz = (nM - fm) < WGM ? (nM - fm) : WGM;
        u.pm = fm + ((wgid % nig) % gsz); u.pn = (wgid % nig) / gsz; u.kb = 0; u.nt = 0; return true;
    }
    __device__ __forceinline__ void a_ready(const Unit&) const {}
    __device__ __forceinline__ void done(const Unit&) const {}
};

__device__ __forceinline__ unsigned cvt_pk_bf16(float lo, float hi) { unsigned r; asm volatile("v_cvt_pk_bf16_f32 %0, %1, %2" : "=v"(r) : "v"(lo), "v"(hi)); return r; }
typedef float f32x2 __attribute__((ext_vector_type(2)));
template <class Epi, class Sched, bool ALIGN_EPI = false, bool SP2 = false, int NTC = 0>
__device__ __forceinline__ void gemm_phase(PG8_LAS unsigned char* lds, const Gemm g, const Sched& S, const Epi& E) {
    const int tid = tid_fresh(), wid = __builtin_amdgcn_readfirstlane(tid >> 6), lane = tid & 63, wr = wid >> 2, wc = wid & 3, fr = lane & 15, fq = lane >> 4;
    const int K = g.K; int nt = NTC ? NTC : K / BK;
    if (NTC) asm volatile("" : "+s"(nt));
    unsigned voffA[2], voffB[2];
#pragma unroll
    for (int i = 0; i < 2; ++i) { int R, C; stage_rc(tid * 16 + i * 8192, R, C); const int Rb = Epi::PERM ? ((R & ~31) + perm32(R & 31)) : R;
        voffA[i] = (unsigned)(R * K + C) * 2u; voffB[i] = (unsigned)(Rb * K + C) * 2u; }
    const size_t kstep = (size_t)(BK * 2);
    const size_t hstep = (size_t)HALF * K * 2;
    const size_t tstep = 2 * hstep;
    const unsigned ldsw = (unsigned)wid * 1024u;
    const int aoff = lds_byte(wr * 64 + fr, fq * 8), boff = lds_byte(wc * 32 + fr, fq * 8);
#define PG8_SA(b, h) (((b) * 2 + (h)) * HTB)
#define PG8_SB(b, h) ((4 + (b) * 2 + (h)) * HTB)
#define PG8_STAGE(bufoff, gbase, voff) do { _Pragma("unroll") for (int _i = 0; _i < 2; ++_i) \
        __builtin_amdgcn_global_load_lds((const unsigned*)((const char*)(gbase) + (voff)[_i]), (PG8_LAS unsigned*)(lds + (bufoff) + ldsw + _i * 8192), 16, 0, 0); } while (0)
#define PG8_LDA(dst, b, h) do { _Pragma("unroll") for (int m = 0; m < 4; ++m) _Pragma("unroll") for (int k = 0; k < 2; ++k) dst[m][k] = *(const PG8_LAS bf16x8*)(lds + PG8_SA(b, h) + aoff + m * 2048 + k * 1024); } while (0)
#define PG8_LDB(dst, b, h) do { _Pragma("unroll") for (int n = 0; n < 2; ++n) _Pragma("unroll") for (int k = 0; k < 2; ++k) dst[n][k] = *(const PG8_LAS bf16x8*)(lds + PG8_SB(b, h) + boff + n * 2048 + k * 1024); } while (0)
#define PG8_MMA(ai, bj, At, Bt) do { __builtin_amdgcn_s_setprio(1); _Pragma("unroll") for (int m = 0; m < 4; ++m) _Pragma("unroll") for (int n = 0; n < 2; ++n) _Pragma("unroll") for (int k = 0; k < 2; ++k) \
        acc[ai][bj][m][n] = __builtin_amdgcn_mfma_f32_16x16x32_bf16(Bt[n][k], At[m][k], acc[ai][bj][m][n], 0, 0, 0); __builtin_amdgcn_s_setprio(0); } while (0)
#define PG8_WAIT_V(n) asm volatile("s_waitcnt vmcnt(" #n ")" ::: "memory")
#define PG8_WAIT_L(n) asm volatile("s_waitcnt lgkmcnt(" #n ")" ::: "memory")
#define PG8_BAR __builtin_amdgcn_s_barrier()
#define PG8_SCHED __builtin_amdgcn_sched_barrier(0)
    Unit cur, nxt; int ui = 0;
    if (!S.next(0, cur)) return;
    f32x4 acc[2][2][4][2];
#pragma unroll
    for (int a = 0; a < 2; ++a)
#pragma unroll
        for (int b = 0; b < 2; ++b)
#pragma unroll
            for (int m = 0; m < 4; ++m)
#pragma unroll
                for (int n = 0; n < 2; ++n) acc[a][b][m][n] = (f32x4){0.f, 0.f, 0.f, 0.f};
    bf16x8 At[4][2], B0[2][2], B1[2][2];
    const char* cA = (const char*)g.A + (size_t)cur.pm * tstep + (size_t)cur.kb * kstep; const char* cB = (const char*)g.Bt + (size_t)cur.pn * tstep + (size_t)cur.kb * kstep;
    S.a_ready(cur);
    if constexpr (SP2) {
        PG8_STAGE(PG8_SB(0, 0), cB, voffB); PG8_STAGE(PG8_SB(0, 1), cB + hstep, voffB); PG8_STAGE(PG8_SA(0, 0), cA, voffA); PG8_STAGE(PG8_SA(0, 1), cA + hstep, voffA);
        if (wr == 1) PG8_BAR;
        PG8_WAIT_V(2); PG8_BAR;
        PG8_STAGE(PG8_SB(1, 0), cB + kstep, voffB); PG8_STAGE(PG8_SA(1, 0), cA + kstep, voffA); PG8_STAGE(PG8_SB(1, 1), cB + hstep + kstep, voffB);
        PG8_WAIT_V(6); PG8_BAR;
    } else {
        PG8_STAGE(PG8_SB(0, 0), cB, voffB); PG8_STAGE(PG8_SA(0, 0), cA, voffA); PG8_STAGE(PG8_SB(0, 1), cB + hstep, voffB); PG8_STAGE(PG8_SA(0, 1), cA + hstep, voffA);
        if (wr == 1) PG8_BAR;
        PG8_WAIT_V(4); PG8_BAR;
        PG8_STAGE(PG8_SB(1, 0), cB + kstep, voffB); PG8_STAGE(PG8_SA(1, 0), cA + kstep, voffA); PG8_STAGE(PG8_SB(1, 1), cB + hstep + kstep, voffB);
        PG8_WAIT_V(6); PG8_BAR;
    }
    for (;;) {
        const bool has_next = S.next(ui + 1, nxt);
        const char* nA = has_next ? (const char*)g.A + (size_t)nxt.pm * tstep + (size_t)nxt.kb * kstep : cA; const char* nB = has_next ? (const char*)g.Bt + (size_t)nxt.pn * tstep + (size_t)nxt.kb * kstep : cB;
        for (int t = 0; t < nt; t += 2) {
            const bool last = (t == nt - 2);
            const char* a1 = cA + (size_t)(t + 1) * kstep;
            const char* a2 = last ? nA : cA + (size_t)(t + 2) * kstep; const char* b2 = last ? nB : cB + (size_t)(t + 2) * kstep;
            const char* a3 = a2 + kstep; const char* b3 = b2 + kstep;
            if (last && has_next) S.a_ready(nxt);
            if constexpr (SP2) {
            PG8_LDB(B0, 0, 0); PG8_LDB(B1, 0, 1); PG8_SCHED; PG8_LDA(At, 0, 0); PG8_STAGE(PG8_SA(1, 1), a1 + hstep, voffA);
            PG8_WAIT_V(8); PG8_WAIT_L(0); PG8_BAR; PG8_MMA(0, 0, At, B0); PG8_MMA(0, 1, At, B1); PG8_BAR; PG8_SCHED;
            PG8_LDA(At, 0, 1); PG8_STAGE(PG8_SB(0, 0), b2, voffB); PG8_STAGE(PG8_SB(0, 1), b2 + hstep, voffB); PG8_STAGE(PG8_SA(0, 0), a2, voffA);
            PG8_WAIT_V(8); PG8_WAIT_L(0); PG8_BAR; PG8_MMA(1, 0, At, B0); PG8_MMA(1, 1, At, B1); PG8_BAR; PG8_SCHED;
            PG8_LDB(B0, 1, 0); PG8_LDB(B1, 1, 1); PG8_SCHED; PG8_LDA(At, 1, 0); PG8_STAGE(PG8_SA(0, 1), a2 + hstep, voffA);
            PG8_WAIT_V(8); PG8_WAIT_L(0); PG8_BAR; PG8_MMA(0, 0, At, B0); PG8_MMA(0, 1, At, B1); PG8_BAR; PG8_SCHED;
            PG8_LDA(At, 1, 1); PG8_STAGE(PG8_SB(1, 0), b3, voffB); PG8_STAGE(PG8_SB(1, 1), b3 + hstep, voffB); PG8_STAGE(PG8_SA(1, 0), a3, voffA);
            PG8_WAIT_V(8); PG8_WAIT_L(0); PG8_BAR; PG8_MMA(1, 0, At, B0); PG8_MMA(1, 1, At, B1); PG8_BAR; PG8_SCHED;
            } else {
            PG8_LDB(B0, 0, 0); PG8_SCHED; PG8_LDA(At, 0, 0); PG8_STAGE(PG8_SA(1, 1), a1 + hstep, voffA);
            PG8_WAIT_L(8); PG8_BAR; PG8_WAIT_L(0); PG8_MMA(0, 0, At, B0); PG8_BAR; PG8_SCHED;
            PG8_LDB(B1, 0, 1); PG8_STAGE(PG8_SB(0, 0), b2, voffB);
            PG8_BAR; PG8_WAIT_L(0); PG8_MMA(0, 1, At, B1); PG8_BAR;
            PG8_LDA(At, 0, 1); PG8_STAGE(PG8_SA(0, 0), a2, voffA);
            PG8_BAR; PG8_WAIT_L(0); PG8_MMA(1, 0, At, B0); PG8_BAR; PG8_SCHED;
            PG8_STAGE(PG8_SB(0, 1), b2 + hstep, voffB);
            PG8_WAIT_V(6); PG8_BAR; PG8_MMA(1, 1, At, B1); PG8_BAR;
            PG8_LDB(B0, 1, 0); PG8_SCHED; PG8_LDA(At, 1, 0); PG8_STAGE(PG8_SA(0, 1), a2 + hstep, voffA);
            PG8_WAIT_L(8); PG8_BAR; PG8_WAIT_L(0); PG8_MMA(0, 0, At, B0); PG8_BAR; PG8_SCHED;
            PG8_LDB(B1, 1, 1); PG8_STAGE(PG8_SB(1, 0), b3, voffB);
            PG8_BAR; PG8_WAIT_L(0); PG8_MMA(0, 1, At, B1); PG8_BAR;
            PG8_LDA(At, 1, 1); PG8_STAGE(PG8_SA(1, 0), a3, voffA);
            PG8_BAR; PG8_WAIT_L(0); PG8_MMA(1, 0, At, B0); PG8_BAR; PG8_SCHED;
            PG8_STAGE(PG8_SB(1, 1), b3 + hstep, voffB);
            PG8_WAIT_V(6); PG8_BAR; PG8_MMA(1, 1, At, B1); PG8_BAR;
            }
        }
        if constexpr (ALIGN_EPI) { if (wr == 0) PG8_BAR; }
        if constexpr (!Epi::AFTER_DRAIN) { E(acc, cur, wr, wc, fr, fq); S.done(cur); }
        if (!has_next) break;
#pragma unroll
        for (int a = 0; a < 2; ++a)
#pragma unroll
            for (int b = 0; b < 2; ++b)
#pragma unroll
                for (int m = 0; m < 4; ++m)
#pragma unroll
                    for (int n = 0; n < 2; ++n) acc[a][b][m][n] = (f32x4){0.f, 0.f, 0.f, 0.f};
        cur = nxt; cA = nA; cB = nB; ++ui;
        if constexpr (ALIGN_EPI) { if (wr == 1) PG8_BAR; }
    }
    PG8_WAIT_V(0);
    if constexpr (!ALIGN_EPI) { if (wr == 0) PG8_BAR; }
    PG8_BAR;
    if constexpr (Epi::AFTER_DRAIN) { E.fused(acc, cur, wr, wc, fr, fq, lds, wid, lane); S.done(cur); }
#undef PG8_SA
#undef PG8_SB
#undef PG8_STAGE
#undef PG8_LDA
#undef PG8_LDB
#undef PG8_MMA
#undef PG8_WAIT_V
#undef PG8_WAIT_L
#undef PG8_BAR
#undef PG8_SCHED
}
}

#define LAS __attribute__((address_space(3)))
typedef LAS unsigned char* lptr;
typedef unsigned short bf16_t;
typedef float f32x4 __attribute__((ext_vector_type(4)));
typedef float f32x2 __attribute__((ext_vector_type(2)));
typedef float f32x16 __attribute__((ext_vector_type(16)));
typedef unsigned u32x4 __attribute__((ext_vector_type(4)));
typedef unsigned u32x2 __attribute__((ext_vector_type(2)));
typedef short bf16x8 __attribute__((ext_vector_type(8)));
typedef short s16x4 __attribute__((ext_vector_type(4)));
typedef short v4i16_t __attribute__((ext_vector_type(4)));

constexpr int M_TOK = 33280, M_P = 32768, DM = 1024, NIN = 5120, DFF = 2816, NUP = 5632;
constexpr float L2E = 1.4426950408889634f, LN2 = 0.6931471805599453f, NEPS = 1e-6f;
constexpr size_t O_Y = 0, O_PDK = 34078720, O_PDV = O_PDK + 16777216, O_PSK = O_PDV + 16777216, O_PSV = O_PSK + 16777216,
                 O_PCONV = O_PSV + 16777216, O_SDK = O_PCONV + 180224, O_SDV = O_SDK + 262144, O_SSK = O_SDV + 262144, O_SSV = O_SSK + 262144,
                 O_SCONV = O_SSV + 262144, O_END = O_SCONV + 360448;
constexpr size_t WS_CTL = 0, WS_RSTD = 16384, WS_SSQ1 = WS_RSTD + 133120, WS_SSQ2 = WS_SSQ1 + 2129920, WS_WIN = WS_SSQ2 + 2129920,
                 WS_WA = WS_WIN + 10485760, WS_WB = WS_WA + 1048576, WS_WOUT = WS_WB + 1048576, WS_WUP = WS_WOUT + 2097152,
                 WS_WDN = WS_WUP + 11534336, WS_A = WS_WDN + 5767168, WS_B = WS_A + 408944640, WS_X1B = WS_B + 187432960, WS_END = WS_X1B + 68157440;
constexpr size_t ZSEC = (size_t)M_TOK * 512;

struct Params {
    const float* x_prompt; const float* x_sample; const float* cdk; const float* cdv; const float* csk; const float* csv; const float* state_conv;
    const float* attn_g; const float* w_in; const float* lq1; const float* lk1; const float* lq2; const float* lk2; const float* subln_g;
    const float* w_a; const float* w_b; const float* w_out; const float* ffn_g; const float* w_up; const float* conv_w; const float* conv_b;
    const float* w_down; const float* final_g; float* out; unsigned char* ws;
};

constexpr int PRM_OFF = 131072 + 1024;
template <class T> __device__ __forceinline__ T prm_ld(lptr lds, int off) {
    const LAS unsigned* q = (const LAS unsigned*)(lds + PRM_OFF + off); unsigned lo = q[0], hi = q[1];
    lo = __builtin_amdgcn_readfirstlane(lo); hi = __builtin_amdgcn_readfirstlane(hi);
    return (T)(__attribute__((address_space(1))) void*)(((unsigned long long)hi << 32) | lo);
}
template <class T> __device__ __forceinline__ void prm_st(lptr lds, int off, T v) { *(LAS unsigned long long*)(lds + PRM_OFF + off) = (unsigned long long)v; }
#define PRM(f) prm_ld<decltype(Params::f)>(lds, (int)offsetof(Params, f))
__device__ __forceinline__ float bflo(unsigned w) { return __uint_as_float(w << 16); }
__device__ __forceinline__ float bfhi(unsigned w) { return __uint_as_float(w & 0xffff0000u); }
__device__ __forceinline__ unsigned cvtpk(float lo, float hi) { unsigned r; asm volatile("v_cvt_pk_bf16_f32 %0, %1, %2" : "=v"(r) : "v"(lo), "v"(hi)); return r; }
__device__ __forceinline__ u32x4 pack8(f32x4 a, f32x4 b) { u32x4 w; w.x = cvtpk(a[0], a[1]); w.y = cvtpk(a[2], a[3]); w.z = cvtpk(b[0], b[1]); w.w = cvtpk(b[2], b[3]); return w; }
__device__ __forceinline__ float wave_sum(float v) {
#pragma unroll
    for (int o = 1; o < 64; o <<= 1) v += __shfl_xor(v, o);
    return v;
}
__device__ __forceinline__ float fexp2(float x) { return __builtin_amdgcn_exp2f(x); }
__device__ __forceinline__ float flog2(float x) { return __builtin_amdgcn_logf(x); }
__device__ __forceinline__ float frcp(float x) { return __builtin_amdgcn_rcpf(x); }
__device__ __forceinline__ float sigmoidf_(float x) { return frcp(1.f + fexp2(-x * L2E)); }

struct EpiIn {
    static constexpr bool PERM = true, AFTER_DRAIN = false;
    const float* rstd; bf16_t* z; float* out;
    __device__ __forceinline__ void operator()(const pg8::f32x4 (&acc)[2][2][4][2], const pg8::Unit& u, int wr, int wc, int fr, int fq) const {
        const int pn = u.pn; const bool samp = u.pm >= 128;
        bf16_t* zb; int ld, tcol; float* fo = nullptr; float sc = 1.f; int mode = 0;
        if (pn < 12) {
            const int sec = pn >> 1; zb = z + (size_t)sec * ZSEC; ld = 512; tcol = (pn & 1) * 256;
            if (sec < 2) mode = 1;
            if (sec == 0) sc = 0.125f * L2E; else if (sec == 3) sc = 0.125f;
            if (sec == 1) fo = out + (samp ? O_SDK : O_PDK); else if (sec == 2) fo = out + (samp ? O_SDV : O_PDV);
            else if (sec == 4) fo = out + (samp ? O_SSK : O_PSK); else if (sec == 5) fo = out + (samp ? O_SSV : O_PSV);
        } else { const int gs = (pn - 12) >> 2; zb = z + (size_t)(6 + 2 * gs) * ZSEC; ld = 1024; tcol = ((pn - 12) & 3) * 256; mode = 2; }
        const int cb = tcol + wc * 64 + fq * 8;
        float ir[2][4];
#pragma unroll
        for (int n = 0; n < 2; ++n)
#pragma unroll
            for (int e = 0; e < 4; ++e) ir[n][e] = exp2f(-(float)(8 * fq + 4 * n + e) * (13.287712379549449f / 32.f)) * 0.15915494309189535f;
#pragma unroll
        for (int ai = 0; ai < 2; ++ai)
#pragma unroll
            for (int m = 0; m < 4; ++m) {
                const int row = u.pm * 256 + ai * 128 + wr * 64 + m * 16 + fr;
                const float rs = rstd[row] * sc;
                f32x4 v[2][2];
#pragma unroll
                for (int bj = 0; bj < 2; ++bj)
#pragma unroll
                    for (int n = 0; n < 2; ++n) v[bj][n] = acc[ai][bj][m][n] * rs;
                if (mode == 1) {
                    const float pos = samp ? (float)(2048 + (row & 15)) : (float)(row & 2047);
#pragma unroll
                    for (int n = 0; n < 2; ++n)
#pragma unroll
                        for (int e = 0; e < 4; ++e) {
                            float rev = pos * ir[n][e]; rev -= rintf(rev);
                            const float sn = __builtin_amdgcn_sinf(rev), cs = __builtin_amdgcn_cosf(rev);
                            const float x1 = v[0][n][e], x2 = v[1][n][e];
                            v[0][n][e] = x1 * cs - x2 * sn; v[1][n][e] = x2 * cs + x1 * sn;
                        }
                } else if (mode == 2) {
#pragma unroll
                    for (int bj = 0; bj < 2; ++bj)
#pragma unroll
                        for (int n = 0; n < 2; ++n)
#pragma unroll
                            for (int e = 0; e < 4; ++e) v[bj][n][e] = sigmoidf_(v[bj][n][e]);
                }
                const size_t rl = samp ? (size_t)(row - M_P) : (size_t)row;
#pragma unroll
                for (int bj = 0; bj < 2; ++bj) {
                    *(u32x4*)(zb + (size_t)row * ld + cb + 32 * bj) = pack8(v[bj][0], v[bj][1]);
                    if (fo) { float* d = fo + rl * 512 + cb + 32 * bj; *(f32x4*)d = v[bj][0]; *(f32x4*)(d + 4) = v[bj][1]; }
                }
            }
    }
};
template <bool FIRST> struct EpiMerge {
    static constexpr bool PERM = true, AFTER_DRAIN = false;
    const bf16_t* gate; bf16_t* mg;
    __device__ __forceinline__ void operator()(const pg8::f32x4 (&acc)[2][2][4][2], const pg8::Unit& u, int wr, int wc, int fr, int fq) const {
#pragma unroll
        for (int ai = 0; ai < 2; ++ai)
#pragma unroll
            for (int m = 0; m < 4; ++m) {
                const int row = u.pm * 256 + ai * 128 + wr * 64 + m * 16 + fr;
#pragma unroll
                for (int bj = 0; bj < 2; ++bj) {
                    const size_t off = (size_t)row * 1024 + u.pn * 256 + bj * 128 + wc * 32 + fq * 8;
                    const u32x4 g = *(const u32x4*)(gate + off);
                    f32x4 a = acc[ai][bj][m][0], b = acc[ai][bj][m][1];
                    a[0] *= bflo(g.x); a[1] *= bfhi(g.x); a[2] *= bflo(g.y); a[3] *= bfhi(g.y);
                    b[0] *= bflo(g.z); b[1] *= bfhi(g.z); b[2] *= bflo(g.w); b[3] *= bfhi(g.w);
                    if (!FIRST) { const u32x4 o = *(const u32x4*)(mg + off);
                        a[0] += bflo(o.x); a[1] += bfhi(o.x); a[2] += bflo(o.y); a[3] += bfhi(o.y);
                        b[0] += bflo(o.z); b[1] += bfhi(o.z); b[2] += bflo(o.w); b[3] += bfhi(o.w); }
                    *(u32x4*)(mg + off) = pack8(a, b);
                }
            }
    }
};
template <bool WRITE_BF> struct EpiRes {
    static constexpr bool PERM = true, AFTER_DRAIN = false;
    const float* base_p; const float* base_s; float* y; bf16_t* yb; float* ssq;
    __device__ __forceinline__ void operator()(const pg8::f32x4 (&acc)[2][2][4][2], const pg8::Unit& u, int wr, int wc, int fr, int fq) const {
        const bool samp = u.pm >= 128;
#pragma unroll
        for (int ai = 0; ai < 2; ++ai)
#pragma unroll
            for (int m = 0; m < 4; ++m) {
                const int row = u.pm * 256 + ai * 128 + wr * 64 + m * 16 + fr;
                const float* brow = samp ? base_s + (size_t)(row - M_P) * 1024 : base_p + (size_t)row * 1024;
                float s = 0.f;
#pragma unroll
                for (int bj = 0; bj < 2; ++bj) {
                    const int col = u.pn * 256 + bj * 128 + wc * 32 + fq * 8;
                    f32x4 a = acc[ai][bj][m][0] + *(const f32x4*)(brow + col), b = acc[ai][bj][m][1] + *(const f32x4*)(brow + col + 4);
                    s += (a[0] * a[0] + a[1] * a[1]) + (a[2] * a[2] + a[3] * a[3]) + (b[0] * b[0] + b[1] * b[1]) + (b[2] * b[2] + b[3] * b[3]);
                    float* d = y + (size_t)row * 1024 + col; *(f32x4*)d = a; *(f32x4*)(d + 4) = b;
                    if (WRITE_BF) *(u32x4*)(yb + (size_t)row * 1024 + col) = pack8(a, b);
                }
                s += __shfl_xor(s, 16); s += __shfl_xor(s, 32);
                if (fq == 0) ssq[(size_t)row * 16 + u.pn * 4 + wc] = s;
            }
    }
};
struct EpiUp {
    static constexpr bool PERM = true, AFTER_DRAIN = false;
    const float* ssq; bf16_t* U; float* out;
    __device__ __forceinline__ void operator()(const pg8::f32x4 (&acc)[2][2][4][2], const pg8::Unit& u, int wr, int wc, int fr, int fq) const {
        const bool samp = u.pm >= 128;
#pragma unroll
        for (int ai = 0; ai < 2; ++ai)
#pragma unroll
            for (int m = 0; m < 4; ++m) {
                const int row = u.pm * 256 + ai * 128 + wr * 64 + m * 16 + fr;
                const f32x4* sp = (const f32x4*)(ssq + (size_t)row * 16);
                const f32x4 s0 = sp[0], s1 = sp[1], s2 = sp[2], s3 = sp[3];
                const float tot = ((s0[0] + s0[1]) + (s0[2] + s0[3])) + ((s1[0] + s1[1]) + (s1[2] + s1[3])) + ((s2[0] + s2[1]) + (s2[2] + s2[3])) + ((s3[0] + s3[1]) + (s3[2] + s3[3]));
                const float rs = rsqrtf(tot * (1.f / 1024.f) + NEPS);
                float* cs = nullptr;
                if (!samp) { const int t = row & 2047; if (t >= 2046) cs = out + O_PCONV + (size_t)((row >> 11) * 2 + (t - 2046)) * NUP; }
                else { const int t = row & 15; if (t >= 14) cs = out + O_SCONV + (size_t)(((row - M_P) >> 4) * 2 + (t - 14)) * NUP; }
#pragma unroll
                for (int bj = 0; bj < 2; ++bj) {
                    const int col = u.pn * 256 + bj * 128 + wc * 32 + fq * 8;
                    const f32x4 a = acc[ai][bj][m][0] * rs, b = acc[ai][bj][m][1] * rs;
                    *(u32x4*)(U + (size_t)row * NUP + col) = pack8(a, b);
                    if (cs) { *(f32x4*)(cs + col) = a; *(f32x4*)(cs + col + 4) = b; }
                }
            }
    }
};


__device__ __forceinline__ float dpp_ror1(float v) { return __int_as_float(__builtin_amdgcn_update_dpp(0, __float_as_int(v), 0x121, 0xf, 0xf, false)); }
__device__ __forceinline__ float dpp_ror2(float v) { return __int_as_float(__builtin_amdgcn_update_dpp(0, __float_as_int(v), 0x122, 0xf, 0xf, false)); }
struct EpiUpConv {
    static constexpr bool PERM = true, AFTER_DRAIN = false;
    const float* ssq; bf16_t* U; bf16_t* H; float* out; const float* cw; const float* cb; lptr wl;
    __device__ __forceinline__ void operator()(const pg8::f32x4 (&acc)[2][2][4][2], const pg8::Unit& u, int wr, int wc, int fr, int fq) const {
        const bool samp = u.pm >= 128;
        const int j0 = u.pn * 128 + wc * 32 + fq * 8;
        {
            const int t_ = (wr * 4 + wc) * 64 + fq * 16 + fr;
#pragma unroll
            for (int i = 0; i < 2; ++i) { const int idx = t_ + 512 * i, k = idx >> 8, p = idx & 255, col = (p >> 7) * DFF + u.pn * 128 + (p & 127);
                ((LAS float*)wl)[idx] = k < 3 ? cw[k * NUP + col] : cb[col]; }
            asm volatile("s_waitcnt lgkmcnt(0)\n\ts_barrier" ::: "memory");
        }
        const LAS float* wq = (const LAS float*)wl + wc * 32 + fq * 8;
        float rs[2][4];
#pragma unroll
        for (int ai = 0; ai < 2; ++ai)
#pragma unroll
            for (int m = 0; m < 4; ++m) {
                const int row = u.pm * 256 + ai * 128 + wr * 64 + m * 16 + fr;
                const f32x4 s0 = *((const f32x4*)(ssq + (size_t)row * 16) + fq);
                float tot = (s0[0] + s0[1]) + (s0[2] + s0[3]);
                tot += __shfl_xor(tot, 16); tot += __shfl_xor(tot, 32);
                rs[ai][m] = rsqrtf(tot * (1.f / 1024.f) + NEPS);
            }
        __builtin_amdgcn_sched_barrier(0);
#pragma unroll
        for (int n = 0; n < 2; ++n) {
            const int jc = j0 + 4 * n;
#pragma unroll
            for (int ai = 0; ai < 2; ++ai) {
                f32x4 k1g = (f32x4){0.f, 0.f, 0.f, 0.f}, k2g = k1g, k1v = k1g, k2v = k1g;
#pragma unroll
                for (int m = 0; m < 4; ++m) {
                    const int row = u.pm * 256 + ai * 128 + wr * 64 + m * 16 + fr;
                    const f32x4 ug = acc[ai][0][m][n] * rs[ai][m], uv = acc[ai][1][m][n] * rs[ai][m];
                    float* cs = nullptr;
                    if (!samp) { const int t = row & 2047; if (t >= 2046) cs = out + O_PCONV + (size_t)((row >> 11) * 2 + (t - 2046)) * NUP; }
                    else { const int t = row & 15; if (t >= 14) cs = out + O_SCONV + (size_t)(((row - M_P) >> 4) * 2 + (t - 14)) * NUP; }
                    if (cs) { *(f32x4*)(cs + jc) = ug; *(f32x4*)(cs + DFF + jc) = uv; }
                    const int lr = samp ? (row & 15) : (row & 63);
                    const bool keep = samp ? (lr < 2) : (lr < 2 || lr >= 62);
                    if (keep) { u32x2 wg, wv; wg.x = cvtpk(ug[0], ug[1]); wg.y = cvtpk(ug[2], ug[3]); wv.x = cvtpk(uv[0], uv[1]); wv.y = cvtpk(uv[2], uv[3]);
                        *(u32x2*)(U + (size_t)row * NUP + jc) = wg; *(u32x2*)(U + (size_t)row * NUP + DFF + jc) = wv; }
                    f32x4 c1g, c2g, c1v, c2v;
#pragma unroll
                    for (int e = 0; e < 4; ++e) { c1g[e] = dpp_ror1(ug[e]); c2g[e] = dpp_ror2(ug[e]); c1v[e] = dpp_ror1(uv[e]); c2v[e] = dpp_ror2(uv[e]); }
                    f32x4 p1g, p2g, p1v, p2v;
#pragma unroll
                    for (int e = 0; e < 4; ++e) { p1g[e] = fr >= 1 ? c1g[e] : k1g[e]; p2g[e] = fr >= 2 ? c2g[e] : k2g[e]; p1v[e] = fr >= 1 ? c1v[e] : k1v[e]; p2v[e] = fr >= 2 ? c2v[e] : k2v[e]; }
                    k1g = c1g; k2g = c2g; k1v = c1v; k2v = c2v;
                    f32x4 hh;
                    { const f32x4 w0g = *(const LAS f32x4*)(wq + 4 * n), w1g = *(const LAS f32x4*)(wq + 256 + 4 * n), w2g = *(const LAS f32x4*)(wq + 512 + 4 * n), bg = *(const LAS f32x4*)(wq + 768 + 4 * n);
                      const f32x4 cg = bg + w0g * p2g + w1g * p1g + w2g * ug;
#pragma unroll
                      for (int e = 0; e < 4; ++e) hh[e] = cg[e] * sigmoidf_(cg[e]); }
                    { const f32x4 w0v = *(const LAS f32x4*)(wq + 128 + 4 * n), w1v = *(const LAS f32x4*)(wq + 384 + 4 * n), w2v = *(const LAS f32x4*)(wq + 640 + 4 * n), bv = *(const LAS f32x4*)(wq + 896 + 4 * n);
                      const f32x4 cv = bv + w0v * p2v + w1v * p1v + w2v * uv;
                      hh = hh * cv; }
                    const bool deferred = samp ? (fr < 2) : (m == 0 && fr < 2);
                    if (!deferred) { u32x2 w; w.x = cvtpk(hh[0], hh[1]); w.y = cvtpk(hh[2], hh[3]); *(u32x2*)(H + (size_t)row * DFF + jc) = w; }
                }
            }
        }
    }
};

struct EpiDown {
    static constexpr bool PERM = true, AFTER_DRAIN = false;
    float* y; float* part;
    __device__ __forceinline__ void operator()(const pg8::f32x4 (&acc)[2][2][4][2], const pg8::Unit& u, int wr, int wc, int fr, int fq) const {
        const bool split = u.pm >= 128;
#pragma unroll
        for (int ai = 0; ai < 2; ++ai)
#pragma unroll
            for (int m = 0; m < 4; ++m) {
                const int row = u.pm * 256 + ai * 128 + wr * 64 + m * 16 + fr;
#pragma unroll
                for (int bj = 0; bj < 2; ++bj) {
                    float* d = y + (size_t)row * 1024 + u.pn * 256 + bj * 128 + wc * 32 + fq * 8;
                    if (!split) { const f32x4 a = acc[ai][bj][m][0] + *(const f32x4*)d, b = acc[ai][bj][m][1] + *(const f32x4*)(d + 4); *(f32x4*)d = a; *(f32x4*)(d + 4) = b; }
                    else { float* q = part + ((size_t)(u.kb >> 2) * 512 + (row - M_P)) * 1024 + u.pn * 256 + bj * 128 + wc * 32 + fq * 8; *(f32x4*)q = acc[ai][bj][m][0]; *(f32x4*)(q + 4) = acc[ai][bj][m][1]; }
                }
            }
    }
};
struct DownOrder {
    int G, c;
    __device__ void init(int G_, int c_) { G = G_; c = c_; }
    __device__ bool next(int i, pg8::Unit& u) const {
        const int s = i * G + c; if (s >= 88) return false;
        u.pm = 128 + (s & 1); u.pn = (s >> 1) & 3; u.kb = 4 * (s >> 3); u.nt = 4; return true;
    }
    __device__ __forceinline__ void a_ready(const pg8::Unit&) const {}
    __device__ __forceinline__ void done(const pg8::Unit&) const {}
};

template <int PERMROWS>
__device__ __forceinline__ void transpose_item(const float* W, int K, int N, bf16_t* WT, const float* g, LAS float* scr, int item, int lane) {
    const int nblk = N / 32, kb = item / nblk, nb = item % nblk, k0 = 64 * kb, n0 = 32 * nb;
#pragma unroll 8
    for (int i = 0; i < 32; ++i) { const int kk = 2 * i + (lane >> 5); float v = W[(size_t)(k0 + kk) * N + n0 + (lane & 31)]; if (g) v *= g[k0 + kk]; scr[kk * 33 + (lane & 31)] = v; }
    asm volatile("s_waitcnt lgkmcnt(0)" ::: "memory");
    const int c = lane & 7;
#pragma unroll
    for (int j = 0; j < 4; ++j) {
        const int n = (lane >> 3) + 8 * j; const LAS float* s = scr + (8 * c) * 33 + n;
        u32x4 o; o.x = cvtpk(s[0 * 33], s[1 * 33]); o.y = cvtpk(s[2 * 33], s[3 * 33]); o.z = cvtpk(s[4 * 33], s[5 * 33]); o.w = cvtpk(s[6 * 33], s[7 * 33]);
        int nn = n0 + n;
        if (PERMROWS == 1) { const int p = nn & 255; nn = (nn & ~255) + ((p >> 5) & 1) * 128 + (p >> 6) * 32 + (p & 31); }
        if (PERMROWS == 2) { const int bj = nn >= DFF ? 1 : 0, j = nn - DFF * bj; nn = (j >> 7) * 256 + bj * 128 + (j & 127); }
        *(u32x4*)(WT + (size_t)nn * K + k0 + 8 * c) = o;
    }
    asm volatile("s_waitcnt lgkmcnt(0)" ::: "memory");
}

namespace att {
constexpr int KCH = 1040, KMAP = 8 * KCH;
constexpr int DA_K = 0, DA_V = 2 * KMAP, DA_VS = 320;
constexpr int SB_K = 0, SB_V = KMAP, SB_VS = 192;
constexpr int BUFB = 37376, WSF = 2 * BUFB, CTL = WSF + 2048, EXCH = 0, EXS = 132;
constexpr int NU_DAS = 128, NU_SBS = 256, NU_DAP = 1024, NU_SBP = 1024, NUNITS = NU_DAS + NU_SBS + NU_DAP + NU_SBP;
constexpr float SB_THR = -88.0f;

__device__ __forceinline__ s16x4 vtr(lptr p) { return __builtin_bit_cast(s16x4, __builtin_amdgcn_ds_read_tr16_b64_v4i16((LAS v4i16_t*)p)); }
__device__ __forceinline__ int crow(int r, int hi) { return (r & 3) + 8 * (r >> 2) + 4 * hi; }
__device__ __forceinline__ void expand8(u32x4 w, f32x4& a, f32x4& b) { a[0] = bflo(w.x); a[1] = bfhi(w.x); a[2] = bflo(w.y); a[3] = bfhi(w.y); b[0] = bflo(w.z); b[1] = bfhi(w.z); b[2] = bflo(w.w); b[3] = bfhi(w.w); }

template <bool SAMPLE> struct DAStage;
template <> struct DAStage<false> {
    u32x4 k[2], v[2];
    __device__ __forceinline__ void load(const float* ck, const float* cv, const bf16_t* KA, const bf16_t* VA, int b, int h, int t, int tid) {
        const size_t tbase = (size_t)(b * 2048 + 64 * t) * 512 + h * 128;
        const bf16_t* kt = KA + tbase; const bf16_t* vt = VA + tbase;
#pragma unroll
        for (int i = 0; i < 2; ++i) { const int id = tid + 512 * i; const unsigned off = (unsigned)((id >> 4) * 512 + (id & 15) * 8);
            k[i] = *(const u32x4*)(kt + off); v[i] = *(const u32x4*)(vt + off); }
    }
    __device__ __forceinline__ void store(lptr lds, int tid) {
#pragma unroll
        for (int i = 0; i < 2; ++i) { const int id = tid + 512 * i, row = id >> 4, ch = id & 15;
            *(LAS u32x4*)(lds + DA_K + (ch >> 3) * KMAP + (ch & 7) * KCH + row * 16) = k[i]; *(LAS u32x4*)(lds + DA_V + row * DA_VS + ch * 16) = v[i]; }
    }
};
template <> struct DAStage<true> {
    f32x4 k[2][2], v[2][2];
    __device__ __forceinline__ void load(const float* ck, const float* cv, const bf16_t* KA, const bf16_t* VA, int b, int h, int t, int tid) {
#pragma unroll
        for (int i = 0; i < 2; ++i) { const int id = tid + 512 * i, row = id >> 4, ch = id & 15;
            if (t < 32) { const size_t off = ((size_t)(b * 2048 + 64 * t + row) * 4 + h) * 128 + ch * 8;
                k[i][0] = *(const f32x4*)(ck + off); k[i][1] = *(const f32x4*)(ck + off + 4); v[i][0] = *(const f32x4*)(cv + off); v[i][1] = *(const f32x4*)(cv + off + 4); }
            else if (row < 16) { const size_t off = (size_t)(M_P + b * 16 + row) * 512 + h * 128 + ch * 8; expand8(*(const u32x4*)(KA + off), k[i][0], k[i][1]); expand8(*(const u32x4*)(VA + off), v[i][0], v[i][1]); }
            else { k[i][0] = k[i][1] = v[i][0] = v[i][1] = (f32x4){0.f, 0.f, 0.f, 0.f}; } }
    }
    __device__ __forceinline__ void store(lptr lds, int tid) {
#pragma unroll
        for (int i = 0; i < 2; ++i) { const int id = tid + 512 * i, row = id >> 4, ch = id & 15;
            *(LAS u32x4*)(lds + DA_K + (ch >> 3) * KMAP + (ch & 7) * KCH + row * 16) = pack8(k[i][0], k[i][1]); *(LAS u32x4*)(lds + DA_V + row * DA_VS + ch * 16) = pack8(v[i][0], v[i][1]); }
    }
};
template <bool SAMPLE> struct SBStage;
template <> struct SBStage<false> {
    u32x4 k, v;
    __device__ __forceinline__ void load(const float* ck, const float* cv, const bf16_t* KB, const bf16_t* VB, int b, int h, int t, int tid) {
        const size_t tbase = (size_t)(b * 2048 + 64 * t) * 512 + h * 64;
        const unsigned off = (unsigned)((tid >> 3) * 512 + (tid & 7) * 8);
        k = *(const u32x4*)(KB + tbase + off); v = *(const u32x4*)(VB + tbase + off);
    }
    __device__ __forceinline__ void store(lptr lds, int tid) {
        const int row = tid >> 3, ch = tid & 7;
        *(LAS u32x4*)(lds + SB_K + ch * KCH + row * 16) = k; *(LAS u32x4*)(lds + SB_V + row * SB_VS + ch * 16) = v;
    }
};
template <> struct SBStage<true> {
    f32x4 k[2], v[2];
    __device__ __forceinline__ void load(const float* ck, const float* cv, const bf16_t* KB, const bf16_t* VB, int b, int h, int t, int tid) {
        const int row = tid >> 3, ch = tid & 7;
        if (t < 32) { const size_t off = ((size_t)(b * 2048 + 64 * t + row) * 8 + h) * 64 + ch * 8;
            k[0] = *(const f32x4*)(ck + off); k[1] = *(const f32x4*)(ck + off + 4); v[0] = *(const f32x4*)(cv + off); v[1] = *(const f32x4*)(cv + off + 4); }
        else if (row < 16) { const size_t off = (size_t)(M_P + b * 16 + row) * 512 + h * 64 + ch * 8; expand8(*(const u32x4*)(KB + off), k[0], k[1]); expand8(*(const u32x4*)(VB + off), v[0], v[1]); }
        else { k[0] = k[1] = v[0] = v[1] = (f32x4){0.f, 0.f, 0.f, 0.f}; }
    }
    __device__ __forceinline__ void store(lptr lds, int tid) {
        const int row = tid >> 3, ch = tid & 7;
        *(LAS u32x4*)(lds + SB_K + ch * KCH + row * 16) = pack8(k[0], k[1]); *(LAS u32x4*)(lds + SB_V + row * SB_VS + ch * 16) = pack8(v[0], v[1]);
    }
};

#define MFMA32(a, b, c) __builtin_amdgcn_mfma_f32_32x32x16_bf16((a), (b), (c), 0, 0, 0)

template <bool SAMPLE>
__device__ __forceinline__ void da_unit(lptr lds, const bf16_t* zA, bf16_t* OA, int b, int h, int qblk, float lam) {
    const int tid = tid_fresh(), lane = tid & 63, r32 = lane & 31, hi = lane >> 5, wid = __builtin_amdgcn_readfirstlane(tid >> 6), c = wid & 1, sub = wid >> 1;
    const bf16_t* QA = zA; const bf16_t* KA = zA + ZSEC; const bf16_t* VA = zA + 2 * ZSEC;
    const size_t qrow = SAMPLE ? (size_t)(M_P + b * 16 + (r32 & 15)) : (size_t)(b * 2048 + qblk * 128 + sub * 32 + r32);
    bf16x8 qr[4];
#pragma unroll
    for (int d0 = 0; d0 < 4; ++d0) qr[d0] = *(const bf16x8*)(QA + qrow * 512 + h * 128 + c * 64 + d0 * 16 + hi * 8);
    const int nt = SAMPLE ? 33 : 2 * qblk + 2;
    const int ntw = SAMPLE ? (sub == 0 ? 33 : 0) : 2 * qblk + 1 + (sub >> 1);
    f32x16 o[4];
#pragma unroll
    for (int i = 0; i < 4; ++i) o[i] = f32x16{};
    float m = 0.f, l = 0.f;
    f32x16 negm = f32x16{};
    LAS float* wsf = (LAS float*)(lds + WSF) + wid * 64;
    const int vlane = ((lane >> 4) & 1) * 32 + (lane & 3) * 8 + (4 * hi + ((lane & 15) >> 2)) * DA_VS;
    const float* ck = SAMPLE ? PRM(cdk) : nullptr; const float* cv = SAMPLE ? PRM(cdv) : nullptr;
    DAStage<SAMPLE> st;
    st.load(ck, cv, KA, VA, b, h, 0, tid);
    for (int t = 0; t < nt; ++t) {
        __syncthreads();
        lptr tb = lds;
        st.store(lds, tid);
        __syncthreads();
        if (t + 1 < nt) st.load(ck, cv, KA, VA, b, h, t + 1, tid);
        if (t < ntw) {
            f32x16 p0, p1;
            bf16x8 kf[8];
#pragma unroll
            for (int d0 = 0; d0 < 4; ++d0) { lptr ka = tb + DA_K + c * KMAP + (2 * d0 + hi) * KCH + r32 * 16; kf[2 * d0] = *(const LAS bf16x8*)ka; kf[2 * d0 + 1] = *(const LAS bf16x8*)(ka + 512); }
            __builtin_amdgcn_sched_barrier(0);
#pragma unroll
            for (int d0 = 0; d0 < 4; ++d0) { p0 = MFMA32(kf[2 * d0], qr[d0], d0 == 0 ? negm : p0); p1 = MFMA32(kf[2 * d0 + 1], qr[d0], d0 == 0 ? negm : p1); }
            constexpr int NPRE = SAMPLE ? 1 : 3;
            s16x4 vlo[NPRE * 4], vhi[NPRE * 4];
#pragma unroll
            for (int ks = 0; ks < NPRE; ++ks)
#pragma unroll
                for (int d0 = 0; d0 < 4; ++d0) { lptr va = tb + DA_V + vlane + ks * 16 * DA_VS + d0 * 64; vlo[ks * 4 + d0] = vtr(va); vhi[ks * 4 + d0] = vtr(va + 8 * DA_VS); }
            __builtin_amdgcn_sched_barrier(0);
            if (SAMPLE && t == 32) {
#pragma unroll
                for (int r = 8; r < 16; ++r) p0[r] = -1e30f;
#pragma unroll
                for (int r = 0; r < 16; ++r) p1[r] = -1e30f;
            }
            float ra = __builtin_fmaxf(__builtin_fmaxf(p0[0], p0[1]), p1[0]), rb = __builtin_fmaxf(__builtin_fmaxf(p0[2], p0[3]), p1[1]);
            ra = __builtin_fmaxf(__builtin_fmaxf(ra, p1[2]), p1[3]);
#pragma unroll
            for (int r = 4; r < 16; r += 4) { ra = __builtin_fmaxf(__builtin_fmaxf(ra, p0[r]), p0[r + 1]); rb = __builtin_fmaxf(__builtin_fmaxf(rb, p0[r + 2]), p0[r + 3]);
                                              ra = __builtin_fmaxf(__builtin_fmaxf(ra, p1[r]), p1[r + 1]); rb = __builtin_fmaxf(__builtin_fmaxf(rb, p1[r + 2]), p1[r + 3]); }
            float rm = fmaxf(ra, rb);
            rm = fmaxf(rm, __shfl_xor(rm, 32));
            if (__any(rm > 8.f)) {
                const float dl = rm > 8.f ? rm : 0.f;
                m += dl;
                const float alpha = fexp2(-dl); l *= alpha;
#pragma unroll
                for (int r = 0; r < 16; ++r) { p0[r] -= dl; p1[r] -= dl; negm[r] = -m; }
                if (hi == 0) wsf[r32] = alpha;
                asm volatile("s_waitcnt lgkmcnt(0)" ::: "memory");
                float f[16];
#pragma unroll
                for (int r = 0; r < 16; ++r) f[r] = wsf[crow(r, hi)];
#pragma unroll
                for (int d0 = 0; d0 < 4; ++d0)
#pragma unroll
                    for (int r = 0; r < 16; ++r) o[d0][r] *= f[r];
                asm volatile("s_waitcnt lgkmcnt(0)" ::: "memory");
            }
#pragma unroll
            for (int r = 0; r < 16; ++r) { p0[r] = fexp2(p0[r]); p1[r] = fexp2(p1[r]); }
            f32x2 s2 = (f32x2){0.f, 0.f}, s3 = s2;
#pragma unroll
            for (int r = 0; r < 16; r += 2) { s2 += (f32x2){p0[r], p0[r + 1]}; s3 += (f32x2){p1[r], p1[r + 1]}; }
            s2 += s3;
            l += s2[0] + s2[1];
            bf16x8 pw[4];
            { u32x4 w;
              w.x = cvtpk(p0[0], p0[1]); w.y = cvtpk(p0[2], p0[3]); w.z = cvtpk(p0[4], p0[5]); w.w = cvtpk(p0[6], p0[7]); pw[0] = __builtin_bit_cast(bf16x8, w);
              w.x = cvtpk(p0[8], p0[9]); w.y = cvtpk(p0[10], p0[11]); w.z = cvtpk(p0[12], p0[13]); w.w = cvtpk(p0[14], p0[15]); pw[1] = __builtin_bit_cast(bf16x8, w);
              w.x = cvtpk(p1[0], p1[1]); w.y = cvtpk(p1[2], p1[3]); w.z = cvtpk(p1[4], p1[5]); w.w = cvtpk(p1[6], p1[7]); pw[2] = __builtin_bit_cast(bf16x8, w);
              w.x = cvtpk(p1[8], p1[9]); w.y = cvtpk(p1[10], p1[11]); w.z = cvtpk(p1[12], p1[13]); w.w = cvtpk(p1[14], p1[15]); pw[3] = __builtin_bit_cast(bf16x8, w); }
            __builtin_amdgcn_sched_barrier(0);
#pragma unroll
            for (int ks = 0; ks < 4; ++ks)
#pragma unroll
                for (int d0 = 0; d0 < 4; ++d0) {
                    s16x4 lo, hh;
                    if (ks < NPRE) { lo = vlo[ks * 4 + d0]; hh = vhi[ks * 4 + d0]; }
                    else { lptr va = tb + DA_V + vlane + ks * 16 * DA_VS + d0 * 64; lo = vtr(va); hh = vtr(va + 8 * DA_VS); }
                    const bf16x8 vf = (bf16x8){lo[0], lo[1], lo[2], lo[3], hh[0], hh[1], hh[2], hh[3]};
                    o[d0] = MFMA32(pw[ks], vf, o[d0]);
                }
        }
    }
    __syncthreads();
    l += __shfl_xor(l, 32);
    const bool live = !SAMPLE || sub == 0;
    if (live) {
        const float fac = (c == 0) ? frcp(l) : lam * frcp(l);
        if (hi == 0) wsf[r32] = fac;
        asm volatile("s_waitcnt lgkmcnt(0)" ::: "memory");
        float f[16];
#pragma unroll
        for (int r = 0; r < 16; ++r) f[r] = wsf[crow(r, hi)];
#pragma unroll
        for (int d0 = 0; d0 < 4; ++d0)
#pragma unroll
            for (int r = 0; r < 16; ++r) o[d0][r] *= f[r];
    }
    LAS float* ex = (LAS float*)(lds + EXCH) + sub * 32 * EXS;
    if (live && c == 1) {
#pragma unroll
        for (int d0 = 0; d0 < 4; ++d0)
#pragma unroll
            for (int r = 0; r < 16; ++r) ex[crow(r, hi) * EXS + d0 * 32 + r32] = o[d0][r];
    }
    __syncthreads();
    if (live && c == 0) {
#pragma unroll
        for (int d0 = 0; d0 < 4; ++d0)
#pragma unroll
            for (int r = 0; r < 16; ++r) { LAS float* e = ex + crow(r, hi) * EXS + d0 * 32 + r32; *e = o[d0][r] - *e; }
    }
    __syncthreads();
    if (live) {
        const f32x2 g = *(const f32x2*)(PRM(subln_g) + 2 * lane);
#pragma unroll 4
        for (int rr = 0; rr < 16; ++rr) {
            const int row = c * 16 + rr;
            const f32x2 v = *(const LAS f32x2*)(ex + row * EXS + 2 * lane);
            const float ss = wave_sum(v.x * v.x + v.y * v.y);
            const float rs = rsqrtf(ss * (1.f / 128.f) + NEPS) * 0.8f;
            const bool ok = !SAMPLE || row < 16;
            const size_t grow = SAMPLE ? (size_t)(M_P + b * 16 + row) : (size_t)(b * 2048 + qblk * 128 + sub * 32 + row);
            if (ok) *(unsigned*)(OA + grow * 512 + h * 128 + 2 * lane) = cvtpk(v.x * rs * g.x, v.y * rs * g.y);
        }
    }
    __syncthreads();
}

template <bool SAMPLE>
__device__ __forceinline__ void sb_unit(lptr lds, const bf16_t* zA, bf16_t* OB, int b, int h, int qblk) {
    const int tid = tid_fresh(), lane = tid & 63, r32 = lane & 31, hi = lane >> 5, wid = __builtin_amdgcn_readfirstlane(tid >> 6);
    const bf16_t* QB = zA + 3 * ZSEC; const bf16_t* KB = zA + 4 * ZSEC; const bf16_t* VB = zA + 5 * ZSEC;
    const int qw = SAMPLE ? 2048 : qblk * 256 + wid * 32;
    const int qpos = SAMPLE ? 2048 + (r32 & 15) : qw + r32;
    const size_t qrow = SAMPLE ? (size_t)(M_P + b * 16 + (r32 & 15)) : (size_t)(b * 2048 + qpos);
    bf16x8 qr[4];
#pragma unroll
    for (int d0 = 0; d0 < 4; ++d0) qr[d0] = *(const bf16x8*)(QB + qrow * 512 + h * 64 + d0 * 16 + hi * 8);
    const int t_hi = SAMPLE ? 32 : 4 * qblk + 3;
    const int tw = qw >> 6;
    const bool active = !SAMPLE || wid == 0;
    f32x16 o[2]; o[0] = f32x16{}; o[1] = f32x16{};
    float R = 0.f;
    bool mydone = !active;
    LAS int* flags = (LAS int*)(lds + CTL);
    if (lane == 0) { flags[wid] = mydone ? 1 : 0; flags[8 + wid] = mydone ? 1 : 0; }
    const int vlane = ((lane >> 4) & 1) * 32 + (lane & 3) * 8 + (4 * hi + ((lane & 15) >> 2)) * SB_VS;
    const float* ck = SAMPLE ? PRM(csk) : nullptr; const float* cv = SAMPLE ? PRM(csv) : nullptr;
    SBStage<SAMPLE> st;
    st.load(ck, cv, KB, VB, b, h, t_hi, tid);
    st.store(lds + (t_hi & 1) * BUFB, tid);
    if (t_hi > 0) st.load(ck, cv, KB, VB, b, h, t_hi - 1, tid);
    for (int t = t_hi; t >= 0; --t) {
        __syncthreads();
        { int nd = 0;
#pragma unroll
          for (int w = 0; w < 8; ++w) nd += flags[((t + 1) & 1) * 8 + w];
          if (nd == 8) break; }
        lptr tb = lds + (t & 1) * BUFB;
        if (t > 0) { st.store(lds + ((t - 1) & 1) * BUFB, tid); if (t > 1) st.load(ck, cv, KB, VB, b, h, t - 2, tid); }
        if (!mydone && t <= tw) {
            f32x16 p0 = f32x16{}, p1 = f32x16{};
#pragma unroll
            for (int d0 = 0; d0 < 4; ++d0) {
                lptr ka = tb + SB_K + (2 * d0 + hi) * KCH + r32 * 16;
                const bf16x8 b0 = *(const LAS bf16x8*)ka, b1 = *(const LAS bf16x8*)(ka + 512);
                p0 = MFMA32(b0, qr[d0], p0); p1 = MFMA32(b1, qr[d0], p1);
            }
            float x[32], lk[32];
#pragma unroll
            for (int r = 0; r < 16; ++r) { x[r] = p0[r]; x[16 + r] = p1[r]; }
            const int kb = 64 * t + 4 * hi;
#pragma unroll
            for (int i = 0; i < 32; ++i) {
                const float z = x[i];
                const float e = fexp2(-fabsf(z) * L2E);
                const float sp = fmaxf(z, 0.f) + LN2 * flog2(1.f + e);
                const bool msk = (kb + 8 * (i >> 2) + (i & 3)) < qpos;
                lk[i] = msk ? -sp : 0.f;
                x[i] = msk ? (z - sp) : -1e30f;
            }
            float gs[8], gp[8];
#pragma unroll
            for (int k = 0; k < 8; ++k) { gs[k] = (lk[4 * k] + lk[4 * k + 1]) + (lk[4 * k + 2] + lk[4 * k + 3]); gp[k] = __shfl_xor(gs[k], 32); }
            float run = R;
#pragma unroll
            for (int k = 7; k >= 0; --k) {
                const float c3 = run + (hi == 0 ? gp[k] : 0.f), c2 = c3 + lk[4 * k + 3], c1 = c2 + lk[4 * k + 2], c0 = c1 + lk[4 * k + 1];
                x[4 * k + 3] += c3; x[4 * k + 2] += c2; x[4 * k + 1] += c1; x[4 * k] += c0;
                run += gs[k] + gp[k];
            }
            R = run;
#pragma unroll
            for (int i = 0; i < 32; ++i) x[i] = fexp2(x[i] * L2E);
            bf16x8 pw[4];
#pragma unroll
            for (int ks = 0; ks < 4; ++ks) { u32x4 w; w.x = cvtpk(x[8 * ks], x[8 * ks + 1]); w.y = cvtpk(x[8 * ks + 2], x[8 * ks + 3]); w.z = cvtpk(x[8 * ks + 4], x[8 * ks + 5]); w.w = cvtpk(x[8 * ks + 6], x[8 * ks + 7]); pw[ks] = __builtin_bit_cast(bf16x8, w); }
#pragma unroll
            for (int d0 = 0; d0 < 2; ++d0)
#pragma unroll
                for (int ks = 0; ks < 4; ++ks) {
                    lptr va = tb + SB_V + vlane + ks * 16 * SB_VS + d0 * 64;
                    const s16x4 lo = vtr(va), hh = vtr(va + 8 * SB_VS);
                    const bf16x8 vf = (bf16x8){lo[0], lo[1], lo[2], lo[3], hh[0], hh[1], hh[2], hh[3]};
                    o[d0] = MFMA32(pw[ks], vf, o[d0]);
                }
            if (__all(R < SB_THR)) mydone = true;
        }
        if (lane == 0) flags[(t & 1) * 8 + wid] = mydone ? 1 : 0;
    }
    __syncthreads();
    if (active) {
#pragma unroll
        for (int d0 = 0; d0 < 2; ++d0)
#pragma unroll
            for (int r = 0; r < 16; ++r) {
                const int q = crow(r, hi);
                const bool ok = !SAMPLE || q < 16;
                const size_t grow = SAMPLE ? (size_t)(M_P + b * 16 + q) : (size_t)(b * 2048 + qw + q);
                if (ok) OB[grow * 512 + h * 64 + d0 * 32 + r32] = (bf16_t)(cvtpk(o[d0][r], 0.f) & 0xffffu);
            }
    }
}

__device__ __forceinline__ void attention_phase(lptr lds, unsigned* counter) {
    const int tid = tid_fresh(), lane = tid & 63;
    bf16_t* zA = (bf16_t*)(PRM(ws) + WS_A);
    bf16_t* OA = zA + 10 * ZSEC; bf16_t* OB = zA + 11 * ZSEC;
    const float d1 = wave_sum(PRM(lq1)[lane] * PRM(lk1)[lane]), d2 = wave_sum(PRM(lq2)[lane] * PRM(lk2)[lane]);
    const float lam = expf(d1) - expf(d2) + 0.2f;
    LAS int* ctl = (LAS int*)(lds + CTL);
    for (;;) {
        __syncthreads();
        if (tid == 0) ctl[16] = (int)atomicAdd(counter, 1u);
        __syncthreads();
        int u = __builtin_amdgcn_readfirstlane(ctl[16]);
        if (u >= NUNITS) break;
        if (u < NU_DAS) { da_unit<true>(lds, zA, OA, u >> 2, u & 3, 0, lam); continue; }
        u -= NU_DAS;
        if (u < NU_SBS) { sb_unit<true>(lds, zA, OB, u >> 3, u & 7, 0); continue; }
        u -= NU_SBS;
        if (u < NU_DAP) { const int bh = u & 63; da_unit<false>(lds, zA, OA, bh >> 2, bh & 3, 15 - (u >> 6), lam); continue; }
        u -= NU_DAP;
        { const int bh = u & 127; sb_unit<false>(lds, zA, OB, bh >> 3, bh & 7, 7 - (u >> 7)); }
    }
}
#undef MFMA32
}

#define XB_TMO      128
#define XB_XCNT(j)  (256  + 64 * (j))
#define XB_XSUB(j)  (1280 + 64 * (j))
#define XB_XGEN(j)  (2304 + 64 * (j))
#define XB_TOP      3328
#define XB_TOPGEN   3392
#define XCD_BAR_WORDS 3456
#define XB_SPIN_CAP (1u << 18)

__device__ __forceinline__ unsigned xb_ld(unsigned* p)              { return __hip_atomic_load(p, __ATOMIC_RELAXED, __HIP_MEMORY_SCOPE_AGENT); }
__device__ __forceinline__ unsigned xb_add(unsigned* p, unsigned v) { return __hip_atomic_fetch_add(p, v, __ATOMIC_RELAXED, __HIP_MEMORY_SCOPE_AGENT); }
__device__ __forceinline__ unsigned xb_xcc_id() { return (unsigned)__builtin_amdgcn_s_getreg((3 << 11) | 20) & 0xFu; }
#define XB_SPIN(cond, bar) do { unsigned _sp = 0; while (cond) { __builtin_amdgcn_s_sleep(1); \
    if ((++_sp & 255u) == 0u) { if (xb_ld(&(bar)[XB_TMO])) break; if (_sp > XB_SPIN_CAP) { atomicAdd(&(bar)[XB_TMO], 1u); break; } } } } while (0)

struct XcdBarrier {
    unsigned* bar; unsigned x;
    volatile LAS unsigned* st;
};

__device__ __forceinline__ XcdBarrier xcd_barrier_post(unsigned* bar, volatile LAS unsigned* st) {
    XcdBarrier b; b.bar = bar; b.x = xb_xcc_id(); b.st = st;
    if (threadIdx.x == 0) (void)xb_add(&bar[XB_XCNT(b.x)], 1u);
    return b;
}
__device__ __forceinline__ void xcd_barrier_complete(unsigned* bar, unsigned x, unsigned& nloc, unsigned& nx) {
    const unsigned G = gridDim.x * gridDim.y * gridDim.z;
    unsigned sum, cnt, mine, sp = 0u;
    for (;;) {
        sum = 0u; cnt = 0u; mine = 0u;
#pragma unroll
        for (unsigned j = 0; j < 16; ++j) { const unsigned c = xb_ld(&bar[XB_XCNT(j)]); sum += c; cnt += (c > 0u) ? 1u : 0u; mine = (j == x) ? c : mine; }
        if (sum == G) break;
        __builtin_amdgcn_s_sleep(1);
        if ((++sp & 255u) == 0u) { if (xb_ld(&bar[XB_TMO])) break; if (sp > XB_SPIN_CAP) { atomicAdd(&bar[XB_TMO], 1u); break; } }
    }
    nloc = mine > 0u ? mine : 1u; nx = cnt > 0u ? cnt : 1u;
}

__device__ __forceinline__ void xcd_barrier(const XcdBarrier& b) {
    asm volatile("s_waitcnt vmcnt(0)" ::: "memory");
    __syncthreads();
    if (threadIdx.x == 0) {
        unsigned* bar = b.bar;
        __builtin_amdgcn_s_waitcnt(0);
        unsigned nloc = b.st[0], nx = b.st[1];
        if (nloc == 0u) { xcd_barrier_complete(bar, b.x, nloc, nx); b.st[0] = nloc; b.st[1] = nx; }
        const unsigned old = xb_add(&bar[XB_XSUB(b.x)], 1u);
        const unsigned gen = old / nloc;
        if (old + 1u == (gen + 1u) * nloc) {
            __builtin_amdgcn_fence(__ATOMIC_RELEASE, "agent");
            asm volatile("s_waitcnt vmcnt(0)" ::: "memory");
            const unsigned og = xb_add(&bar[XB_TOP], 1u);
            const unsigned tg = og / nx;
            if (og + 1u == (tg + 1u) * nx) xb_add(&bar[XB_TOPGEN], 1u);
            else XB_SPIN(xb_ld(&bar[XB_TOPGEN]) == tg, bar);
            __builtin_amdgcn_fence(__ATOMIC_ACQUIRE, "agent");
            xb_add(&bar[XB_XGEN(b.x)], 1u);
            asm volatile("s_waitcnt vmcnt(0)" ::: "memory");
        } else {
            XB_SPIN(xb_ld(&bar[XB_XGEN(b.x)]) == gen, bar);
            __builtin_amdgcn_fence(__ATOMIC_ACQUIRE, "agent");
            asm volatile("s_waitcnt vmcnt(0)" ::: "memory");
        }
    }
    __syncthreads();
}

constexpr int LDS_BYTES = 147456;
__global__ void __launch_bounds__(512, 2) fwd_megakernel(Params p) {
    extern __shared__ __attribute__((aligned(16))) unsigned char lds_raw[];
    lptr lds = (lptr)lds_raw;
    cg::grid_group grid = cg::this_grid();
    const int tid = threadIdx.x, lane = tid & 63, wave = __builtin_amdgcn_readfirstlane(tid >> 6);
    const int G = gridDim.x, gw = blockIdx.x * 8 + wave, NGW = G * 8;
    if (tid == 0) {
        prm_st(lds, offsetof(Params, x_prompt), p.x_prompt); prm_st(lds, offsetof(Params, x_sample), p.x_sample); prm_st(lds, offsetof(Params, cdk), p.cdk); prm_st(lds, offsetof(Params, cdv), p.cdv);
        prm_st(lds, offsetof(Params, csk), p.csk); prm_st(lds, offsetof(Params, csv), p.csv); prm_st(lds, offsetof(Params, state_conv), p.state_conv); prm_st(lds, offsetof(Params, attn_g), p.attn_g);
        prm_st(lds, offsetof(Params, w_in), p.w_in); prm_st(lds, offsetof(Params, lq1), p.lq1); prm_st(lds, offsetof(Params, lk1), p.lk1); prm_st(lds, offsetof(Params, lq2), p.lq2); prm_st(lds, offsetof(Params, lk2), p.lk2);
        prm_st(lds, offsetof(Params, subln_g), p.subln_g); prm_st(lds, offsetof(Params, w_a), p.w_a); prm_st(lds, offsetof(Params, w_b), p.w_b); prm_st(lds, offsetof(Params, w_out), p.w_out); prm_st(lds, offsetof(Params, ffn_g), p.ffn_g);
        prm_st(lds, offsetof(Params, w_up), p.w_up); prm_st(lds, offsetof(Params, conv_w), p.conv_w); prm_st(lds, offsetof(Params, conv_b), p.conv_b); prm_st(lds, offsetof(Params, w_down), p.w_down); prm_st(lds, offsetof(Params, final_g), p.final_g);
        prm_st(lds, offsetof(Params, out), p.out); prm_st(lds, offsetof(Params, ws), p.ws);
    }
    __syncthreads();
#define ws PRM(ws)
    float* rstd1 = (float*)(ws + WS_RSTD); float* ssq1 = (float*)(ws + WS_SSQ1);
    bf16_t* WinT = (bf16_t*)(ws + WS_WIN); bf16_t* WaT = (bf16_t*)(ws + WS_WA); bf16_t* WbT = (bf16_t*)(ws + WS_WB); bf16_t* WoutT = (bf16_t*)(ws + WS_WOUT);
    bf16_t* WupT = (bf16_t*)(ws + WS_WUP); bf16_t* WdnT = (bf16_t*)(ws + WS_WDN);
    bf16_t* zA = (bf16_t*)(ws + WS_A); bf16_t* U = zA;
    bf16_t* XB = (bf16_t*)(ws + WS_B); bf16_t* MG = XB + (size_t)M_TOK * 1024; bf16_t* H = XB;
    bf16_t* X1B = (bf16_t*)(ws + WS_X1B);
    unsigned* counter = (unsigned*)(ws + WS_CTL);
    volatile LAS unsigned* bst = (volatile LAS unsigned*)(lds + 131072 + 512);
    if (tid == 0) { bst[0] = 0u; bst[1] = 0u; }
    __syncthreads();

    {
        if (blockIdx.x == 0) for (int i = tid; i < 4096; i += 512) counter[i] = 0u;
        LAS float* scr = (LAS float*)(lds + wave * 16384);
        constexpr int I_IN = 16 * 160, I_A = 8 * 32, I_O = 16 * 32, I_UP = 16 * 176, I_DN = 44 * 32, NITEMS = I_IN + 2 * I_A + I_O + I_UP + I_DN;
        for (int it = gw; it < NITEMS; it += NGW) {
            int r = it;
            if (r < I_IN) { transpose_item<1>(PRM(w_in), 1024, NIN, WinT, PRM(attn_g), scr, r, lane); continue; } r -= I_IN;
            if (r < I_A) { transpose_item<0>(PRM(w_a), 512, 1024, WaT, nullptr, scr, r, lane); continue; } r -= I_A;
            if (r < I_A) { transpose_item<0>(PRM(w_b), 512, 1024, WbT, nullptr, scr, r, lane); continue; } r -= I_A;
            if (r < I_O) { transpose_item<0>(PRM(w_out), 1024, 1024, WoutT, nullptr, scr, r, lane); continue; } r -= I_O;
            if (r < I_UP) { transpose_item<2>(PRM(w_up), 1024, NUP, WupT, PRM(ffn_g), scr, r, lane); continue; } r -= I_UP;
            transpose_item<0>(PRM(w_down), DFF, 1024, WdnT, nullptr, scr, r, lane);
        }
        for (int row0 = gw; row0 < M_TOK; row0 += 4 * NGW) {
            f32x4 v[4][4];
#pragma unroll
            for (int q = 0; q < 4; ++q) { const int row = row0 + q * NGW;
                if (row < M_TOK) { const float* xr = row < M_P ? PRM(x_prompt) + (size_t)row * 1024 : PRM(x_sample) + (size_t)(row - M_P) * 1024;
#pragma unroll
                    for (int j = 0; j < 4; ++j) v[q][j] = *(const f32x4*)(xr + 4 * lane + 256 * j); } }
#pragma unroll
            for (int q = 0; q < 4; ++q) { const int row = row0 + q * NGW;
                if (row < M_TOK) { float s = 0.f;
#pragma unroll
                    for (int j = 0; j < 4; ++j) s += (v[q][j][0] * v[q][j][0] + v[q][j][1] * v[q][j][1]) + (v[q][j][2] * v[q][j][2] + v[q][j][3] * v[q][j][3]);
                    s = wave_sum(s);
                    if (lane == 0) rstd1[row] = rsqrtf(s * (1.f / 1024.f) + NEPS);
#pragma unroll
                    for (int j = 0; j < 4; ++j) { u32x2 w; w.x = cvtpk(v[q][j][0], v[q][j][1]); w.y = cvtpk(v[q][j][2], v[q][j][3]); *(u32x2*)(XB + (size_t)row * 1024 + 4 * lane + 256 * j) = w; } } }
        }
    }
    grid.sync();
    const XcdBarrier xbar = xcd_barrier_post(counter + 256, bst);
    {
        pg8::Gemm g{XB, WinT, M_TOK, NIN, 1024}; pg8::StaticOrder S; S.init(M_TOK, NIN, G, (int)blockIdx.x);
        EpiIn E{rstd1, zA, PRM(out)};
        pg8::gemm_phase<EpiIn, pg8::StaticOrder, true, true>(lds, g, S, E);
    }
    xcd_barrier(xbar);
    att::attention_phase(lds, counter);
    xcd_barrier(xbar);
    {
        pg8::Gemm g{zA + 10 * ZSEC, WaT, M_TOK, 1024, 512}; pg8::StaticOrder S; S.init(M_TOK, 1024, G, (int)blockIdx.x);
        EpiMerge<true> E{zA + 6 * ZSEC, MG};
        pg8::gemm_phase<EpiMerge<true>, pg8::StaticOrder, true, true>(lds, g, S, E);
    }
    {
        pg8::Gemm g{zA + 11 * ZSEC, WbT, M_TOK, 1024, 512}; pg8::StaticOrder S; S.init(M_TOK, 1024, G, (int)blockIdx.x);
        EpiMerge<false> E{zA + 8 * ZSEC, MG};
        pg8::gemm_phase<EpiMerge<false>, pg8::StaticOrder, true, true>(lds, g, S, E);
    }
    xcd_barrier(xbar);
    {
        pg8::Gemm g{MG, WoutT, M_TOK, 1024, 1024}; pg8::StaticOrder S; S.init(M_TOK, 1024, G, (int)blockIdx.x);
        EpiRes<true> E{PRM(x_prompt), PRM(x_sample), PRM(out) + O_Y, X1B, ssq1};
        pg8::gemm_phase<EpiRes<true>, pg8::StaticOrder, true, true>(lds, g, S, E);
    }
    xcd_barrier(xbar);
    {
        pg8::Gemm g{X1B, WupT, M_TOK, NUP, 1024}; pg8::StaticOrder S; S.init(M_TOK, NUP, G, (int)blockIdx.x);
        EpiUpConv E{ssq1, U, H, PRM(out), PRM(conv_w), PRM(conv_b), lds + 131072 + 4096};
        pg8::gemm_phase<EpiUpConv, pg8::StaticOrder, true, true>(lds, g, S, E);
    }
    xcd_barrier(xbar);
    {
        constexpr int NCH = DFF / 8, NPAIR = M_P / 64 + 512 / 16, TOTAL = NPAIR * NCH;
        for (int it = blockIdx.x * 512 + tid; it < TOTAL; it += G * 512) {
            const int pr = it / NCH, ch = it - pr * NCH, j0 = ch * 8;
            const bool samp = pr >= M_P / 64;
            const int row0 = samp ? M_P + (pr - M_P / 64) * 16 : pr * 64;
            const bool first = samp || (row0 & 2047) == 0;
            float wg[3][8], wv[3][8], bg[8], bv[8];
#pragma unroll
            for (int j = 0; j < 3; ++j)
#pragma unroll
                for (int e = 0; e < 8; ++e) { wg[j][e] = PRM(conv_w)[j * NUP + j0 + e]; wv[j][e] = PRM(conv_w)[j * NUP + DFF + j0 + e]; }
#pragma unroll
            for (int e = 0; e < 8; ++e) { bg[e] = PRM(conv_b)[j0 + e]; bv[e] = PRM(conv_b)[DFF + j0 + e]; }
            f32x4 g2[2], g1[2], v2[2], v1[2];
            if (first) {
                if (samp) { const float* sc = PRM(state_conv) + (size_t)((row0 - M_P) >> 4) * 2 * NUP;
                    g2[0] = *(const f32x4*)(sc + j0); g2[1] = *(const f32x4*)(sc + j0 + 4); v2[0] = *(const f32x4*)(sc + DFF + j0); v2[1] = *(const f32x4*)(sc + DFF + j0 + 4);
                    g1[0] = *(const f32x4*)(sc + NUP + j0); g1[1] = *(const f32x4*)(sc + NUP + j0 + 4); v1[0] = *(const f32x4*)(sc + NUP + DFF + j0); v1[1] = *(const f32x4*)(sc + NUP + DFF + j0 + 4);
                } else { g2[0] = g2[1] = g1[0] = g1[1] = v2[0] = v2[1] = v1[0] = v1[1] = (f32x4){0.f, 0.f, 0.f, 0.f}; }
            } else {
                att::expand8(*(const u32x4*)(U + (size_t)(row0 - 2) * NUP + j0), g2[0], g2[1]); att::expand8(*(const u32x4*)(U + (size_t)(row0 - 2) * NUP + DFF + j0), v2[0], v2[1]);
                att::expand8(*(const u32x4*)(U + (size_t)(row0 - 1) * NUP + j0), g1[0], g1[1]); att::expand8(*(const u32x4*)(U + (size_t)(row0 - 1) * NUP + DFF + j0), v1[0], v1[1]);
            }
#pragma unroll
            for (int r = 0; r < 2; ++r) {
                f32x4 g0[2], v0[2];
                att::expand8(*(const u32x4*)(U + (size_t)(row0 + r) * NUP + j0), g0[0], g0[1]); att::expand8(*(const u32x4*)(U + (size_t)(row0 + r) * NUP + DFF + j0), v0[0], v0[1]);
                f32x4 hh[2];
#pragma unroll
                for (int q = 0; q < 2; ++q)
#pragma unroll
                    for (int e = 0; e < 4; ++e) {
                        const int i = 4 * q + e;
                        const float cgt = bg[i] + wg[0][i] * g2[q][e] + wg[1][i] * g1[q][e] + wg[2][i] * g0[q][e];
                        const float cvl = bv[i] + wv[0][i] * v2[q][e] + wv[1][i] * v1[q][e] + wv[2][i] * v0[q][e];
                        hh[q][e] = cgt * sigmoidf_(cgt) * cvl;
                    }
                *(u32x4*)(H + (size_t)(row0 + r) * DFF + j0) = pack8(hh[0], hh[1]);
                g2[0] = g1[0]; g2[1] = g1[1]; v2[0] = v1[0]; v2[1] = v1[1]; g1[0] = g0[0]; g1[1] = g0[1]; v1[0] = v0[0]; v1[1] = v0[1];
            }
        }
    }
    xcd_barrier(xbar);
    {
        pg8::Gemm g{H, WdnT, M_TOK, 1024, DFF}; pg8::StaticOrder S; S.init(M_P, 1024, G, (int)blockIdx.x);
        EpiDown E{PRM(out) + O_Y, (float*)(ws + WS_A)};
        pg8::gemm_phase<EpiDown, pg8::StaticOrder, true, true>(lds, g, S, E);
        DownOrder S2; S2.init(G, (int)blockIdx.x);
        pg8::gemm_phase<EpiDown, DownOrder, true, true, 4>(lds, g, S2, E);
    }
    xcd_barrier(xbar);
    for (int row0 = gw; row0 < M_P; row0 += 4 * NGW) {
        f32x4 v[4][4];
#pragma unroll
        for (int q = 0; q < 4; ++q) { const int row = row0 + q * NGW;
            if (row < M_P) { const float* yr = PRM(out) + O_Y + (size_t)row * 1024;
#pragma unroll
                for (int j = 0; j < 4; ++j) v[q][j] = *(const f32x4*)(yr + 4 * lane + 256 * j); } }
#pragma unroll
        for (int q = 0; q < 4; ++q) { const int row = row0 + q * NGW;
            if (row < M_P) { float* yr = PRM(out) + O_Y + (size_t)row * 1024; float s = 0.f;
#pragma unroll
                for (int j = 0; j < 4; ++j) s += (v[q][j][0] * v[q][j][0] + v[q][j][1] * v[q][j][1]) + (v[q][j][2] * v[q][j][2] + v[q][j][3] * v[q][j][3]);
                const float rs = rsqrtf(wave_sum(s) * (1.f / 1024.f) + NEPS);
#pragma unroll
                for (int j = 0; j < 4; ++j) { const int c = 4 * lane + 256 * j; const f32x4 g = *(const f32x4*)(PRM(final_g) + c); *(f32x4*)(yr + c) = v[q][j] * rs * g; } } }
    }
    for (int row = M_P + gw; row < M_TOK; row += NGW) {
        float* yr = PRM(out) + O_Y + (size_t)row * 1024;
        f32x4 v[4]; float s = 0.f;
#pragma unroll
        for (int j = 0; j < 4; ++j) {
            v[j] = *(const f32x4*)(yr + 4 * lane + 256 * j);
#pragma unroll
            for (int ks = 0; ks < 11; ++ks) v[j] += *(const f32x4*)((const float*)(ws + WS_A) + ((size_t)ks * 512 + (row - M_P)) * 1024 + 4 * lane + 256 * j);
            s += (v[j][0] * v[j][0] + v[j][1] * v[j][1]) + (v[j][2] * v[j][2] + v[j][3] * v[j][3]);
        }
        const float rs = rsqrtf(wave_sum(s) * (1.f / 1024.f) + NEPS);
#pragma unroll
        for (int j = 0; j < 4; ++j) { const int c = 4 * lane + 256 * j; const f32x4 g = *(const f32x4*)(PRM(final_g) + c); *(f32x4*)(yr + c) = v[j] * rs * g; }
    }
}
#undef ws

extern "C" void kernel_launch(void* const* d_in, const int* in_sizes, int n_in, void* d_out, int out_size, void* d_ws, size_t ws_size, hipStream_t stream) {
    static int grid = 0;
    if (grid == 0) {
        if (n_in != 23 || (size_t)out_size != O_END || ws_size < WS_END) { fprintf(stderr, "kernel_launch: unexpected sizes n_in %d out %d ws %zu (need %zu)\n", n_in, out_size, ws_size, (size_t)WS_END); grid = -1; return; }
        int dev = 0, cus = 0, per_cu = 0;
        hipGetDevice(&dev); hipDeviceGetAttribute(&cus, hipDeviceAttributeMultiprocessorCount, dev);
        if (hipFuncSetAttribute((const void*)fwd_megakernel, hipFuncAttributeMaxDynamicSharedMemorySize, LDS_BYTES) != hipSuccess) { fprintf(stderr, "kernel_launch: hipFuncSetAttribute failed\n"); grid = -1; return; }
        if (hipOccupancyMaxActiveBlocksPerMultiprocessor(&per_cu, (const void*)fwd_megakernel, 512, LDS_BYTES) != hipSuccess || per_cu < 1) { fprintf(stderr, "kernel_launch: occupancy query says %d\n", per_cu); per_cu = 1; }
        (void)hipGetLastError();
        grid = cus * 1;
    }
    if (grid < 0) return;
    Params p{};
    p.x_prompt = (const float*)d_in[0]; p.x_sample = (const float*)d_in[1]; p.cdk = (const float*)d_in[2]; p.cdv = (const float*)d_in[3]; p.csk = (const float*)d_in[4]; p.csv = (const float*)d_in[5];
    p.state_conv = (const float*)d_in[6]; p.attn_g = (const float*)d_in[7]; p.w_in = (const float*)d_in[8]; p.lq1 = (const float*)d_in[9]; p.lk1 = (const float*)d_in[10]; p.lq2 = (const float*)d_in[11];
    p.lk2 = (const float*)d_in[12]; p.subln_g = (const float*)d_in[13]; p.w_a = (const float*)d_in[14]; p.w_b = (const float*)d_in[15]; p.w_out = (const float*)d_in[16]; p.ffn_g = (const float*)d_in[17];
    p.w_up = (const float*)d_in[18]; p.conv_w = (const float*)d_in[19]; p.conv_b = (const float*)d_in[20]; p.w_down = (const float*)d_in[21]; p.final_g = (const float*)d_in[22];
    p.out = (float*)d_out; p.ws = (unsigned char*)d_ws;
    void* args[] = {&p};
    hipError_t e = hipLaunchCooperativeKernel((const void*)fwd_megakernel, dim3(grid), dim3(512), args, LDS_BYTES, stream);
    if (e != hipSuccess) fprintf(stderr, "cooperative launch failed: %s (grid %d)\n", hipGetErrorString(e), grid);
}
```
